# Optimizing an MI355X kernel written in HIP

```python
import math
import jax, jax.numpy as jnp
from jax import lax
import numpy as np

D_MODEL = 1024
BATCH = 8
SEQ = 2048
DEPTH = 2
DEC_BATCH = 128
DEC_SEQ = 8
PAST_LEN = 2048
PAGE_SIZE = 128

N_A_LAYERS = DEPTH // 2
N_B_LAYERS = DEPTH - N_A_LAYERS
DN_ALPHA = (2.0 * DEPTH) ** 0.25
DN_BETA = (8.0 * DEPTH) ** -0.25
LN_EPS = 1e-5
RMS_EPS = 1e-5
D_FF = 4 * D_MODEL

M_D_INNER = 2 * D_MODEL
M_HEAD_DIM = 64
M_N_HEADS = M_D_INNER // M_HEAD_DIM
M_N_GROUPS = 4
M_HPG = M_N_HEADS // M_N_GROUPS
M_D_STATE = 128
M_CONV = 4
M_CHUNK = 128
M_CONV_DIM = M_D_INNER + 2 * M_N_GROUPS * M_D_STATE
M_IN_DIM = M_D_INNER + M_CONV_DIM + M_N_HEADS

A_HEAD_DIM = 64
A_N_HEADS = D_MODEL // A_HEAD_DIM
A_N_KV = 4
A_GROUP = A_N_HEADS // A_N_KV
A_Q_DIM = A_N_HEADS * A_HEAD_DIM
CMP_LEN = 32
CMP_STRIDE = 16
CMP_RATIO = CMP_LEN // CMP_STRIDE
CMP_HIDDEN = 2 * A_HEAD_DIM
SEL_BLOCK = 64
SEL_TOPN = 16
WINDOW = 512
Q_BLOCK = 128
N_BUCKETS = 32
MAX_DISTANCE = 128
MASK_VALUE = -1e30
FORCE_SCORE = 1e3

kernel_name = "yoco_mamba2_nsa_decoder_step"


def layer_norm(x, g, b):
    xf = x.astype(jnp.float32)
    mu = jnp.mean(xf, axis=-1, keepdims=True)
    var = jnp.mean(jnp.square(xf - mu), axis=-1, keepdims=True)
    return ((xf - mu) * lax.rsqrt(var + LN_EPS)).astype(x.dtype) * g + b


def sq_relu_mlp(x, w1, w2):
    return jnp.square(jax.nn.relu(x @ w1)) @ w2


def rel_bucket(dist):
    n = jnp.maximum(dist, 0)
    max_exact = N_BUCKETS // 2
    large = max_exact + (jnp.log(jnp.maximum(n, max_exact).astype(jnp.float32) / max_exact)
                         / math.log(MAX_DISTANCE / max_exact) * (N_BUCKETS - max_exact)).astype(jnp.int32)
    return jnp.where(n < max_exact, n, jnp.minimum(large, N_BUCKETS - 1))


def causal_conv(xbc, conv_state, w, b):
    L = xbc.shape[1]
    xp = jnp.concatenate([conv_state, xbc], axis=1)
    acc = b + xp[:, 0:L] * w[0]
    for k in range(1, M_CONV):
        acc = acc + xp[:, k:k + L] * w[k]
    return jax.nn.silu(acc), xp[:, L:]


def segsum(a):
    T = a.shape[-1]
    aa = jnp.broadcast_to(a[..., :, None], a.shape + (T,))
    aa = jnp.where(jnp.tril(jnp.ones((T, T), bool), -1), aa, 0.0)
    s = jnp.cumsum(aa, axis=-2)
    return jnp.where(jnp.tril(jnp.ones((T, T), bool)), s, -jnp.inf)


def ssd_scan(x, a, Bm, Cm, h0):
    Bn, L, G, R, P = x.shape
    Q = M_CHUNK if L % M_CHUNK == 0 else L
    c = L // Q
    x = x.reshape(Bn, c, Q, G, R, P)
    Bm = Bm.reshape(Bn, c, Q, G, -1)
    Cm = Cm.reshape(Bn, c, Q, G, -1)
    a = a.reshape(Bn, c, Q, G, R).transpose(0, 3, 4, 1, 2)
    a_cum = jnp.cumsum(a, axis=-1)
    lmat = jnp.exp(segsum(a))
    y_diag = jnp.einsum('bclgn,bcsgn,bgrcls,bcsgrp->bclgrp', Cm, Bm, lmat, x)
    decay_states = jnp.exp(a_cum[..., -1:] - a_cum)
    states = jnp.einsum('bclgn,bgrcl,bclgrp->bcgrpn', Bm, decay_states, x)
    states = jnp.concatenate([h0[:, None], states], axis=1)
    chunk_a = jnp.pad(a_cum[..., -1], ((0, 0), (0, 0), (0, 0), (1, 0)))
    decay_chunk = jnp.exp(segsum(chunk_a))
    states = jnp.einsum('bgrzc,bcgrpn->bzgrpn', decay_chunk, states)
    prev_states, h_last = states[:, :-1], states[:, -1]
    y_off = jnp.einsum('bclgn,bcgrpn,bgrcl->bclgrp', Cm, prev_states, jnp.exp(a_cum))
    return (y_diag + y_off).reshape(Bn, L, G, R, P), h_last


def mamba_mixer(h, ssm_state, conv_state, in_w, conv_w, conv_b, dt_bias, a_log, d_skip, norm_w, out_w):
    Bn, L, _ = h.shape
    f32 = jnp.float32
    zxbcdt = h @ in_w
    z, xbc, dt = jnp.split(zxbcdt, [M_D_INNER, M_D_INNER + M_CONV_DIM], axis=-1)
    xbc, new_conv = causal_conv(xbc, conv_state, conv_w, conv_b)
    xs, Bm, Cm = jnp.split(xbc, [M_D_INNER, M_D_INNER + M_N_GROUPS * M_D_STATE], axis=-1)
    xs = xs.reshape(Bn, L, M_N_GROUPS, M_HPG, M_HEAD_DIM).astype(f32)
    Bm = Bm.reshape(Bn, L, M_N_GROUPS, M_D_STATE).astype(f32)
    Cm = Cm.reshape(Bn, L, M_N_GROUPS, M_D_STATE).astype(f32)
    dt = jax.nn.softplus(dt.astype(f32) + dt_bias.astype(f32)).reshape(Bn, L, M_N_GROUPS, M_HPG)
    A = -jnp.exp(a_log.astype(f32)).reshape(M_N_GROUPS, M_HPG)
    h0 = ssm_state.astype(f32).reshape(Bn, M_N_GROUPS, M_HPG, M_HEAD_DIM, M_D_STATE)
    y, h_last = ssd_scan(xs * dt[..., None], dt * A, Bm, Cm, h0)
    y = y + xs * d_skip.astype(f32).reshape(M_N_GROUPS, M_HPG)[:, :, None]
    y = y.reshape(Bn, L, M_D_INNER) * jax.nn.silu(z.astype(f32))
    yg = y.reshape(Bn, L, M_N_GROUPS, M_D_INNER // M_N_GROUPS)
    yg = yg * lax.rsqrt(jnp.mean(yg * yg, axis=-1, keepdims=True) + RMS_EPS)
    y = (yg.reshape(Bn, L, M_D_INNER) * norm_w).astype(h.dtype)
    new_ssm = h_last.reshape(Bn, M_N_HEADS, M_HEAD_DIM, M_D_STATE).astype(ssm_state.dtype)
    return y @ out_w, new_ssm, new_conv


def compress_tokens(tok, w1, pe, w2):
    Bn, T = tok.shape[:2]
    n_chunks = T // CMP_STRIDE
    n_cmp = n_chunks - CMP_RATIO + 1
    chunks = tok[:, :n_chunks * CMP_STRIDE].reshape(Bn, n_chunks, CMP_STRIDE, A_N_KV, A_HEAD_DIM)
    hid = jnp.einsum('bcjgd,jde->bcge', chunks[:, 0:n_cmp] + pe[0:CMP_STRIDE][:, None, :], w1[0])
    for r in range(1, CMP_RATIO):
        part = chunks[:, r:r + n_cmp] + pe[r * CMP_STRIDE:(r + 1) * CMP_STRIDE][:, None, :]
        hid = hid + jnp.einsum('bcjgd,jde->bcge', part, w1[r])
    return jnp.einsum('bcge,ed->bcgd', jax.nn.silu(hid), w2)


def to_sel_blocks(tok):
    Bn, T = tok.shape[:2]
    n_sel = -(-T // SEL_BLOCK)
    tok = jnp.pad(tok, ((0, 0), (0, n_sel * SEL_BLOCK - T), (0, 0), (0, 0)))
    return tok.reshape(Bn, n_sel, SEL_BLOCK, A_N_KV, A_HEAD_DIM)


def shared_kv(h, start, past_cmp, past_sel, past_win, kv_w, cmp_w1, cmp_pe, cmp_w2):
    Bn, Sq, _ = h.shape
    kv = (h @ kv_w).reshape(Bn, Sq, 3, 2, A_N_KV, A_HEAD_DIM)
    new_cmp, new_sel, new_win = kv[:, :, 0], kv[:, :, 1], kv[:, :, 2]
    full_cmp = jnp.concatenate([past_cmp, new_cmp], axis=1)
    full_sel = jnp.concatenate([past_sel, new_sel], axis=1)
    win_rows = jnp.concatenate([past_win, new_win], axis=1)
    n_past_w = past_win.shape[1]
    n_pad = WINDOW - n_past_w
    win_full = jnp.pad(win_rows, ((0, 0), (n_pad, 0), (0, 0), (0, 0), (0, 0)))
    win_pos = jnp.concatenate([jnp.full((n_pad,), -1, jnp.int32),
                               jnp.arange(start - n_past_w, start + Sq, dtype=jnp.int32)])
    k_cmp = compress_tokens(full_cmp[:, :, 0], cmp_w1[0], cmp_pe[0], cmp_w2[0])
    v_cmp = compress_tokens(full_cmp[:, :, 1], cmp_w1[1], cmp_pe[1], cmp_w2[1])
    shared = (k_cmp, v_cmp, to_sel_blocks(full_sel[:, :, 0]), to_sel_blocks(full_sel[:, :, 1]),
              win_full[:, :, 0], win_full[:, :, 1])
    n_keep = min(WINDOW, win_rows.shape[1])
    return shared, win_pos, new_cmp, new_sel, win_rows[:, win_rows.shape[1] - n_keep:]


def softmax_masked(s, mask):
    p = jax.nn.softmax(jnp.where(mask, s, MASK_VALUE), axis=-1)
    return jnp.where(mask, p, 0.0)


def nsa_attend(q, gates, q_pos, shared, win_pos, rel_bias):
    k_cmp, v_cmp, k_sel, v_sel, k_win, v_win = shared
    f32 = jnp.float32
    Bn, Sq = q.shape[:2]
    n_cmp, n_sel = k_cmp.shape[1], k_sel.shape[1]
    qb = Q_BLOCK if Sq % Q_BLOCK == 0 else Sq
    nqb = Sq // qb
    top_n = min(SEL_TOPN, n_sel)
    win_len = WINDOW + qb
    scale = A_HEAD_DIM ** -0.5
    cmp_start = jnp.arange(n_cmp, dtype=jnp.int32) * CMP_STRIDE
    cmp_end = cmp_start + CMP_LEN - 1
    sel_start = jnp.arange(n_sel, dtype=jnp.int32) * SEL_BLOCK
    sel_idx = jnp.arange(n_sel, dtype=jnp.int32)
    overlap = ((cmp_start[:, None] < sel_start[None, :] + SEL_BLOCK)
               & (cmp_start[:, None] + CMP_LEN > sel_start[None, :])).astype(f32)
    bias_hgr = rel_bias.astype(f32).reshape(N_BUCKETS, A_N_KV, A_GROUP)
    bias_g = bias_hgr.transpose(1, 0, 2)
    g_idx = jnp.arange(A_N_KV)

    def per_block(args, kc, vc, ksg, vsg, kw, vw):
        qq, gg, pos, s0 = args
        s_c = jnp.einsum('qgrd,cgd->qgrc', qq, kc).astype(f32) * scale
        s_c = s_c + bias_hgr[rel_bucket(pos[:, None] - cmp_end[None, :])].transpose(0, 2, 3, 1)
        m_c = (cmp_end[None, :] <= pos[:, None])[:, None, None, :]
        p_c = softmax_masked(s_c, m_c)
        o_c = jnp.einsum('qgrc,cgd->qgrd', p_c.astype(vc.dtype), vc)
        imp = jnp.einsum('qgrc,cs->qgs', p_c, overlap)
        blk = pos // SEL_BLOCK
        valid = sel_start[None, :] <= pos[:, None]
        forced = (sel_idx[None, :] == 0) | (sel_idx[None, :] == blk[:, None]) | (sel_idx[None, :] == blk[:, None] - 1)
        score = jnp.where(valid[:, None, :], imp + jnp.where(forced, FORCE_SCORE, 0.0)[:, None, :], -1.0)
        _, idx = lax.top_k(score, top_n)
        kg = ksg[g_idx[None, :, None], idx]
        vg = vsg[g_idx[None, :, None], idx]
        k_pos = idx[..., None] * SEL_BLOCK + jnp.arange(SEL_BLOCK, dtype=jnp.int32)
        s_s = jnp.einsum('qgrd,qgkld->qgrkl', qq, kg).astype(f32) * scale
        b_s = bias_g[g_idx[None, :, None, None], rel_bucket(pos[:, None, None, None] - k_pos)]
        s_s = s_s + b_s.transpose(0, 1, 4, 2, 3)
        m_s = (k_pos <= pos[:, None, None, None])[:, :, None]
        p_s = softmax_masked(s_s.reshape(qb, A_N_KV, A_GROUP, -1), m_s.reshape(qb, A_N_KV, 1, -1))
        o_s = jnp.einsum('qgrm,qgmd->qgrd', p_s.astype(vg.dtype), vg.reshape(qb, A_N_KV, -1, A_HEAD_DIM))
        kwb = lax.dynamic_slice_in_dim(kw, s0, win_len, axis=0)
        vwb = lax.dynamic_slice_in_dim(vw, s0, win_len, axis=0)
        wpos = lax.dynamic_slice_in_dim(win_pos, s0, win_len, axis=0)
        dist = pos[:, None] - wpos[None, :]
        s_w = jnp.einsum('qgrd,kgd->qgrk', qq, kwb).astype(f32) * scale
        s_w = s_w + bias_hgr[rel_bucket(dist)].transpose(0, 2, 3, 1)
        m_w = ((wpos[None, :] >= 0) & (dist >= 0) & (dist < WINDOW))[:, None, None, :]
        p_w = softmax_masked(s_w, m_w)
        o_w = jnp.einsum('qgrk,kgd->qgrd', p_w.astype(vwb.dtype), vwb)
        gf = gg.astype(f32)
        o = gf[..., 0:1] * o_c + gf[..., 1:2] * o_s + gf[..., 2:3] * o_w
        return o.reshape(qb, A_Q_DIM).astype(qq.dtype)

    def per_seq(args):
        qs, gs, kc, vc, ks, vs, kw, vw = args
        ksg = ks.transpose(2, 0, 1, 3)
        vsg = vs.transpose(2, 0, 1, 3)
        blocks = (qs.reshape(nqb, qb, A_N_KV, A_GROUP, A_HEAD_DIM),
                  gs.reshape(nqb, qb, A_N_KV, A_GROUP, 3),
                  q_pos.reshape(nqb, qb),
                  jnp.arange(nqb, dtype=jnp.int32) * qb)
        out = lax.map(lambda a: per_block(a, kc, vc, ksg, vsg, kw, vw), blocks)
        return out.reshape(Sq, A_Q_DIM)

    return lax.map(per_seq, (q, gates, k_cmp, v_cmp, k_sel, v_sel, k_win, v_win))


def nsa_mixer(h, q_pos, shared, win_pos, qg_w, o_w, rel_bias):
    Bn, Sq, _ = h.shape
    qg = h @ qg_w
    q = qg[..., :A_Q_DIM].reshape(Bn, Sq, A_N_HEADS, A_HEAD_DIM)
    gates = jax.nn.sigmoid(qg[..., A_Q_DIM:].astype(jnp.float32)).reshape(Bn, Sq, A_N_HEADS, 3)
    o = nsa_attend(q, gates, q_pos, shared, win_pos, rel_bias)
    return o @ o_w


def run_group(x, start, ssm0, conv0, past_cmp, past_sel, past_win, weights):
    (ln_g, ln_b, m_in_w, m_conv_w, m_conv_b, m_dt_bias, m_a_log, m_d, m_norm_w, m_out_w,
     kv_w, cmp_w1, cmp_pe, cmp_w2, q_w, o_w, rel_bias, mlp_w1, mlp_w2) = weights
    Bn, Sq, _ = x.shape
    q_pos = start + jnp.arange(Sq, dtype=jnp.int32)
    h = x
    new_ssm, new_conv = [], []
    for i in range(DEPTH):
        if i < N_A_LAYERS:
            mix, s_i, c_i = mamba_mixer(h, ssm0[i], conv0[i], m_in_w[i], m_conv_w[i], m_conv_b[i],
                                        m_dt_bias[i], m_a_log[i], m_d[i], m_norm_w[i], m_out_w[i])
            new_ssm.append(s_i)
            new_conv.append(c_i)
        else:
            if i == N_A_LAYERS:
                shared, win_pos, new_cmp, new_sel, new_win = shared_kv(
                    h, start, past_cmp, past_sel, past_win, kv_w, cmp_w1, cmp_pe, cmp_w2)
            j = i - N_A_LAYERS
            mix = nsa_mixer(h, q_pos, shared, win_pos, q_w[j], o_w[j], rel_bias)
        h = layer_norm(DN_ALPHA * h + mix, ln_g[i, 0], ln_b[i, 0])
        h = layer_norm(DN_ALPHA * h + sq_relu_mlp(h, mlp_w1[i], mlp_w2[i]), ln_g[i, 1], ln_b[i, 1])
    return h, jnp.stack(new_ssm), jnp.stack(new_conv), new_cmp, new_sel, new_win


def setup_inputs(seed: int = 0) -> dict:
    key = jax.random.key(seed)
    ks = jax.random.split(key, 28)
    f32 = jnp.float32

    def nrm(k, shape, scale):
        return jax.random.normal(k, shape, f32) * scale

    n_pages = PAST_LEN // PAGE_SIZE
    n_used = DEC_BATCH * n_pages
    n_phys = n_used + n_used // 4
    win_keep = min(WINDOW, PAST_LEN)
    kv_row = (2, A_N_KV, A_HEAD_DIM)
    page_table = jax.random.permutation(ks[7], n_phys)[:n_used].reshape(DEC_BATCH, n_pages).astype(jnp.int32)
    dt0 = jnp.exp(jax.random.uniform(ks[13], (N_A_LAYERS, M_N_HEADS), f32, math.log(1e-3), math.log(1e-1)))
    return {
        "x_prompt": nrm(ks[0], (BATCH, SEQ, D_MODEL), 1.0),
        "x_sample": nrm(ks[1], (DEC_BATCH, DEC_SEQ, D_MODEL), 1.0),
        "state_ssm": nrm(ks[2], (N_A_LAYERS, DEC_BATCH, M_N_HEADS, M_HEAD_DIM, M_D_STATE), 0.1),
        "state_conv": nrm(ks[3], (N_A_LAYERS, DEC_BATCH, M_CONV - 1, M_CONV_DIM), 1.0),
        "cache_cmp_kv": nrm(ks[4], (n_phys, PAGE_SIZE) + kv_row, 1.0),
        "cache_sel_kv": nrm(ks[5], (n_phys, PAGE_SIZE) + kv_row, 1.0),
        "cache_win_kv": nrm(ks[6], (DEC_BATCH, win_keep) + kv_row, 1.0),
        "page_table": page_table,
        "ln_g": 1.0 + nrm(ks[8], (DEPTH, 2, D_MODEL), 0.05),
        "ln_b": nrm(ks[9], (DEPTH, 2, D_MODEL), 0.02),
        "m_in_w": nrm(ks[10], (N_A_LAYERS, D_MODEL, M_IN_DIM), D_MODEL ** -0.5),
        "m_conv_w": nrm(ks[11], (N_A_LAYERS, M_CONV, M_CONV_DIM), M_CONV ** -0.5),
        "m_conv_b": nrm(ks[12], (N_A_LAYERS, M_CONV_DIM), 0.02),
        "m_dt_bias": dt0 + jnp.log(-jnp.expm1(-dt0)),
        "m_a_log": jnp.log(jax.random.uniform(ks[14], (N_A_LAYERS, M_N_HEADS), f32, 1.0, 16.0)),
        "m_d": 1.0 + nrm(ks[15], (N_A_LAYERS, M_N_HEADS), 0.1),
        "m_norm_w": 1.0 + nrm(ks[16], (N_A_LAYERS, M_D_INNER), 0.05),
        "m_out_w": nrm(ks[17], (N_A_LAYERS, M_D_INNER, D_MODEL), M_D_INNER ** -0.5 * DN_BETA),
        "kv_w": nrm(ks[18], (D_MODEL, 3 * 2 * A_N_KV * A_HEAD_DIM), D_MODEL ** -0.5),
        "cmp_w1": nrm(ks[19], (2, CMP_RATIO, CMP_STRIDE, A_HEAD_DIM, CMP_HIDDEN), (CMP_LEN * A_HEAD_DIM) ** -0.5),
        "cmp_pe": nrm(ks[20], (2, CMP_LEN, A_HEAD_DIM), 0.5),
        "cmp_w2": nrm(ks[21], (2, CMP_HIDDEN, A_HEAD_DIM), CMP_HIDDEN ** -0.5),
        "q_w": nrm(ks[22], (N_B_LAYERS, D_MODEL, A_Q_DIM + 3 * A_N_HEADS), D_MODEL ** -0.5),
        "o_w": nrm(ks[23], (N_B_LAYERS, A_Q_DIM, D_MODEL), A_Q_DIM ** -0.5 * DN_BETA),
        "rel_bias": nrm(ks[24], (N_BUCKETS, A_N_HEADS), 0.5),
        "mlp_w1": nrm(ks[25], (DEPTH, D_MODEL, D_FF), D_MODEL ** -0.5),
        "mlp_w2": nrm(ks[26], (DEPTH, D_FF, D_MODEL), D_FF ** -0.5 * DN_BETA),
    }


def reference(x_prompt, x_sample, state_ssm, state_conv, cache_cmp_kv, cache_sel_kv, cache_win_kv, page_table,
              ln_g, ln_b, m_in_w, m_conv_w, m_conv_b, m_dt_bias, m_a_log, m_d, m_norm_w, m_out_w,
              kv_w, cmp_w1, cmp_pe, cmp_w2, q_w, o_w, rel_bias, mlp_w1, mlp_w2):
    weights = (ln_g, ln_b, m_in_w, m_conv_w, m_conv_b, m_dt_bias, m_a_log, m_d, m_norm_w, m_out_w,
               kv_w, cmp_w1, cmp_pe, cmp_w2, q_w, o_w, rel_bias, mlp_w1, mlp_w2)
    kv_row = (2, A_N_KV, A_HEAD_DIM)
    empty_kv = jnp.zeros((BATCH, 0) + kv_row, cache_cmp_kv.dtype)
    y_prompt, p_ssm, p_conv, p_cmp, p_sel, p_win = run_group(
        x_prompt, 0,
        jnp.zeros((N_A_LAYERS, BATCH, M_N_HEADS, M_HEAD_DIM, M_D_STATE), state_ssm.dtype),
        jnp.zeros((N_A_LAYERS, BATCH, M_CONV - 1, M_CONV_DIM), state_conv.dtype),
        empty_kv, empty_kv, jnp.zeros((BATCH, 0) + kv_row, cache_win_kv.dtype), weights)
    n_pages = PAST_LEN // PAGE_SIZE
    past_cmp = cache_cmp_kv[page_table].reshape((DEC_BATCH, n_pages * PAGE_SIZE) + kv_row)
    past_sel = cache_sel_kv[page_table].reshape((DEC_BATCH, n_pages * PAGE_SIZE) + kv_row)
    y_sample, s_ssm, s_conv, s_cmp, s_sel, s_win = run_group(
        x_sample, PAST_LEN, state_ssm, state_conv, past_cmp, past_sel, cache_win_kv, weights)
    return (y_prompt, y_sample, p_ssm, p_conv, p_cmp, p_sel, p_win, s_ssm, s_conv, s_cmp, s_sel, s_win)
```

```cpp
#include <hip/hip_runtime.h>
#include <cstdio>
#include <cstdint>

#ifndef MK_N_LAUNCHES
#define MK_N_LAUNCHES 1
#endif

namespace cfg {
constexpr int DM = 1024, NPB = 8, SEQ = 2048, DB = 128, DS = 8, PAST = 2048, PAGE = 128, NPAGE = PAST / PAGE;
constexpr int MP = NPB * SEQ, MS = DB * DS, M = MP + MS;
constexpr int DFF = 4096, DIN = 2048, NH = 32, HD = 64, NG = 4, HPG = 8, DST = 128, CONVD = 3072, INDIM = 5152, INPAD = 5376, ZXW = 5120;
constexpr int AH = 16, AKV = 4, AGRP = 4, KVW = 1536, QGW = 1072, KVQN = 2816, KVROW = 512;
constexpr int NCMPROWS = (DB + NPB) * AKV * 128;
constexpr float LN_EPS = 1e-5f, RMS_EPS = 1e-5f;
constexpr float ALPHA = 1.4142135623730951f;
constexpr float LOG2E = 1.4426950408889634f;
constexpr float QSCALE = 0.125f * LOG2E;
constexpr size_t O_YP = 0, O_YS = O_YP + (size_t)MP * DM, O_PSSM = O_YS + (size_t)MS * DM, O_PCONV = O_PSSM + (size_t)NPB * NH * HD * DST,
                 O_PCMP = O_PCONV + (size_t)NPB * 3 * CONVD, O_PSEL = O_PCMP + (size_t)MP * KVROW, O_PWIN = O_PSEL + (size_t)MP * KVROW,
                 O_SSSM = O_PWIN + (size_t)NPB * 512 * KVROW, O_SCONV = O_SSSM + (size_t)DB * NH * HD * DST, O_SCMP = O_SCONV + (size_t)DB * 3 * CONVD,
                 O_SSEL = O_SCMP + (size_t)MS * KVROW, O_SWIN = O_SSEL + (size_t)MS * KVROW, O_END = O_SWIN + (size_t)DB * 512 * KVROW;
static_assert(O_END == 108208128ull, "output size");
constexpr size_t MiB = 1u << 20;
constexpr size_t al(size_t x) { return (x + MiB - 1) / MiB * MiB; }
constexpr size_t WS_CTL = 0, CTL_ZERO_BYTES = MiB;
constexpr size_t WS_WIN = MiB;
constexpr size_t WS_WOUT = WS_WIN + al((size_t)INPAD * DM * 2);
constexpr size_t WS_W1 = WS_WOUT + al((size_t)DM * DIN * 2);
constexpr size_t WS_W2 = WS_W1 + 2 * al((size_t)DFF * DM * 2);
constexpr size_t WS_WKVQ = WS_W2 + 2 * al((size_t)DFF * DM * 2);
constexpr size_t WS_WO = WS_WKVQ + al((size_t)KVQN * DM * 2);
constexpr size_t WS_WC1 = WS_WO + al((size_t)DM * DM * 2);
constexpr size_t WS_PEC = WS_WC1 + al((size_t)512 * 1024 * 2);
constexpr size_t WS_XB = WS_PEC + MiB;
constexpr size_t WS_ZX = WS_XB + al((size_t)M * DM * 2);
constexpr size_t WS_DT = WS_ZX + al((size_t)M * ZXW * 2);
constexpr size_t WS_YG = WS_DT + al((size_t)M * 32 * 4);
constexpr size_t WS_SSQ = WS_YG + al((size_t)M * DIN * 2);
constexpr size_t WS_YN = WS_SSQ + al((size_t)M * 32 * 4);
constexpr size_t WS_PRE = WS_YN + al((size_t)M * DIN * 2);
constexpr size_t WS_HA = WS_PRE + al((size_t)M * DM * 4);
constexpr size_t WS_HB = WS_HA + al((size_t)M * DM * 4);
constexpr size_t WS_HAB = WS_HB + al((size_t)M * DM * 4);
constexpr size_t WS_HBB = WS_HAB + al((size_t)M * DM * 2);
constexpr size_t WS_HFF = WS_HBB + al((size_t)M * DM * 2);
constexpr size_t WS_KVB = WS_HFF + al((size_t)M * DFF * 2);
constexpr size_t WS_QB = WS_KVB + al((size_t)M * KVW * 2);
constexpr size_t WS_GATES = WS_QB + al((size_t)M * DM * 2);
constexpr size_t WS_ACMP = WS_GATES + al((size_t)M * 48 * 4);
constexpr size_t WS_PCMP = WS_ACMP + al((size_t)2 * NCMPROWS * 1024 * 2);
constexpr size_t WS_KC = WS_PCMP + al((size_t)2 * NCMPROWS * 256 * 4);
constexpr size_t WS_VC = WS_KC + al((size_t)NCMPROWS * 64 * 2);
constexpr size_t WS_OB = WS_VC + al((size_t)NCMPROWS * 64 * 2);
constexpr size_t WS_END = WS_OB + al((size_t)M * DM * 2);
constexpr int CW_BAR = 4096;
constexpr int RING_BYTES = 131072, MISC_OFF = RING_BYTES + 320, LDS_BYTES = 147456;
}

#define GAS __attribute__((address_space(1)))
#define LAS __attribute__((address_space(3)))
typedef unsigned short bf16;
typedef unsigned v4u __attribute__((ext_vector_type(4)));
typedef unsigned v2u __attribute__((ext_vector_type(2)));
typedef float f32x4 __attribute__((ext_vector_type(4)));
#define LDS_WAIT() asm volatile("s_waitcnt lgkmcnt(0)" ::: "memory")
#define VM_WAIT() asm volatile("s_waitcnt vmcnt(0)" ::: "memory")
__device__ __forceinline__ unsigned f2bf(float f) { unsigned u = __builtin_bit_cast(unsigned, f); return (u + 0x7fffu + ((u >> 16) & 1u)) >> 16; }
__device__ __forceinline__ unsigned pk2(float lo, float hi) { return f2bf(lo) | (f2bf(hi) << 16); }
__device__ __forceinline__ float bf2f(unsigned short b) { return __builtin_bit_cast(float, ((unsigned)b) << 16); }
__device__ __forceinline__ float bflo(unsigned w) { return __builtin_bit_cast(float, w << 16); }
__device__ __forceinline__ float bfhi(unsigned w) { return __builtin_bit_cast(float, w & 0xffff0000u); }

namespace pg8 {
#define PG8_LAS __attribute__((address_space(3)))
typedef unsigned short bf16_t;
typedef short bf16x8 __attribute__((ext_vector_type(8)));
typedef float f32x4 __attribute__((ext_vector_type(4)));
typedef unsigned u32x4 __attribute__((ext_vector_type(4)));
constexpr int BM = 256, BK = 64, HALF = 128, HTB = HALF * BK * 2  , STAGE_BYTES = 8 * HTB, NXCD = 8, WGM = 8;

__host__ __device__ __forceinline__ int lds_byte(int r, int c) { const int st = (r >> 4) * 2 + (c >> 5), rr = r & 15, cc = c & 31, ob = rr * 64 + cc * 2; return st * 1024 + (ob ^ (((ob >> 9) & 1) << 5)); }
__host__ __device__ __forceinline__ void stage_rc(int b, int& R, int& C) { const int st = b / 1024, sb = b % 1024, swz = sb ^ (((sb >> 9) & 1) << 5); R = (st >> 1) * 16 + swz / 64; C = (st & 1) * 32 + (swz % 64) / 2; }
__host__ __device__ __forceinline__ int perm32(int rho) { const int n = rho >> 4, i = rho & 15; return 8 * (i >> 2) + 4 * n + (i & 3); }

struct Unit { int pm, pn; };
struct Gemm { const bf16_t* A; const bf16_t* Bt; int M, N, K; };

struct StaticOrder {
    int nM, nN, nwg, G, c;
    __host__ __device__ void init(int M, int N, int G_, int c_) { nM = M / BM; nN = N / BM; nwg = nM * nN; G = G_; c = c_; }
    __host__ __device__ bool next(int i, Unit& u) const {
        const long L = (long)i * G + c; if (L >= nwg) return false;
        int wgid = (int)L; { const int q = nwg / NXCD, r = nwg % NXCD, xcd = wgid % NXCD, off = wgid / NXCD; wgid = (xcd < r ? xcd * (q + 1) : r * (q + 1) + (xcd - r) * q) + off; }
        const int nig = WGM * nN, gid = wgid / nig, fm = gid * WGM, gsz = (nM - fm) < WGM ? (nM - fm) : WGM;
        u.pm = fm + ((wgid % nig) % gsz); u.pn = (wgid % nig) / gsz; return true;
    }
    __device__ __forceinline__ void a_ready(const Unit&) const {}
    __device__ __forceinline__ void done(const Unit&) const {}
};

__device__ __forceinline__ unsigned cvt_pk_bf16(float lo, float hi) { unsigned r; asm volatile("v_cvt_pk_bf16_f32 %0, %1, %2" : "=v"(r) : "v"(lo), "v"(hi)); return r; }
typedef unsigned u32x2 __attribute__((ext_vector_type(2)));

struct CmpOrder {
    int G, c;
    __device__ bool next(int i, Unit& u) const { const int L = i * G + c; if (L >= 544) return false; u.pm = L; u.pn = L >= 272 ? 1 : 0; return true; }
    __device__ __forceinline__ void a_ready(const Unit&) const {}
    __device__ __forceinline__ void done(const Unit&) const {}
};

struct EpiIn {
    static constexpr bool PERM = false, AFTER_DRAIN = false;
    bf16_t* ZX; float* DT; float* pconv; float* sconv;
    __device__ __forceinline__ void operator()(const f32x4 (&acc)[2][2][4][2], const Unit& u, int wr, int wc, int fr, int fq) const {
        const int colt = u.pn * BM + wc * 32 + 4 * fq;
#pragma unroll
        for (int ai = 0; ai < 2; ++ai)
#pragma unroll
            for (int m = 0; m < 4; ++m) {
                const int row = u.pm * BM + ai * HALF + wr * 64 + m * 16 + fr;
                float* cptr = nullptr;
                if (row < cfg::MP) { const int t = row & 2047; if (t >= 2045) cptr = pconv + (size_t)((row >> 11) * 3 + (t - 2045)) * cfg::CONVD; }
                else { const int sr = row - cfg::MP, t = sr & 7; if (t >= 5) cptr = sconv + (size_t)((sr >> 3) * 3 + (t - 5)) * cfg::CONVD; }
#pragma unroll
                for (int bj = 0; bj < 2; ++bj)
#pragma unroll
                    for (int n = 0; n < 2; ++n) {
                        const int col = colt + bj * HALF + n * 16; const f32x4 v = acc[ai][bj][m][n];
                        if (col < cfg::ZXW) {
                            u32x2 w; w.x = cvt_pk_bf16(v[0], v[1]); w.y = cvt_pk_bf16(v[2], v[3]);
                            *(u32x2*)(ZX + (size_t)row * cfg::ZXW + col) = w;
                            if (cptr && col >= cfg::DIN) *(f32x4*)(cptr + (col - cfg::DIN)) = v;
                        } else if (col < cfg::INDIM) *(f32x4*)(DT + (size_t)row * 32 + (col - cfg::ZXW)) = v;
                    }
            }
    }
};
struct EpiRes {
    static constexpr bool PERM = false, AFTER_DRAIN = false;
    float* out; const float* resA; const float* resB;
    __device__ __forceinline__ void operator()(const f32x4 (&acc)[2][2][4][2], const Unit& u, int wr, int wc, int fr, int fq) const {
        const int colt = u.pn * BM + wc * 32 + 4 * fq;
#pragma unroll
        for (int ai = 0; ai < 2; ++ai)
#pragma unroll
            for (int m = 0; m < 4; ++m) {
                const int row = u.pm * BM + ai * HALF + wr * 64 + m * 16 + fr;
                const float* rp = (row < cfg::MP ? resA : resB) + (size_t)row * cfg::DM + colt; float* op = out + (size_t)row * cfg::DM + colt;
#pragma unroll
                for (int bj = 0; bj < 2; ++bj)
#pragma unroll
                    for (int n = 0; n < 2; ++n) { const f32x4 r = *(const f32x4*)(rp + bj * HALF + n * 16); *(f32x4*)(op + bj * HALF + n * 16) = acc[ai][bj][m][n] + r * cfg::ALPHA; }
            }
    }
};
struct EpiRelu2 {
    static constexpr bool PERM = true, AFTER_DRAIN = false;
    bf16_t* O;
    __device__ __forceinline__ void operator()(const f32x4 (&acc)[2][2][4][2], const Unit& u, int wr, int wc, int fr, int fq) const {
        const int col0 = u.pn * BM + wc * 32 + 8 * fq;
#pragma unroll
        for (int ai = 0; ai < 2; ++ai)
#pragma unroll
            for (int m = 0; m < 4; ++m) { bf16_t* rowp = O + (size_t)(u.pm * BM + ai * HALF + wr * 64 + m * 16 + fr) * cfg::DFF + col0;
#pragma unroll
                for (int bj = 0; bj < 2; ++bj) { f32x4 v0 = acc[ai][bj][m][0], v1 = acc[ai][bj][m][1];
#pragma unroll
                    for (int j = 0; j < 4; ++j) { const float a = fmaxf(v0[j], 0.f), b = fmaxf(v1[j], 0.f); v0[j] = a * a; v1[j] = b * b; }
                    u32x4 w; w.x = cvt_pk_bf16(v0[0], v0[1]); w.y = cvt_pk_bf16(v0[2], v0[3]); w.z = cvt_pk_bf16(v1[0], v1[1]); w.w = cvt_pk_bf16(v1[2], v1[3]);
                    *(u32x4*)(rowp + bj * HALF) = w; } }
    }
};
struct EpiKvq {
    static constexpr bool PERM = false, AFTER_DRAIN = false;
    float* out; bf16_t* KVB; bf16_t* QB; float* GATES; bf16_t* ACMP;
    __device__ __forceinline__ void operator()(const f32x4 (&acc)[2][2][4][2], const Unit& u, int wr, int wc, int fr, int fq) const {
        const int colt = u.pn * BM + wc * 32 + 4 * fq;
#pragma unroll
        for (int ai = 0; ai < 2; ++ai)
#pragma unroll
            for (int m = 0; m < 4; ++m) {
                const int row = u.pm * BM + ai * HALF + wr * 64 + m * 16 + fr;
                const bool prompt = row < cfg::MP; const int sr = row - cfg::MP;
                const int b = prompt ? (row >> 11) : (sr >> 3), t = prompt ? (row & 2047) : (sr & 7);
#pragma unroll
                for (int bj = 0; bj < 2; ++bj)
#pragma unroll
                    for (int n = 0; n < 2; ++n) {
                        const int col = colt + bj * HALF + n * 16; const f32x4 v = acc[ai][bj][m][n];
                        if (col < cfg::KVW) {
                            const int br = col >> 9, cc = col & 511;
                            float* dst = nullptr;
                            if (prompt) { if (br == 0) dst = out + cfg::O_PCMP + (size_t)row * 512 + cc; else if (br == 1) dst = out + cfg::O_PSEL + (size_t)row * 512 + cc;
                                          else if (t >= 1536) dst = out + cfg::O_PWIN + (size_t)(b * 512 + t - 1536) * 512 + cc; }
                            else { if (br == 0) dst = out + cfg::O_SCMP + (size_t)sr * 512 + cc; else if (br == 1) dst = out + cfg::O_SSEL + (size_t)sr * 512 + cc;
                                   else dst = out + cfg::O_SWIN + (size_t)(b * 512 + 504 + t) * 512 + cc; }
                            if (dst) *(f32x4*)dst = v;
                            u32x2 w; w.x = cvt_pk_bf16(v[0], v[1]); w.y = cvt_pk_bf16(v[2], v[3]);
                            *(u32x2*)(KVB + (size_t)row * cfg::KVW + col) = w;
                            if (prompt && br == 0) { const int kv = cc >> 8, g = (cc >> 6) & 3, d = cc & 63;
                                *(u32x2*)(ACMP + ((size_t)kv * cfg::NCMPROWS + 65536 + (size_t)(b * 4 + g) * 128 + (t >> 4)) * 1024 + (t & 15) * 64 + d) = w; }
                        } else if (col < cfg::KVW + 1024) {
                            u32x2 w; w.x = cvt_pk_bf16(v[0] * cfg::QSCALE, v[1] * cfg::QSCALE); w.y = cvt_pk_bf16(v[2] * cfg::QSCALE, v[3] * cfg::QSCALE);
                            *(u32x2*)(QB + (size_t)row * cfg::DM + (col - cfg::KVW)) = w;
                        } else if (col < cfg::KVW + cfg::QGW) {
                            f32x4 s;
#pragma unroll
                            for (int j = 0; j < 4; ++j) s[j] = 1.f / (1.f + __expf(-v[j]));
                            *(f32x4*)(GATES + (size_t)row * 48 + (col - cfg::KVW - 1024)) = s;
                        }
                    }
            }
    }
};
struct EpiP {
    static constexpr bool PERM = false, AFTER_DRAIN = false;
    float* P;
    __device__ __forceinline__ void operator()(const f32x4 (&acc)[2][2][4][2], const Unit& u, int wr, int wc, int fr, int fq) const {
        const int colt = wc * 32 + 4 * fq;
#pragma unroll
        for (int ai = 0; ai < 2; ++ai)
#pragma unroll
            for (int m = 0; m < 4; ++m) { float* op = P + (size_t)(u.pm * BM + ai * HALF + wr * 64 + m * 16 + fr) * 256 + colt;
#pragma unroll
                for (int bj = 0; bj < 2; ++bj)
#pragma unroll
                    for (int n = 0; n < 2; ++n) *(f32x4*)(op + bj * HALF + n * 16) = acc[ai][bj][m][n]; }
    }
};

template <class Epi, class Sched, bool ALIGN_EPI = false, bool SP2 = false>
__device__ __forceinline__ void gemm_phase(PG8_LAS unsigned char* lds, const Gemm g, const Sched& S, const Epi& E) {
    const int tid = threadIdx.x, wid = __builtin_amdgcn_readfirstlane(tid >> 6), lane = tid & 63, wr = wid >> 2, wc = wid & 3, fr = lane & 15, fq = lane >> 4;
    const int K = g.K, nt = K / BK;
    unsigned voffA[2], voffB[2];
#pragma unroll
    for (int i = 0; i < 2; ++i) { int R, C; stage_rc(tid * 16 + i * 8192, R, C); const int Rb = Epi::PERM ? ((R & ~31) + perm32(R & 31)) : R;
        voffA[i] = (unsigned)(R * K + C) * 2u; voffB[i] = (unsigned)(Rb * K + C) * 2u; }
    const size_t kstep = (size_t)(BK * 2);
    const size_t hstep = (size_t)HALF * K * 2;
    const size_t tstep = 2 * hstep;
    const unsigned ldsw = (unsigned)wid * 1024u;
    const int aoff = lds_byte(wr * 64 + fr, fq * 8), boff = lds_byte(wc * 32 + fr, fq * 8);
#define PG8_SA(b, h) (((b) * 2 + (h)) * HTB)
#define PG8_SB(b, h) ((4 + (b) * 2 + (h)) * HTB)
#define PG8_STAGE(bufoff, gbase, voff) do { _Pragma("unroll") for (int _i = 0; _i < 2; ++_i) \
        __builtin_amdgcn_global_load_lds((const unsigned*)((const char*)(gbase) + (voff)[_i]), (PG8_LAS unsigned*)(lds + (bufoff) + ldsw + _i * 8192), 16, 0, 0); } while (0)
#define PG8_LDA(dst, b, h) do { _Pragma("unroll") for (int m = 0; m < 4; ++m) _Pragma("unroll") for (int k = 0; k < 2; ++k) dst[m][k] = *(const PG8_LAS bf16x8*)(lds + PG8_SA(b, h) + aoff + m * 2048 + k * 1024); } while (0)
#define PG8_LDB(dst, b, h) do { _Pragma("unroll") for (int n = 0; n < 2; ++n) _Pragma("unroll") for (int k = 0; k < 2; ++k) dst[n][k] = *(const PG8_LAS bf16x8*)(lds + PG8_SB(b, h) + boff + n * 2048 + k * 1024); } while (0)
#define PG8_MMA(ai, bj, At, Bt) do { __builtin_amdgcn_s_setprio(1); _Pragma("unroll") for (int m = 0; m < 4; ++m) _Pragma("unroll") for (int n = 0; n < 2; ++n) _Pragma("unroll") for (int k = 0; k < 2; ++k) \
        acc[ai][bj][m][n] = __builtin_amdgcn_mfma_f32_16x16x32_bf16(Bt[n][k], At[m][k], acc[ai][bj][m][n], 0, 0, 0); __builtin_amdgcn_s_setprio(0); } while (0)
#define PG8_WAIT_V(n) asm volatile("s_waitcnt vmcnt(" #n ")" ::: "memory")
#define PG8_WAIT_L(n) asm volatile("s_waitcnt lgkmcnt(" #n ")" ::: "memory")
#define PG8_BAR __builtin_amdgcn_s_barrier()
#define PG8_SCHED __builtin_amdgcn_sched_barrier(0)
    Unit cur, nxt; int ui = 0;
    if (!S.next(0, cur)) return;
    f32x4 acc[2][2][4][2];
#pragma unroll
    for (int a = 0; a < 2; ++a)
#pragma unroll
        for (int b = 0; b < 2; ++b)
#pragma unroll
            for (int m = 0; m < 4; ++m)
#pragma unroll
                for (int n = 0; n < 2; ++n) acc[a][b][m][n] = (f32x4){0.f, 0.f, 0.f, 0.f};
    bf16x8 At[4][2], B0[2][2], B1[2][2];
    const char* cA = (const char*)g.A + (size_t)cur.pm * tstep; const char* cB = (const char*)g.Bt + (size_t)cur.pn * tstep;
    S.a_ready(cur);
    if constexpr (SP2) {
        PG8_STAGE(PG8_SB(0, 0), cB, voffB); PG8_STAGE(PG8_SB(0, 1), cB + hstep, voffB); PG8_STAGE(PG8_SA(0, 0), cA, voffA); PG8_STAGE(PG8_SA(0, 1), cA + hstep, voffA);
        if (wr == 1) PG8_BAR;
        PG8_WAIT_V(2); PG8_BAR;
        PG8_STAGE(PG8_SB(1, 0), cB + kstep, voffB); PG8_STAGE(PG8_SA(1, 0), cA + kstep, voffA); PG8_STAGE(PG8_SB(1, 1), cB + hstep + kstep, voffB);
        PG8_WAIT_V(6); PG8_BAR;
    } else {
        PG8_STAGE(PG8_SB(0, 0), cB, voffB); PG8_STAGE(PG8_SA(0, 0), cA, voffA); PG8_STAGE(PG8_SB(0, 1), cB + hstep, voffB); PG8_STAGE(PG8_SA(0, 1), cA + hstep, voffA);
        if (wr == 1) PG8_BAR;
        PG8_WAIT_V(4); PG8_BAR;
        PG8_STAGE(PG8_SB(1, 0), cB + kstep, voffB); PG8_STAGE(PG8_SA(1, 0), cA + kstep, voffA); PG8_STAGE(PG8_SB(1, 1), cB + hstep + kstep, voffB);
        PG8_WAIT_V(6); PG8_BAR;
    }
    for (;;) {
        const bool has_next = S.next(ui + 1, nxt);
        const char* nA = has_next ? (const char*)g.A + (size_t)nxt.pm * tstep : cA; const char* nB = has_next ? (const char*)g.Bt + (size_t)nxt.pn * tstep : cB;
        for (int t = 0; t < nt; t += 2) {
            const bool last = (t == nt - 2);
            const char* a1 = cA + (size_t)(t + 1) * kstep;
            const char* a2 = last ? nA : cA + (size_t)(t + 2) * kstep; const char* b2 = last ? nB : cB + (size_t)(t + 2) * kstep;
            const char* a3 = a2 + kstep; const char* b3 = b2 + kstep;
            if (last && has_next) S.a_ready(nxt);
            if constexpr (SP2) {
            PG8_LDB(B0, 0, 0); PG8_LDB(B1, 0, 1); PG8_SCHED; PG8_LDA(At, 0, 0); PG8_STAGE(PG8_SA(1, 1), a1 + hstep, voffA);
            PG8_WAIT_V(8); PG8_WAIT_L(0); PG8_BAR; PG8_MMA(0, 0, At, B0); PG8_MMA(0, 1, At, B1); PG8_BAR; PG8_SCHED;
            PG8_LDA(At, 0, 1); PG8_STAGE(PG8_SB(0, 0), b2, voffB); PG8_STAGE(PG8_SB(0, 1), b2 + hstep, voffB); PG8_STAGE(PG8_SA(0, 0), a2, voffA);
            PG8_WAIT_V(8); PG8_WAIT_L(0); PG8_BAR; PG8_MMA(1, 0, At, B0); PG8_MMA(1, 1, At, B1); PG8_BAR; PG8_SCHED;
            PG8_LDB(B0, 1, 0); PG8_LDB(B1, 1, 1); PG8_SCHED; PG8_LDA(At, 1, 0); PG8_STAGE(PG8_SA(0, 1), a2 + hstep, voffA);
            PG8_WAIT_V(8); PG8_WAIT_L(0); PG8_BAR; PG8_MMA(0, 0, At, B0); PG8_MMA(0, 1, At, B1); PG8_BAR; PG8_SCHED;
            PG8_LDA(At, 1, 1); PG8_STAGE(PG8_SB(1, 0), b3, voffB); PG8_STAGE(PG8_SB(1, 1), b3 + hstep, voffB); PG8_STAGE(PG8_SA(1, 0), a3, voffA);
            PG8_WAIT_V(8); PG8_WAIT_L(0); PG8_BAR; PG8_MMA(1, 0, At, B0); PG8_MMA(1, 1, At, B1); PG8_BAR; PG8_SCHED;
            } else {
            PG8_LDB(B0, 0, 0); PG8_SCHED; PG8_LDA(At, 0, 0); PG8_STAGE(PG8_SA(1, 1), a1 + hstep, voffA);
            PG8_WAIT_L(8); PG8_BAR; PG8_WAIT_L(0); PG8_MMA(0, 0, At, B0); PG8_BAR; PG8_SCHED;
            PG8_LDB(B1, 0, 1); PG8_STAGE(PG8_SB(0, 0), b2, voffB);
            PG8_BAR; PG8_WAIT_L(0); PG8_MMA(0, 1, At, B1); PG8_BAR;
            PG8_LDA(At, 0, 1); PG8_STAGE(PG8_SA(0, 0), a2, voffA);
            PG8_BAR; PG8_WAIT_L(0); PG8_MMA(1, 0, At, B0); PG8_BAR; PG8_SCHED;
            PG8_STAGE(PG8_SB(0, 1), b2 + hstep, voffB);
            PG8_WAIT_V(6); PG8_BAR; PG8_MMA(1, 1, At, B1); PG8_BAR;
            PG8_LDB(B0, 1, 0); PG8_SCHED; PG8_LDA(At, 1, 0); PG8_STAGE(PG8_SA(0, 1), a2 + hstep, voffA);
            PG8_WAIT_L(8); PG8_BAR; PG8_WAIT_L(0); PG8_MMA(0, 0, At, B0); PG8_BAR; PG8_SCHED;
            PG8_LDB(B1, 1, 1); PG8_STAGE(PG8_SB(1, 0), b3, voffB);
            PG8_BAR; PG8_WAIT_L(0); PG8_MMA(0, 1, At, B1); PG8_BAR;
            PG8_LDA(At, 1, 1); PG8_STAGE(PG8_SA(1, 0), a3, voffA);
            PG8_BAR; PG8_WAIT_L(0); PG8_MMA(1, 0, At, B0); PG8_BAR; PG8_SCHED;
            PG8_STAGE(PG8_SB(1, 1), b3 + hstep, voffB);
            PG8_WAIT_V(6); PG8_BAR; PG8_MMA(1, 1, At, B1); PG8_BAR;
            }
        }
        if constexpr (ALIGN_EPI) { if (wr == 0) PG8_BAR; }
        if constexpr (!Epi::AFTER_DRAIN) { E(acc, cur, wr, wc, fr, fq); S.done(cur); }
        if (!has_next) break;
#pragma unroll
        for (int a = 0; a < 2; ++a)
#pragma unroll
            for (int b = 0; b < 2; ++b)
#pragma unroll
                for (int m = 0; m < 4; ++m)
#pragma unroll
                    for (int n = 0; n < 2; ++n) acc[a][b][m][n] = (f32x4){0.f, 0.f, 0.f, 0.f};
        cur = nxt; cA = nA; cB = nB; ++ui;
        if constexpr (ALIGN_EPI) { if (wr == 1) PG8_BAR; }
    }
    PG8_WAIT_V(0);
    if constexpr (!ALIGN_EPI) { if (wr == 0) PG8_BAR; }
    PG8_BAR;
    if constexpr (Epi::AFTER_DRAIN) { E.fused(acc, cur, wr, wc, fr, fq, lds, wid, lane); S.done(cur); }
#undef PG8_SA
#undef PG8_SB
#undef PG8_STAGE
#undef PG8_LDA
#undef PG8_LDB
#undef PG8_MMA
#undef PG8_WAIT_V
#undef PG8_WAIT_L
#undef PG8_BAR
#undef PG8_SCHED
}
}
#define XB_TMO      128
#define XB_XCNT(j)  (256  + 64 * (j))
#define XB_XSUB(j)  (1280 + 64 * (j))
#define XB_XGEN(j)  (2304 + 64 * (j))
#define XB_TOP      3328
#define XB_TOPGEN   3392
#define XCD_BAR_WORDS 3456
#define XB_SPIN_CAP (1u << 18)

__device__ __forceinline__ unsigned xb_ld(unsigned* p)              { return __hip_atomic_load(p, __ATOMIC_RELAXED, __HIP_MEMORY_SCOPE_AGENT); }
__device__ __forceinline__ unsigned xb_add(unsigned* p, unsigned v) { return __hip_atomic_fetch_add(p, v, __ATOMIC_RELAXED, __HIP_MEMORY_SCOPE_AGENT); }
__device__ __forceinline__ unsigned xb_xcc_id() { return (unsigned)__builtin_amdgcn_s_getreg((3 << 11) | 20) & 0xFu; }
#define XB_SPIN(cond, bar) do { unsigned _sp = 0; while (cond) { __builtin_amdgcn_s_sleep(1); \
    if ((++_sp & 255u) == 0u) { if (xb_ld(&(bar)[XB_TMO])) break; if (_sp > XB_SPIN_CAP) { atomicAdd(&(bar)[XB_TMO], 1u); break; } } } } while (0)

struct XcdBarrier {
    unsigned* bar; unsigned x;
    volatile LAS unsigned* st;
};

__device__ __forceinline__ XcdBarrier xcd_barrier_post(unsigned* bar, volatile LAS unsigned* st) {
    XcdBarrier b; b.bar = bar; b.x = xb_xcc_id(); b.st = st;
    if (threadIdx.x == 0) (void)xb_add(&bar[XB_XCNT(b.x)], 1u);
    return b;
}
__device__ __forceinline__ void xcd_barrier_complete(unsigned* bar, unsigned x, unsigned& nloc, unsigned& nx) {
    const unsigned G = gridDim.x * gridDim.y * gridDim.z;
    unsigned sum, cnt, mine, sp = 0u;
    for (;;) {
        sum = 0u; cnt = 0u; mine = 0u;
#pragma unroll
        for (unsigned j = 0; j < 16; ++j) { const unsigned c = xb_ld(&bar[XB_XCNT(j)]); sum += c; cnt += (c > 0u) ? 1u : 0u; mine = (j == x) ? c : mine; }
        if (sum == G) break;
        __builtin_amdgcn_s_sleep(1);
        if ((++sp & 255u) == 0u) { if (xb_ld(&bar[XB_TMO])) break; if (sp > XB_SPIN_CAP) { atomicAdd(&bar[XB_TMO], 1u); break; } }
    }
    nloc = mine > 0u ? mine : 1u; nx = cnt > 0u ? cnt : 1u;
}

__device__ __forceinline__ void xcd_barrier(const XcdBarrier& b) {
    asm volatile("s_waitcnt vmcnt(0)" ::: "memory");
    __syncthreads();
    if (threadIdx.x == 0) {
        unsigned* bar = b.bar;
        __builtin_amdgcn_s_waitcnt(0);
        unsigned nloc = b.st[0], nx = b.st[1];
        if (nloc == 0u) { xcd_barrier_complete(bar, b.x, nloc, nx); b.st[0] = nloc; b.st[1] = nx; }
        const unsigned old = xb_add(&bar[XB_XSUB(b.x)], 1u);
        const unsigned gen = old / nloc;
        if (old + 1u == (gen + 1u) * nloc) {
            __builtin_amdgcn_fence(__ATOMIC_RELEASE, "agent");
            asm volatile("s_waitcnt vmcnt(0)" ::: "memory");
            const unsigned og = xb_add(&bar[XB_TOP], 1u);
            const unsigned tg = og / nx;
            if (og + 1u == (tg + 1u) * nx) xb_add(&bar[XB_TOPGEN], 1u);
            else XB_SPIN(xb_ld(&bar[XB_TOPGEN]) == tg, bar);
            __builtin_amdgcn_fence(__ATOMIC_ACQUIRE, "agent");
            xb_add(&bar[XB_XGEN(b.x)], 1u);
            asm volatile("s_waitcnt vmcnt(0)" ::: "memory");
        } else {
            XB_SPIN(xb_ld(&bar[XB_XGEN(b.x)]) == gen, bar);
            __builtin_amdgcn_fence(__ATOMIC_ACQUIRE, "agent");
            asm volatile("s_waitcnt vmcnt(0)" ::: "memory");
        }
    }
    __syncthreads();
}

constexpr int NWAVES = 8, NTHR = 512;
__device__ __forceinline__ float wave_sum(float v) {
#pragma unroll
    for (int o = 1; o < 64; o <<= 1) v += __shfl_xor(v, o);
    return v;
}
__device__ __forceinline__ float silu_f(float v) { return v / (1.f + __expf(-v)); }

__device__ __forceinline__ void tr_item(const float* __restrict__ W, int N, bf16* WT, int ldk, int row_off, const float* __restrict__ kscale, LAS float* scr, int item, int lane) {
    const int nblk = (N + 31) >> 5, kb = item / nblk, nb = item - kb * nblk, k0 = 64 * kb, n0 = 32 * nb;
    const int nn = n0 + (lane & 31);
#pragma unroll 8
    for (int i = 0; i < 32; ++i) { const int kk = 2 * i + (lane >> 5); float v = (nn < N) ? W[(size_t)(k0 + kk) * N + nn] : 0.f; if (kscale) v *= kscale[k0 + kk]; scr[kk * 33 + (lane & 31)] = v; }
    LDS_WAIT();
    const int c = lane & 7;
#pragma unroll
    for (int j = 0; j < 4; ++j) { const int n = (lane >> 3) + 8 * j; const LAS float* s = scr + (8 * c) * 33 + n;
        v4u o; o.x = pk2(s[0 * 33], s[1 * 33]); o.y = pk2(s[2 * 33], s[3 * 33]); o.z = pk2(s[4 * 33], s[5 * 33]); o.w = pk2(s[6 * 33], s[7 * 33]);
        if (n0 + n < N) *(v4u*)(WT + (size_t)(row_off + n0 + n) * ldk + k0 + 8 * c) = o; }
    LDS_WAIT();
}

struct Args {
    const float* x_prompt; const float* x_sample; const float* state_ssm; const float* state_conv; const float* cache_cmp; const float* cache_sel; const float* cache_win; const int* page_table;
    const float* ln_g; const float* ln_b; const float* m_in_w; const float* m_conv_w; const float* m_conv_b; const float* m_dt_bias; const float* m_a_log; const float* m_d; const float* m_norm_w; const float* m_out_w;
    const float* kv_w; const float* cmp_w1; const float* cmp_pe; const float* cmp_w2; const float* q_w; const float* o_w; const float* rel_bias; const float* mlp_w1; const float* mlp_w2;
    float* out; unsigned char* ws; int ph_lo, ph_hi, li, pad;
};

__device__ __forceinline__ void p0_prologue(const Args& a, LAS unsigned char* lds, int G) {
    using namespace cfg;
    const int tid = threadIdx.x, lane = tid & 63, wave = tid >> 6;
    LAS float* scr = (LAS float*)(lds + wave * 16384);
    unsigned char* ws = a.ws;
    const int gw = blockIdx.x * NWAVES + wave, NGW = G * NWAVES;
    constexpr int I_IN = 16 * 161, I_OUT = 32 * 32, I_W1 = 16 * 128, I_W2 = 64 * 32, I_KV = 16 * 48, I_Q = 16 * 34, I_O = 16 * 32, I_C = 16 * 4;
    constexpr int NIT = I_IN + I_OUT + 2 * I_W1 + 2 * I_W2 + I_KV + I_Q + I_O + 4 * I_C;
    for (int it = gw; it < NIT; it += NGW) {
        int r = it;
        if (r < I_IN) { tr_item(a.m_in_w, INDIM, (bf16*)(ws + WS_WIN), DM, 0, nullptr, scr, r, lane); continue; } r -= I_IN;
        if (r < I_OUT) { tr_item(a.m_out_w, DM, (bf16*)(ws + WS_WOUT), DIN, 0, a.m_norm_w, scr, r, lane); continue; } r -= I_OUT;
        if (r < 2 * I_W1) { const int l = r / I_W1; tr_item(a.mlp_w1 + (size_t)l * DM * DFF, DFF, (bf16*)(ws + WS_W1) + (size_t)l * DFF * DM, DM, 0, nullptr, scr, r - l * I_W1, lane); continue; } r -= 2 * I_W1;
        if (r < 2 * I_W2) { const int l = r / I_W2; tr_item(a.mlp_w2 + (size_t)l * DM * DFF, DM, (bf16*)(ws + WS_W2) + (size_t)l * DFF * DM, DFF, 0, nullptr, scr, r - l * I_W2, lane); continue; } r -= 2 * I_W2;
        if (r < I_KV) { tr_item(a.kv_w, KVW, (bf16*)(ws + WS_WKVQ), DM, 0, nullptr, scr, r, lane); continue; } r -= I_KV;
        if (r < I_Q) { tr_item(a.q_w, QGW, (bf16*)(ws + WS_WKVQ), DM, KVW, nullptr, scr, r, lane); continue; } r -= I_Q;
        if (r < I_O) { tr_item(a.o_w, DM, (bf16*)(ws + WS_WO), DM, 0, nullptr, scr, r, lane); continue; } r -= I_O;
        { const int q = r / I_C; tr_item(a.cmp_w1 + (size_t)q * 1024 * 128, 128, (bf16*)(ws + WS_WC1), 1024, q * 128, nullptr, scr, r - q * I_C, lane); }
    }
    const size_t gt = (size_t)blockIdx.x * NTHR + tid, NT = (size_t)G * NTHR;
    { v4u z = {0u, 0u, 0u, 0u};
      v4u* p1 = (v4u*)((bf16*)(ws + WS_WIN) + (size_t)INDIM * DM); for (size_t i = gt; i < (size_t)(INPAD - INDIM) * DM / 8; i += NT) p1[i] = z;
      v4u* p2 = (v4u*)((bf16*)(ws + WS_WKVQ) + (size_t)(KVW + QGW) * DM); for (size_t i = gt; i < (size_t)(KVQN - KVW - QGW) * DM / 8; i += NT) p2[i] = z; }
    { v4u* xb = (v4u*)(ws + WS_XB);
      for (size_t i = gt; i < (size_t)M * DM / 8; i += NT) { const size_t e = i * 8; const float* src = e < (size_t)MP * DM ? a.x_prompt + e : a.x_sample + (e - (size_t)MP * DM);
          const f32x4 v0 = *(const f32x4*)src, v1 = *(const f32x4*)(src + 4); v4u o; o.x = pk2(v0[0], v0[1]); o.y = pk2(v0[2], v0[3]); o.z = pk2(v1[0], v1[1]); o.w = pk2(v1[2], v1[3]); xb[i] = o; } }
    { bf16* ac = (bf16*)(ws + WS_ACMP);
      for (size_t i = gt; i < (size_t)DB * PAST * 64; i += NT) { const int ch = (int)(i & 63); const size_t tok = i >> 6; const int b = (int)(tok >> 11), t = (int)(tok & 2047);
          const int page = a.page_table[b * NPAGE + (t >> 7)]; const float* src = a.cache_cmp + ((size_t)page * PAGE + (t & 127)) * 512 + ch * 8;
          const f32x4 v0 = *(const f32x4*)src, v1 = *(const f32x4*)(src + 4); v4u o; o.x = pk2(v0[0], v0[1]); o.y = pk2(v0[2], v0[3]); o.z = pk2(v1[0], v1[1]); o.w = pk2(v1[2], v1[3]);
          const int kv = ch >> 5, g = (ch >> 3) & 3, d0 = (ch & 7) * 8;
          *(v4u*)(ac + ((size_t)kv * NCMPROWS + (size_t)(b * 4 + g) * 128 + (t >> 4)) * 1024 + (t & 15) * 64 + d0) = o; } }
    { f32x4* dst = (f32x4*)(a.out + O_SWIN); const f32x4* src = (const f32x4*)a.cache_win;
      for (size_t i = gt; i < (size_t)DB * 504 * 128; i += NT) { const size_t b = i / (504 * 128), r = i - b * (504 * 128); dst[b * 512 * 128 + r] = src[b * 512 * 128 + 8 * 128 + r]; } }
    { float* pec = (float*)(ws + WS_PEC);
      for (size_t i = gt; i < 32 * 256; i += NT) { const int sl = (int)(i >> 8), kve = (int)(i & 255), kv = kve >> 7, e = kve & 127; float s = 0.f;
          for (int k = 64 * sl; k < 64 * sl + 64; ++k) s += a.cmp_pe[(size_t)kv * 2048 + k] * a.cmp_w1[((size_t)kv * 2048 + k) * 128 + e];
          pec[i] = s; } }
}

__device__ __forceinline__ void scan_phase(const Args& a, LAS unsigned char* lds, int G) {
    using namespace cfg;
    const int tid = threadIdx.x, lane = tid & 63, wave = tid >> 6, p = tid >> 3, nq = tid & 7;
    LAS float* cv = (LAS float*)lds;
    LAS float* dts = cv + 16 * 320;
    LAS float* dAs = dts + 16;
    LAS float* ygs = dAs + 16;
    const bf16* ZX = (const bf16*)(a.ws + WS_ZX); const float* DT = (const float*)(a.ws + WS_DT);
    bf16* YG = (bf16*)(a.ws + WS_YG); float* SSQ = (float*)(a.ws + WS_SSQ);
    for (int u = blockIdx.x; u < NPB * NH + DB * NH; u += G) {
        const bool prompt = u < NPB * NH; const int su = prompt ? u : u - NPB * NH; const int b = su >> 5, hd = su & 31, g = hd >> 3;
        const int L = prompt ? SEQ : DS; const int row0 = prompt ? b * SEQ : MP + b * DS;
        float h[16];
        float* sdst = a.out + (prompt ? O_PSSM : O_SSSM) + ((size_t)(b * NH + hd) * HD + p) * DST + nq * 16;
        if (prompt) {
#pragma unroll
            for (int i = 0; i < 16; ++i) h[i] = 0.f;
        } else { const float* s0 = a.state_ssm + ((size_t)(b * NH + hd) * HD + p) * DST + nq * 16;
#pragma unroll
            for (int i4 = 0; i4 < 4; ++i4) { const f32x4 v = *(const f32x4*)(s0 + 4 * i4); h[4 * i4] = v[0]; h[4 * i4 + 1] = v[1]; h[4 * i4 + 2] = v[2]; h[4 * i4 + 3] = v[3]; } }
        const float dtb = a.m_dt_bias[hd], Aneg = -__expf(a.m_a_log[hd]), Dh = a.m_d[hd];
        for (int t0 = 0; t0 < L; t0 += 16) {
            const int nt = (L - t0) < 16 ? (L - t0) : 16;
            __syncthreads();
            for (int idx = tid; idx < nt * 320; idx += NTHR) { const int tt = idx / 320, cl = idx - tt * 320;
                const int cx = cl < 64 ? hd * 64 + cl : (cl < 192 ? 2048 + g * 128 + (cl - 64) : 2560 + g * 128 + (cl - 192));
                float acc = a.m_conv_b[cx];
#pragma unroll
                for (int k = 0; k < 4; ++k) { const int t = t0 + tt - 3 + k;
                    const float xv = t >= 0 ? bf2f(ZX[(size_t)(row0 + t) * ZXW + DIN + cx]) : (prompt ? 0.f : a.state_conv[(size_t)(b * 3 + t + 3) * CONVD + cx]);
                    acc += a.m_conv_w[k * CONVD + cx] * xv; }
                cv[tt * 320 + cl] = silu_f(acc); }
            if (tid < nt) { const float dtr = DT[(size_t)(row0 + t0 + tid) * 32 + hd] + dtb; const float dtv = dtr > 20.f ? dtr : log1pf(__expf(dtr)); dts[tid] = dtv; dAs[tid] = __expf(dtv * Aneg); }
            __syncthreads();
            for (int tt = 0; tt < nt; ++tt) {
                const float x = cv[tt * 320 + p], dtv = dts[tt], dA = dAs[tt], xdt = x * dtv;
                const LAS f32x4* Bp = (const LAS f32x4*)(cv + tt * 320 + 64 + nq * 16); const LAS f32x4* Cp = (const LAS f32x4*)(cv + tt * 320 + 192 + nq * 16);
                float acc = 0.f;
#pragma unroll
                for (int i4 = 0; i4 < 4; ++i4) { const f32x4 Bv = Bp[i4], Cv = Cp[i4];
#pragma unroll
                    for (int j = 0; j < 4; ++j) { h[4 * i4 + j] = dA * h[4 * i4 + j] + xdt * Bv[j]; acc += h[4 * i4 + j] * Cv[j]; } }
                acc += __shfl_xor(acc, 1); acc += __shfl_xor(acc, 2); acc += __shfl_xor(acc, 4);
                if (nq == 0) { const float y = acc + Dh * x; const float z = bf2f(ZX[(size_t)(row0 + t0 + tt) * ZXW + hd * 64 + p]); ygs[tt * 64 + p] = y * silu_f(z); }
            }
            __syncthreads();
            for (int idx = tid; idx < nt * 32; idx += NTHR) { const int tt = idx >> 5, pp = (idx & 31) * 2;
                *(unsigned*)(YG + (size_t)(row0 + t0 + tt) * DIN + hd * 64 + pp) = pk2(ygs[tt * 64 + pp], ygs[tt * 64 + pp + 1]); }
            for (int tt = wave; tt < nt; tt += NWAVES) { const float v = ygs[tt * 64 + lane]; const float s = wave_sum(v * v); if (lane == 0) SSQ[(size_t)(row0 + t0 + tt) * 32 + hd] = s; }
        }
#pragma unroll
        for (int i4 = 0; i4 < 4; ++i4) { f32x4 v = {h[4 * i4], h[4 * i4 + 1], h[4 * i4 + 2], h[4 * i4 + 3]}; *(f32x4*)(sdst + 4 * i4) = v; }
    }
}

__device__ __forceinline__ void norm_phase(const Args& a, int G) {
    using namespace cfg;
    const bf16* YG = (const bf16*)(a.ws + WS_YG); const float* SSQ = (const float*)(a.ws + WS_SSQ); bf16* YN = (bf16*)(a.ws + WS_YN);
    const size_t gt = (size_t)blockIdx.x * NTHR + threadIdx.x, NT = (size_t)G * NTHR;
    for (size_t i = gt; i < (size_t)M * DIN / 8; i += NT) { const size_t row = i >> 8; const int c8 = (int)(i & 255), g = c8 >> 6;
        const f32x4 s0 = *(const f32x4*)(SSQ + row * 32 + g * 8), s1 = *(const f32x4*)(SSQ + row * 32 + g * 8 + 4);
        const float ms = ((s0[0] + s0[1]) + (s0[2] + s0[3]) + (s1[0] + s1[1]) + (s1[2] + s1[3])) * (1.f / 512.f);
        const float r = 1.f / sqrtf(ms + RMS_EPS);
        const v4u v = *(const v4u*)(YG + i * 8); v4u o;
        o.x = pk2(bflo(v.x) * r, bfhi(v.x) * r); o.y = pk2(bflo(v.y) * r, bfhi(v.y) * r); o.z = pk2(bflo(v.z) * r, bfhi(v.z) * r); o.w = pk2(bflo(v.w) * r, bfhi(v.w) * r);
        *(v4u*)(YN + i * 8) = o; }
}

__device__ __forceinline__ void ln_phase(const float* PRE, const float* gam, const float* bet, float* outF, bf16* outB, int G) {
    using namespace cfg;
    const int lane = threadIdx.x & 63, wave = threadIdx.x >> 6;
    f32x4 gv[4], bv[4];
#pragma unroll
    for (int j = 0; j < 4; ++j) { gv[j] = *(const f32x4*)(gam + 4 * lane + 256 * j); bv[j] = *(const f32x4*)(bet + 4 * lane + 256 * j); }
    for (int row = blockIdx.x * NWAVES + wave; row < M; row += G * NWAVES) {
        const float* xr = PRE + (size_t)row * DM + 4 * lane; f32x4 v[4]; float s = 0.f;
#pragma unroll
        for (int j = 0; j < 4; ++j) { v[j] = *(const f32x4*)(xr + 256 * j); s += (v[j][0] + v[j][1]) + (v[j][2] + v[j][3]); }
        const float mean = wave_sum(s) * (1.f / DM); float s2 = 0.f;
#pragma unroll
        for (int j = 0; j < 4; ++j) { v[j] = v[j] - mean; s2 += (v[j][0] * v[j][0] + v[j][1] * v[j][1]) + (v[j][2] * v[j][2] + v[j][3] * v[j][3]); }
        const float rstd = 1.f / sqrtf(wave_sum(s2) * (1.f / DM) + LN_EPS);
#pragma unroll
        for (int j = 0; j < 4; ++j) { const f32x4 o = v[j] * rstd * gv[j] + bv[j]; *(f32x4*)(outF + (size_t)row * DM + 4 * lane + 256 * j) = o;
            if (outB) { v2u w; w.x = pk2(o[0], o[1]); w.y = pk2(o[2], o[3]); *(v2u*)(outB + (size_t)row * DM + 4 * lane + 256 * j) = w; } }
    }
}

__device__ __forceinline__ void cmp2_phase(const Args& a, LAS unsigned char* lds, int G) {
    using namespace cfg;
    const int tid = threadIdx.x;
    LAS float* w2s = (LAS float*)lds;
    LAS float* pcs = w2s + 2 * 128 * 64;
    LAS float* hs = pcs + 256;
    const float* P = (const float*)(a.ws + WS_PCMP); const float* pec = (const float*)(a.ws + WS_PEC);
    for (int i = tid; i < 2 * 128 * 64; i += NTHR) w2s[i] = a.cmp_w2[i];
    if (tid < 256) { float s = 0.f; for (int sl = 0; sl < 32; ++sl) s += pec[sl * 256 + tid]; pcs[tid] = s; }
    __syncthreads();
    for (int u = blockIdx.x; u < 2 * NCMPROWS / 64; u += G) {
        const size_t r0 = (size_t)u * 64; const int kv = r0 >= (size_t)NCMPROWS ? 1 : 0;
        __syncthreads();
        for (int i = tid; i < 64 * 128; i += NTHR) { const int rl = i >> 7, e = i & 127; const size_t r = r0 + rl; const int c = (int)(r & 127);
            float hv = 0.f; if (c < 127) hv = silu_f(P[r * 256 + e] + P[(r + 1) * 256 + 128 + e] + pcs[kv * 128 + e]);
            hs[rl * 129 + e] = hv; }
        __syncthreads();
        const int rl = tid >> 3, dq = tid & 7; float o[8];
#pragma unroll
        for (int j = 0; j < 8; ++j) o[j] = 0.f;
        for (int e = 0; e < 128; ++e) { const float s = hs[rl * 129 + e]; const LAS f32x4* wp = (const LAS f32x4*)(w2s + (kv * 128 + e) * 64 + dq * 8); const f32x4 w0 = wp[0], w1 = wp[1];
            o[0] += s * w0[0]; o[1] += s * w0[1]; o[2] += s * w0[2]; o[3] += s * w0[3]; o[4] += s * w1[0]; o[5] += s * w1[1]; o[6] += s * w1[2]; o[7] += s * w1[3]; }
        bf16* dst = (bf16*)(a.ws + (kv ? WS_VC : WS_KC)) + ((r0 - (size_t)kv * NCMPROWS) + rl) * 64 + dq * 8;
        v4u w; w.x = pk2(o[0], o[1]); w.y = pk2(o[2], o[3]); w.z = pk2(o[4], o[5]); w.w = pk2(o[6], o[7]); *(v4u*)dst = w;
    }
}

__device__ __forceinline__ void ld16(const void* p, bool isf32, float (&o)[16]) {
    if (isf32) { const f32x4* q = (const f32x4*)p;
#pragma unroll
        for (int i = 0; i < 4; ++i) { const f32x4 v = q[i]; o[4 * i] = v[0]; o[4 * i + 1] = v[1]; o[4 * i + 2] = v[2]; o[4 * i + 3] = v[3]; } }
    else { const v4u* q = (const v4u*)p;
#pragma unroll
        for (int i = 0; i < 2; ++i) { const v4u v = q[i]; o[8 * i] = bflo(v.x); o[8 * i + 1] = bfhi(v.x); o[8 * i + 2] = bflo(v.y); o[8 * i + 3] = bfhi(v.y); o[8 * i + 4] = bflo(v.z); o[8 * i + 5] = bfhi(v.z); o[8 * i + 6] = bflo(v.w); o[8 * i + 7] = bfhi(v.w); } }
}
#define WSYNC() asm volatile("s_waitcnt lgkmcnt(0)" ::: "memory")

template <bool PROMPT>
__device__ __forceinline__ void attn_item(const Args& a, int b, int g, int tg, int lane, const LAS float* bt, LAS float* sc, LAS float* scoreL, LAS int* flagL) {
    using namespace cfg;
    const int tl = lane >> 4, hh = (lane >> 2) & 3, dq = lane & 3, rowl = lane >> 2;
    const int t = tg * 4 + tl, pos = PROMPT ? t : PAST + t, row = PROMPT ? b * SEQ + t : MP + b * DS + t, head = g * 4 + hh;
    const int posmax = (PROMPT ? 0 : PAST) + tg * 4 + 3, posmin = posmax - 3;
    const bf16* KVB = (const bf16*)(a.ws + WS_KVB);
    float q[16]; ld16((const bf16*)(a.ws + WS_QB) + (size_t)row * DM + head * 64 + dq * 16, false, q);
    const float* gp = (const float*)(a.ws + WS_GATES) + (size_t)row * 48 + head * 3; const float g0 = gp[0], g1 = gp[1], g2 = gp[2];
    const LAS float* btr = bt + head * 128;
    float out[16];
    {
        const size_t cb = ((size_t)((PROMPT ? DB + b : b) * 4 + g) * 128) * 64;
        const bf16* KCb = (const bf16*)(a.ws + WS_KC) + cb; const bf16* VCb = (const bf16*)(a.ws + WS_VC) + cb;
        int ncw = posmax >= 31 ? ((posmax - 31) >> 4) + 1 : 0; if (ncw > 127) ncw = 127;
        float m = -1e30f;
        for (int c = 0; c < ncw; ++c) { float k[16]; ld16(KCb + c * 64 + dq * 16, false, k); float s = 0.f;
#pragma unroll
            for (int i = 0; i < 16; ++i) s += q[i] * k[i];
            s += __shfl_xor(s, 1); s += __shfl_xor(s, 2);
            const int dist = pos - (16 * c + 31); s = dist >= 0 ? s + btr[dist < 127 ? dist : 127] : -1e30f;
            if (dq == 0) sc[rowl * 128 + c] = s; m = fmaxf(m, s); }
        WSYNC();
        float l = 0.f;
        for (int c = dq; c < ncw; c += 4) { const float s = sc[rowl * 128 + c]; const float e = s > -1e29f ? exp2f(s - m) : 0.f; sc[rowl * 128 + c] = e; l += e; }
        l += __shfl_xor(l, 1); l += __shfl_xor(l, 2);
        const float inv = l > 0.f ? 1.f / l : 0.f;
        WSYNC();
        float oc[16];
#pragma unroll
        for (int i = 0; i < 16; ++i) oc[i] = 0.f;
        for (int c = 0; c < ncw; ++c) { const float pv = sc[rowl * 128 + c] * inv; float v[16]; ld16(VCb + c * 64 + dq * 16, false, v);
#pragma unroll
            for (int i = 0; i < 16; ++i) oc[i] += pv * v[i]; }
        WSYNC();
        if (dq == 0) scoreL[144 + rowl] = inv;
        WSYNC();
        const int nsel = PROMPT ? 32 : 33, j = lane & 15, blk = pos >> 6;
        for (int s = j; s < nsel; s += 16) { float imp = 0.f;
#pragma unroll
            for (int h2 = 0; h2 < 4; ++h2) { const float iv = scoreL[144 + tl * 4 + h2]; float sm = 0.f;
#pragma unroll
                for (int c = 4 * s - 1; c <= 4 * s + 3; ++c) if (c >= 0 && c < ncw) sm += sc[(tl * 4 + h2) * 128 + c];
                imp += sm * iv; }
            const bool valid = s * 64 <= pos, forced = (s == 0) || (s == blk) || (s == blk - 1);
            scoreL[tl * 36 + s] = valid ? imp + (forced ? 1000.f : 0.f) : -1.f; }
        WSYNC();
        for (int s = j; s < nsel; s += 16) { const float my = scoreL[tl * 36 + s]; int rank = 0;
            for (int s2 = 0; s2 < nsel; ++s2) { const float o = scoreL[tl * 36 + s2]; rank += ((o > my) || (o == my && s2 < s)) ? 1 : 0; }
            flagL[tl * 36 + s] = rank < 16 ? 1 : 0; }
        WSYNC();
#pragma unroll
        for (int i = 0; i < 16; ++i) out[i] = g0 * oc[i];
    }
    {
        float ms = -1e30f, ls = 0.f, os[16];
#pragma unroll
        for (int i = 0; i < 16; ++i) os[i] = 0.f;
        const int nblk = (posmax >> 6) + 1;
        for (int s = 0; s < nblk; ++s) {
            const int fl = flagL[tl * 36 + s];
            if (!__any(fl)) continue;
            int kend = posmax - s * 64 + 1; if (kend > 64) kend = 64;
            for (int kk = 0; kk < kend; ++kk) { const int kpos = s * 64 + kk;
                const void* kp; const void* vp; bool f32src = false;
                if (PROMPT) { const bf16* r = KVB + (size_t)(b * SEQ + kpos) * KVW + 512 + g * 64 + dq * 16; kp = r; vp = r + 256; }
                else if (kpos < PAST) { const int page = a.page_table[b * NPAGE + (kpos >> 7)]; const float* r = a.cache_sel + ((size_t)page * PAGE + (kpos & 127)) * 512 + g * 64 + dq * 16; kp = r; vp = r + 256; f32src = true; }
                else { const bf16* r = KVB + (size_t)(MP + b * DS + kpos - PAST) * KVW + 512 + g * 64 + dq * 16; kp = r; vp = r + 256; }
                float k[16]; ld16(kp, f32src, k); float sd = 0.f;
#pragma unroll
                for (int i = 0; i < 16; ++i) sd += q[i] * k[i];
                sd += __shfl_xor(sd, 1); sd += __shfl_xor(sd, 2);
                float v[16]; ld16(vp, f32src, v);
                if (fl && kpos <= pos) { const int dist = pos - kpos; const float sv = sd + btr[dist < 127 ? dist : 127];
                    if (sv > ms) { const float corr = exp2f(ms - sv); ls *= corr;
#pragma unroll
                        for (int i = 0; i < 16; ++i) os[i] *= corr;
                        ms = sv; }
                    const float pv = exp2f(sv - ms); ls += pv;
#pragma unroll
                    for (int i = 0; i < 16; ++i) os[i] += pv * v[i]; }
            }
        }
        const float sc1 = g1 / ls;
#pragma unroll
        for (int i = 0; i < 16; ++i) out[i] += sc1 * os[i];
    }
    {
        float ms = -1e30f, ls = 0.f, os[16];
#pragma unroll
        for (int i = 0; i < 16; ++i) os[i] = 0.f;
        int kstart = posmin - 511; if (kstart < 0) kstart = 0;
        for (int kpos = kstart; kpos <= posmax; ++kpos) {
            const void* kp; const void* vp; bool f32src = false;
            if (PROMPT) { const bf16* r = KVB + (size_t)(b * SEQ + kpos) * KVW + 1024 + g * 64 + dq * 16; kp = r; vp = r + 256; }
            else if (kpos < PAST) { const float* r = a.cache_win + ((size_t)b * 512 + (kpos - (PAST - 512))) * 512 + g * 64 + dq * 16; kp = r; vp = r + 256; f32src = true; }
            else { const bf16* r = KVB + (size_t)(MP + b * DS + kpos - PAST) * KVW + 1024 + g * 64 + dq * 16; kp = r; vp = r + 256; }
            float k[16]; ld16(kp, f32src, k); float sd = 0.f;
#pragma unroll
            for (int i = 0; i < 16; ++i) sd += q[i] * k[i];
            sd += __shfl_xor(sd, 1); sd += __shfl_xor(sd, 2);
            float v[16]; ld16(vp, f32src, v);
            const int dist = pos - kpos;
            if (dist >= 0 && dist < 512) { const float sv = sd + btr[dist < 127 ? dist : 127];
                if (sv > ms) { const float corr = exp2f(ms - sv); ls *= corr;
#pragma unroll
                    for (int i = 0; i < 16; ++i) os[i] *= corr;
                    ms = sv; }
                const float pv = exp2f(sv - ms); ls += pv;
#pragma unroll
                for (int i = 0; i < 16; ++i) os[i] += pv * v[i]; }
        }
        const float sc2 = g2 / ls;
#pragma unroll
        for (int i = 0; i < 16; ++i) out[i] += sc2 * os[i];
    }
    bf16* op = (bf16*)(a.ws + WS_OB) + (size_t)row * DM + head * 64 + dq * 16;
    v4u w0, w1; w0.x = pk2(out[0], out[1]); w0.y = pk2(out[2], out[3]); w0.z = pk2(out[4], out[5]); w0.w = pk2(out[6], out[7]);
    w1.x = pk2(out[8], out[9]); w1.y = pk2(out[10], out[11]); w1.z = pk2(out[12], out[13]); w1.w = pk2(out[14], out[15]);
    *(v4u*)op = w0; *(v4u*)(op + 8) = w1;
}

__device__ __forceinline__ void attn_phase(const Args& a, LAS unsigned char* lds, int G) {
    using namespace cfg;
    const int tid = threadIdx.x, lane = tid & 63, wave = tid >> 6;
    LAS float* bt = (LAS float*)lds;
    LAS float* sc = (LAS float*)(lds + 8192 + wave * 9728);
    LAS float* scoreL = sc + 16 * 128;
    LAS int* flagL = (LAS int*)(scoreL + 160);
    for (int i = tid; i < 16 * 128; i += NTHR) { const int h = i >> 7, d = i & 127;
        int bucket = d; if (d >= 16) { bucket = 16 + (int)(__logf((float)d / 16.f) / 2.0794415416798357f * 16.f); if (bucket > 31) bucket = 31; }
        bt[i] = a.rel_bias[bucket * 16 + h] * LOG2E; }
    __syncthreads();
    for (int v = blockIdx.x; v < 2048 + 128; v += G) {
        if (v < 2048) { const int j = v >> 8, k = v & 255, bg = k >> 3, r = k & 7;
            const int uidx = (j >> 1) * 16 + ((j & 1) ? 15 - r : r);
            attn_item<true>(a, bg >> 2, bg & 3, uidx * 8 + wave, lane, bt, sc, scoreL, flagL); }
        else { const int bs = v - 2048; attn_item<false>(a, bs, wave >> 1, wave & 1, lane, bt, sc, scoreL, flagL); }
    }
}

constexpr int N_PHASES = 18;
__global__ void __launch_bounds__(NTHR, 2) yoco_fwd(Args args) {
    using namespace cfg;
    extern __shared__ __attribute__((aligned(16))) unsigned char lds_raw[];
    LAS unsigned char* lds = (LAS unsigned char*)lds_raw;
    const int tid = threadIdx.x, G = gridDim.x;
    unsigned char* ws = args.ws;
    for (int u = tid; u < (LDS_BYTES - RING_BYTES) / 4; u += NTHR) ((LAS unsigned*)(lds + RING_BYTES))[u] = 0u;
    __syncthreads();
    const bool one_launch = (args.ph_hi - args.ph_lo) > 1;
    XcdBarrier bar; bar.bar = (unsigned*)(ws + WS_CTL) + CW_BAR; bar.x = 0; bar.st = nullptr;
    if (one_launch) bar = xcd_barrier_post((unsigned*)(ws + WS_CTL) + CW_BAR, (volatile LAS unsigned*)(lds + MISC_OFF) + 8);
    const int lo = args.ph_lo, hi = args.ph_hi;
#define IN(k) (lo <= (k) && (k) < hi)
#define SEAM(k) do { if (IN(k) && IN((k) + 1)) xcd_barrier(bar); } while (0)
    bf16* const XB = (bf16*)(ws + WS_XB); bf16* const HAB = (bf16*)(ws + WS_HAB); bf16* const HBB = (bf16*)(ws + WS_HBB); bf16* const HFF = (bf16*)(ws + WS_HFF);
    float* const PRE = (float*)(ws + WS_PRE); float* const HA = (float*)(ws + WS_HA); float* const HB = (float*)(ws + WS_HB);

    if (IN(0)) { p0_prologue(args, lds, G); SEAM(0); }
    if (IN(1)) { pg8::Gemm g{XB, (const bf16*)(ws + WS_WIN), M, INPAD, DM}; pg8::StaticOrder S; S.init(M, INPAD, G, (int)blockIdx.x);
        pg8::EpiIn E{(bf16*)(ws + WS_ZX), (float*)(ws + WS_DT), args.out + O_PCONV, args.out + O_SCONV};
        pg8::gemm_phase<pg8::EpiIn, pg8::StaticOrder, true, true>(lds, g, S, E); SEAM(1); }
    if (IN(2)) { scan_phase(args, lds, G); SEAM(2); }
    if (IN(3)) { norm_phase(args, G); SEAM(3); }
    if (IN(4)) { pg8::Gemm g{(const bf16*)(ws + WS_YN), (const bf16*)(ws + WS_WOUT), M, DM, DIN}; pg8::StaticOrder S; S.init(M, DM, G, (int)blockIdx.x);
        pg8::EpiRes E{PRE, args.x_prompt, args.x_sample - (size_t)MP * DM};
        pg8::gemm_phase<pg8::EpiRes, pg8::StaticOrder, true, true>(lds, g, S, E); SEAM(4); }
    if (IN(5)) { ln_phase(PRE, args.ln_g + 0 * DM, args.ln_b + 0 * DM, HA, HAB, G); SEAM(5); }
    if (IN(6)) { pg8::Gemm g{HAB, (const bf16*)(ws + WS_W1), M, DFF, DM}; pg8::StaticOrder S; S.init(M, DFF, G, (int)blockIdx.x);
        pg8::EpiRelu2 E{HFF}; pg8::gemm_phase<pg8::EpiRelu2, pg8::StaticOrder, true, true>(lds, g, S, E); SEAM(6); }
    if (IN(7)) { pg8::Gemm g{HFF, (const bf16*)(ws + WS_W2), M, DM, DFF}; pg8::StaticOrder S; S.init(M, DM, G, (int)blockIdx.x);
        pg8::EpiRes E{PRE, HA, HA}; pg8::gemm_phase<pg8::EpiRes, pg8::StaticOrder, true, true>(lds, g, S, E); SEAM(7); }
    if (IN(8)) { ln_phase(PRE, args.ln_g + 1 * DM, args.ln_b + 1 * DM, HB, HBB, G); SEAM(8); }
    if (IN(9)) { pg8::Gemm g{HBB, (const bf16*)(ws + WS_WKVQ), M, KVQN, DM}; pg8::StaticOrder S; S.init(M, KVQN, G, (int)blockIdx.x);
        pg8::EpiKvq E{args.out, (bf16*)(ws + WS_KVB), (bf16*)(ws + WS_QB), (float*)(ws + WS_GATES), (bf16*)(ws + WS_ACMP)};
        pg8::gemm_phase<pg8::EpiKvq, pg8::StaticOrder, true, true>(lds, g, S, E); SEAM(9); }
    if (IN(10)) { pg8::Gemm g{(const bf16*)(ws + WS_ACMP), (const bf16*)(ws + WS_WC1), 2 * NCMPROWS, 512, 1024}; pg8::CmpOrder S{G, (int)blockIdx.x};
        pg8::EpiP E{(float*)(ws + WS_PCMP)}; pg8::gemm_phase<pg8::EpiP, pg8::CmpOrder, true, true>(lds, g, S, E); SEAM(10); }
    if (IN(11)) { cmp2_phase(args, lds, G); SEAM(11); }
    if (IN(12)) { attn_phase(args, lds, G); SEAM(12); }
    if (IN(13)) { pg8::Gemm g{(const bf16*)(ws + WS_OB), (const bf16*)(ws + WS_WO), M, DM, DM}; pg8::StaticOrder S; S.init(M, DM, G, (int)blockIdx.x);
        pg8::EpiRes E{PRE, HB, HB}; pg8::gemm_phase<pg8::EpiRes, pg8::StaticOrder, true, true>(lds, g, S, E); SEAM(13); }
    if (IN(14)) { ln_phase(PRE, args.ln_g + 2 * DM, args.ln_b + 2 * DM, HA, HAB, G); SEAM(14); }
    if (IN(15)) { pg8::Gemm g{HAB, (const bf16*)(ws + WS_W1) + (size_t)DFF * DM, M, DFF, DM}; pg8::StaticOrder S; S.init(M, DFF, G, (int)blockIdx.x);
        pg8::EpiRelu2 E{HFF}; pg8::gemm_phase<pg8::EpiRelu2, pg8::StaticOrder, true, true>(lds, g, S, E); SEAM(15); }
    if (IN(16)) { pg8::Gemm g{HFF, (const bf16*)(ws + WS_W2) + (size_t)DFF * DM, M, DM, DFF}; pg8::StaticOrder S; S.init(M, DM, G, (int)blockIdx.x);
        pg8::EpiRes E{PRE, HA, HA}; pg8::gemm_phase<pg8::EpiRes, pg8::StaticOrder, true, true>(lds, g, S, E); SEAM(16); }
    if (IN(17)) { ln_phase(PRE, args.ln_g + 3 * DM, args.ln_b + 3 * DM, args.out + O_YP, nullptr, G); }
#undef IN
#undef SEAM
}

extern "C" void kernel_launch(void* const* d_in, const int* in_sizes, int n_in, void* d_out, int out_size, void* d_ws, size_t ws_size, hipStream_t stream) {
    using namespace cfg;
    static int grid = 0;
    if (grid == 0) {
        if (n_in != 27 || (size_t)out_size != O_END || ws_size < WS_END) { fprintf(stderr, "kernel_launch: unexpected shapes (n_in %d, out %d, ws %zu, need %zu); nothing launched\n", n_in, out_size, ws_size, (size_t)WS_END); grid = -1; return; }
        int dev = 0, cus = 0, per_cu = 0;
        if (hipGetDevice(&dev) != hipSuccess || hipDeviceGetAttribute(&cus, hipDeviceAttributeMultiprocessorCount, dev) != hipSuccess) { grid = -1; return; }
        if (hipFuncSetAttribute((const void*)yoco_fwd, hipFuncAttributeMaxDynamicSharedMemorySize, LDS_BYTES) != hipSuccess) { fprintf(stderr, "kernel_launch: hipFuncSetAttribute failed\n"); grid = -1; return; }
        if (hipOccupancyMaxActiveBlocksPerMultiprocessor(&per_cu, (const void*)yoco_fwd, NTHR, LDS_BYTES) != hipSuccess || per_cu < 1) { fprintf(stderr, "kernel_launch: occupancy query says %d blocks per CU\n", per_cu); }
        (void)hipGetLastError();
        grid = cus;
    }
    if (grid < 0) return;
    if (hipMemsetAsync((char*)d_ws + WS_CTL, 0, CTL_ZERO_BYTES, stream) != hipSuccess) { fprintf(stderr, "kernel_launch: memset failed\n"); return; }
    Args a{};
    const float* const* fin = (const float* const*)d_in;
    a.x_prompt = fin[0]; a.x_sample = fin[1]; a.state_ssm = fin[2]; a.state_conv = fin[3]; a.cache_cmp = fin[4]; a.cache_sel = fin[5]; a.cache_win = fin[6]; a.page_table = (const int*)d_in[7];
    a.ln_g = fin[8]; a.ln_b = fin[9]; a.m_in_w = fin[10]; a.m_conv_w = fin[11]; a.m_conv_b = fin[12]; a.m_dt_bias = fin[13]; a.m_a_log = fin[14]; a.m_d = fin[15]; a.m_norm_w = fin[16]; a.m_out_w = fin[17];
    a.kv_w = fin[18]; a.cmp_w1 = fin[19]; a.cmp_pe = fin[20]; a.cmp_w2 = fin[21]; a.q_w = fin[22]; a.o_w = fin[23]; a.rel_bias = fin[24]; a.mlp_w1 = fin[25]; a.mlp_w2 = fin[26];
    a.out = (float*)d_out; a.ws = (unsigned char*)d_ws; a.pad = 0;
    constexpr int NL = (MK_N_LAUNCHES == 1) ? 1 : N_PHASES;
    for (int li = 0; li < NL; ++li) {
        a.ph_lo = (NL == 1) ? 0 : li; a.ph_hi = (NL == 1) ? N_PHASES : li + 1; a.li = li;
        hipLaunchKernelGGL(yoco_fwd, dim3(grid), dim3(NTHR), LDS_BYTES, stream, a);
        const hipError_t le = hipPeekAtLastError();
        if (le != hipSuccess) { fprintf(stderr, "kernel_launch: launch %d failed: %s\n", li, hipGetErrorName(le)); break; }
    }
}
```

```cpp
#include <hip/hip_runtime.h>
#include <cstdio>
#include <cstdint>

#ifndef MK_N_LAUNCHES
#define MK_N_LAUNCHES 1
#endif

namespace cfg {
constexpr int DM = 1024, NPB = 8, SEQ = 2048, DB = 128, DS = 8, PAST = 2048, PAGE = 128, NPAGE = PAST / PAGE;
constexpr int MP = NPB * SEQ, MS = DB * DS, M = MP + MS;
constexpr int DFF = 4096, DIN = 2048, NH = 32, HD = 64, NG = 4, HPG = 8, DST = 128, CONVD = 3072, INDIM = 5152, INPAD = 5376, ZXW = 5120;
constexpr int AH = 16, AKV = 4, AGRP = 4, KVW = 1536, QGW = 1072, KVQN = 2816, KVROW = 512;
constexpr int NCMPROWS = (DB + NPB) * AKV * 128;
constexpr float LN_EPS = 1e-5f, RMS_EPS = 1e-5f;
constexpr float ALPHA = 1.4142135623730951f;
constexpr float LOG2E = 1.4426950408889634f;
constexpr float QSCALE = 0.125f * LOG2E;
constexpr size_t O_YP = 0, O_YS = O_YP + (size_t)MP * DM, O_PSSM = O_YS + (size_t)MS * DM, O_PCONV = O_PSSM + (size_t)NPB * NH * HD * DST,
                 O_PCMP = O_PCONV + (size_t)NPB * 3 * CONVD, O_PSEL = O_PCMP + (size_t)MP * KVROW, O_PWIN = O_PSEL + (size_t)MP * KVROW,
                 O_SSSM = O_PWIN + (size_t)NPB * 512 * KVROW, O_SCONV = O_SSSM + (size_t)DB * NH * HD * DST, O_SCMP = O_SCONV + (size_t)DB * 3 * CONVD,
                 O_SSEL = O_SCMP + (size_t)MS * KVROW, O_SWIN = O_SSEL + (size_t)MS * KVROW, O_END = O_SWIN + (size_t)DB * 512 * KVROW;
static_assert(O_END == 108208128ull, "output size");
constexpr size_t MiB = 1u << 20;
constexpr size_t al(size_t x) { return (x + MiB - 1) / MiB * MiB; }
constexpr size_t WS_CTL = 0, CTL_ZERO_BYTES = MiB;
constexpr size_t WS_WIN = MiB;
constexpr size_t WS_WOUT = WS_WIN + al((size_t)INPAD * DM * 2);
constexpr size_t WS_W1 = WS_WOUT + al((size_t)DM * DIN * 2);
constexpr size_t WS_W2 = WS_W1 + 2 * al((size_t)DFF * DM * 2);
constexpr size_t WS_WKVQ = WS_W2 + 2 * al((size_t)DFF * DM * 2);
constexpr size_t WS_WO = WS_WKVQ + al((size_t)KVQN * DM * 2);
constexpr size_t WS_WC1 = WS_WO + al((size_t)DM * DM * 2);
constexpr size_t WS_PEC = WS_WC1 + al((size_t)512 * 1024 * 2);
constexpr size_t WS_XB = WS_PEC + MiB;
constexpr size_t WS_ZX = WS_XB + al((size_t)M * DM * 2);
constexpr size_t WS_DT = WS_ZX + al((size_t)M * ZXW * 2);
constexpr size_t WS_YG = WS_DT + al((size_t)M * 32 * 4);
constexpr size_t WS_SSQ = WS_YG + al((size_t)M * DIN * 2);
constexpr size_t WS_YN = WS_SSQ + al((size_t)M * 32 * 4);
constexpr size_t WS_PRE = WS_YN + al((size_t)M * DIN * 2);
constexpr size_t WS_HA = WS_PRE + al((size_t)M * DM * 4);
constexpr size_t WS_HB = WS_HA + al((size_t)M * DM * 4);
constexpr size_t WS_HAB = WS_HB + al((size_t)M * DM * 4);
constexpr size_t WS_HBB = WS_HAB + al((size_t)M * DM * 2);
constexpr size_t WS_HFF = WS_HBB + al((size_t)M * DM * 2);
constexpr size_t WS_KVB = WS_HFF + al((size_t)M * DFF * 2);
constexpr size_t WS_QB = WS_KVB + al((size_t)M * KVW * 2);
constexpr size_t WS_GATES = WS_QB + al((size_t)M * DM * 2);
constexpr size_t WS_ACMP = WS_GATES + al((size_t)M * 48 * 4);
constexpr size_t WS_PCMP = WS_ACMP + al((size_t)2 * NCMPROWS * 1024 * 2);
constexpr size_t WS_KC = WS_PCMP + al((size_t)2 * NCMPROWS * 256 * 4);
constexpr size_t WS_VC = WS_KC + al((size_t)NCMPROWS * 64 * 2);
constexpr size_t WS_OB = WS_VC + al((size_t)NCMPROWS * 64 * 2);
constexpr size_t WS_END = WS_OB + al((size_t)M * DM * 2);
constexpr int CW_BAR = 4096;
constexpr int RING_BYTES = 131072, MISC_OFF = RING_BYTES + 320, LDS_BYTES = 147456;
}

#define GAS __attribute__((address_space(1)))
#define LAS __attribute__((address_space(3)))
typedef unsigned short bf16;
typedef unsigned v4u __attribute__((ext_vector_type(4)));
typedef unsigned v2u __attribute__((ext_vector_type(2)));
typedef float f32x4 __attribute__((ext_vector_type(4)));
#define LDS_WAIT() asm volatile("s_waitcnt lgkmcnt(0)" ::: "memory")
#define VM_WAIT() asm volatile("s_waitcnt vmcnt(0)" ::: "memory")
__device__ __forceinline__ unsigned f2bf(float f) { unsigned u = __builtin_bit_cast(unsigned, f); return (u + 0x7fffu + ((u >> 16) & 1u)) >> 16; }
__device__ __forceinline__ unsigned pk2(float lo, float hi) { return f2bf(lo) | (f2bf(hi) << 16); }
__device__ __forceinline__ float bf2f(unsigned short b) { return __builtin_bit_cast(float, ((unsigned)b) << 16); }
__device__ __forceinline__ float bflo(unsigned w) { return __builtin_bit_cast(float, w << 16); }
__device__ __forceinline__ float bfhi(unsigned w) { return __builtin_bit_cast(float, w & 0xffff0000u); }

namespace pg8 {
#define PG8_LAS __attribute__((address_space(3)))
typedef unsigned short bf16_t;
typedef short bf16x8 __attribute__((ext_vector_type(8)));
typedef float f32x4 __attribute__((ext_vector_type(4)));
typedef unsigned u32x4 __attribute__((ext_vector_type(4)));
constexpr int BM = 256, BK = 64, HALF = 128, HTB = HALF * BK * 2  , STAGE_BYTES = 8 * HTB, NXCD = 8, WGM = 8;

__host__ __device__ __forceinline__ int lds_byte(int r, int c) { const int st = (r >> 4) * 2 + (c >> 5), rr = r & 15, cc = c & 31, ob = rr * 64 + cc * 2; return st * 1024 + (ob ^ (((ob >> 9) & 1) << 5)); }
__host__ __device__ __forceinline__ void stage_rc(int b, int& R, int& C) { const int st = b / 1024, sb = b % 1024, swz = sb ^ (((sb >> 9) & 1) << 5); R = (st >> 1) * 16 + swz / 64; C = (st & 1) * 32 + (swz % 64) / 2; }
__host__ __device__ __forceinline__ int perm32(int rho) { const int n = rho >> 4, i = rho & 15; return 8 * (i >> 2) + 4 * n + (i & 3); }

struct Unit { int pm, pn; };
struct Gemm { const bf16_t* A; const bf16_t* Bt; int M, N, K; };

struct StaticOrder {
    int nM, nN, nwg, G, c;
    __host__ __device__ void init(int M, int N, int G_, int c_) { nM = M / BM; nN = N / BM; nwg = nM * nN; G = G_; c = c_; }
    __host__ __device__ bool next(int i, Unit& u) const {
        const long L = (long)i * G + c; if (L >= nwg) return false;
        int wgid = (int)L; { const int q = nwg / NXCD, r = nwg % NXCD, xcd = wgid % NXCD, off = wgid / NXCD; wgid = (xcd < r ? xcd * (q + 1) : r * (q + 1) + (xcd - r) * q) + off; }
        const int nig = WGM * nN, gid = wgid / nig, fm = gid * WGM, gsz = (nM - fm) < WGM ? (nM - fm) : WGM;
        u.pm = fm + ((wgid % nig) % gsz); u.pn = (wgid % nig) / gsz; return true;
    }
    __device__ __forceinline__ void a_ready(const Unit&) const {}
    __device__ __forceinline__ void done(const Unit&) const {}
};

__device__ __forceinline__ unsigned cvt_pk_bf16(float lo, float hi) { unsigned r; asm volatile("v_cvt_pk_bf16_f32 %0, %1, %2" : "=v"(r) : "v"(lo), "v"(hi)); return r; }
typedef unsigned u32x2 __attribute__((ext_vector_type(2)));

struct CmpOrder {
    int G, c;
    __device__ bool next(int i, Unit& u) const { const int L = i * G + c; if (L >= 544) return false; u.pm = L; u.pn = L >= 272 ? 1 : 0; return true; }
    __device__ __forceinline__ void a_ready(const Unit&) const {}
    __device__ __forceinline__ void done(const Unit&) const {}
};

struct EpiIn {
    static constexpr bool PERM = false, AFTER_DRAIN = false;
    bf16_t* ZX; float* DT; float* pconv; float* sconv;
    __device__ __forceinline__ void operator()(const f32x4 (&acc)[2][2][4][2], const Unit& u, int wr, int wc, int fr, int fq) const {
        const int colt = u.pn * BM + wc * 32 + 4 * fq;
#pragma unroll
        for (int ai = 0; ai < 2; ++ai)
#pragma unroll
            for (int m = 0; m < 4; ++m) {
                const int row = u.pm * BM + ai * HALF + wr * 64 + m * 16 + fr;
                float* cptr = nullptr;
                if (row < cfg::MP) { const int t = row & 2047; if (t >= 2045) cptr = pconv + (size_t)((row >> 11) * 3 + (t - 2045)) * cfg::CONVD; }
                else { const int sr = row - cfg::MP, t = sr & 7; if (t >= 5) cptr = sconv + (size_t)((sr >> 3) * 3 + (t - 5)) * cfg::CONVD; }
#pragma unroll
                for (int bj = 0; bj < 2; ++bj)
#pragma unroll
                    for (int n = 0; n < 2; ++n) {
                        const int col = colt + bj * HALF + n * 16; const f32x4 v = acc[ai][bj][m][n];
                        if (col < cfg::ZXW) {
                            u32x2 w; w.x = cvt_pk_bf16(v[0], v[1]); w.y = cvt_pk_bf16(v[2], v[3]);
                            *(u32x2*)(ZX + (size_t)row * cfg::ZXW + col) = w;
                            if (cptr && col >= cfg::DIN) *(f32x4*)(cptr + (col - cfg::DIN)) = v;
                        } else if (col < cfg::INDIM) *(f32x4*)(DT + (size_t)row * 32 + (col - cfg::ZXW)) = v;
                    }
            }
    }
};
struct EpiRes {
    static constexpr bool PERM = false, AFTER_DRAIN = false;
    float* out; const float* resA; const float* resB;
    __device__ __forceinline__ void operator()(const f32x4 (&acc)[2][2][4][2], const Unit& u, int wr, int wc, int fr, int fq) const {
        const int colt = u.pn * BM + wc * 32 + 4 * fq;
#pragma unroll
        for (int ai = 0; ai < 2; ++ai)
#pragma unroll
            for (int m = 0; m < 4; ++m) {
                const int row = u.pm * BM + ai * HALF + wr * 64 + m * 16 + fr;
                const float* rp = (row < cfg::MP ? resA : resB) + (size_t)row * cfg::DM + colt; float* op = out + (size_t)row * cfg::DM + colt;
#pragma unroll
                for (int bj = 0; bj < 2; ++bj)
#pragma unroll
                    for (int n = 0; n < 2; ++n) { const f32x4 r = *(const f32x4*)(rp + bj * HALF + n * 16); *(f32x4*)(op + bj * HALF + n * 16) = acc[ai][bj][m][n] + r * cfg::ALPHA; }
            }
    }
};
struct EpiRelu2 {
    static constexpr bool PERM = true, AFTER_DRAIN = false;
    bf16_t* O;
    __device__ __forceinline__ void operator()(const f32x4 (&acc)[2][2][4][2], const Unit& u, int wr, int wc, int fr, int fq) const {
        const int col0 = u.pn * BM + wc * 32 + 8 * fq;
#pragma unroll
        for (int ai = 0; ai < 2; ++ai)
#pragma unroll
            for (int m = 0; m < 4; ++m) { bf16_t* rowp = O + (size_t)(u.pm * BM + ai * HALF + wr * 64 + m * 16 + fr) * cfg::DFF + col0;
#pragma unroll
                for (int bj = 0; bj < 2; ++bj) { f32x4 v0 = acc[ai][bj][m][0], v1 = acc[ai][bj][m][1];
#pragma unroll
                    for (int j = 0; j < 4; ++j) { const float a = fmaxf(v0[j], 0.f), b = fmaxf(v1[j], 0.f); v0[j] = a * a; v1[j] = b * b; }
                    u32x4 w; w.x = cvt_pk_bf16(v0[0], v0[1]); w.y = cvt_pk_bf16(v0[2], v0[3]); w.z = cvt_pk_bf16(v1[0], v1[1]); w.w = cvt_pk_bf16(v1[2], v1[3]);
                    *(u32x4*)(rowp + bj * HALF) = w; } }
    }
};
struct EpiKvq {
    static constexpr bool PERM = false, AFTER_DRAIN = false;
    float* out; bf16_t* KVB; bf16_t* QB; float* GATES; bf16_t* ACMP;
    __device__ __forceinline__ void operator()(const f32x4 (&acc)[2][2][4][2], const Unit& u, int wr, int wc, int fr, int fq) const {
        const int colt = u.pn * BM + wc * 32 + 4 * fq;
#pragma unroll
        for (int ai = 0; ai < 2; ++ai)
#pragma unroll
            for (int m = 0; m < 4; ++m) {
                const int row = u.pm * BM + ai * HALF + wr * 64 + m * 16 + fr;
                const bool prompt = row < cfg::MP; const int sr = row - cfg::MP;
                const int b = prompt ? (row >> 11) : (sr >> 3), t = prompt ? (row & 2047) : (sr & 7);
#pragma unroll
                for (int bj = 0; bj < 2; ++bj)
#pragma unroll
                    for (int n = 0; n < 2; ++n) {
                        const int col = colt + bj * HALF + n * 16; const f32x4 v = acc[ai][bj][m][n];
                        if (col < cfg::KVW) {
                            const int br = col >> 9, cc = col & 511;
                            float* dst = nullptr;
                            if (prompt) { if (br == 0) dst = out + cfg::O_PCMP + (size_t)row * 512 + cc; else if (br == 1) dst = out + cfg::O_PSEL + (size_t)row * 512 + cc;
                                          else if (t >= 1536) dst = out + cfg::O_PWIN + (size_t)(b * 512 + t - 1536) * 512 + cc; }
                            else { if (br == 0) dst = out + cfg::O_SCMP + (size_t)sr * 512 + cc; else if (br == 1) dst = out + cfg::O_SSEL + (size_t)sr * 512 + cc;
                                   else dst = out + cfg::O_SWIN + (size_t)(b * 512 + 504 + t) * 512 + cc; }
                            if (dst) *(f32x4*)dst = v;
                            u32x2 w; w.x = cvt_pk_bf16(v[0], v[1]); w.y = cvt_pk_bf16(v[2], v[3]);
                            *(u32x2*)(KVB + (size_t)row * cfg::KVW + col) = w;
                            if (prompt && br == 0) { const int kv = cc >> 8, g = (cc >> 6) & 3, d = cc & 63;
                                *(u32x2*)(ACMP + ((size_t)kv * cfg::NCMPROWS + 65536 + (size_t)(b * 4 + g) * 128 + (t >> 4)) * 1024 + (t & 15) * 64 + d) = w; }
                        } else if (col < cfg::KVW + 1024) {
                            u32x2 w; w.x = cvt_pk_bf16(v[0] * cfg::QSCALE, v[1] * cfg::QSCALE); w.y = cvt_pk_bf16(v[2] * cfg::QSCALE, v[3] * cfg::QSCALE);
                            *(u32x2*)(QB + (size_t)row * cfg::DM + (col - cfg::KVW)) = w;
                        } else if (col < cfg::KVW + cfg::QGW) {
                            f32x4 s;
#pragma unroll
                            for (int j = 0; j < 4; ++j) s[j] = 1.f / (1.f + __expf(-v[j]));
                            *(f32x4*)(GATES + (size_t)row * 48 + (col - cfg::KVW - 1024)) = s;
                        }
                    }
            }
    }
};
struct EpiP {
    static constexpr bool PERM = false, AFTER_DRAIN = false;
    float* P;
    __device__ __forceinline__ void operator()(const f32x4 (&acc)[2][2][4][2], const Unit& u, int wr, int wc, int fr, int fq) const {
        const int colt = wc * 32 + 4 * fq;
#pragma unroll
        for (int ai = 0; ai < 2; ++ai)
#pragma unroll
            for (int m = 0; m < 4; ++m) { float* op = P + (size_t)(u.pm * BM + ai * HALF + wr * 64 + m * 16 + fr) * 256 + colt;
#pragma unroll
                for (int bj = 0; bj < 2; ++bj)
#pragma unroll
                    for (int n = 0; n < 2; ++n) *(f32x4*)(op + bj * HALF + n * 16) = acc[ai][bj][m][n]; }
    }
};

template <class Epi, class Sched, bool ALIGN_EPI = false, bool SP2 = false>
__device__ __forceinline__ void gemm_phase(PG8_LAS unsigned char* lds, const Gemm g, const Sched& S, const Epi& E) {
    const int tid = threadIdx.x, wid = __builtin_amdgcn_readfirstlane(tid >> 6), lane = tid & 63, wr = wid >> 2, wc = wid & 3, fr = lane & 15, fq = lane >> 4;
    const int K = g.K, nt = K / BK;
    unsigned voffA[2], voffB[2];
#pragma unroll
    for (int i = 0; i < 2; ++i) { int R, C; stage_rc(tid * 16 + i * 8192, R, C); const int Rb = Epi::PERM ? ((R & ~31) + perm32(R & 31)) : R;
        voffA[i] = (unsigned)(R * K + C) * 2u; voffB[i] = (unsigned)(Rb * K + C) * 2u; }
    const size_t kstep = (size_t)(BK * 2);
    const size_t hstep = (size_t)HALF * K * 2;
    const size_t tstep = 2 * hstep;
    const unsigned ldsw = (unsigned)wid * 1024u;
    const int aoff = lds_byte(wr * 64 + fr, fq * 8), boff = lds_byte(wc * 32 + fr, fq * 8);
#define PG8_SA(b, h) (((b) * 2 + (h)) * HTB)
#define PG8_SB(b, h) ((4 + (b) * 2 + (h)) * HTB)
#define PG8_STAGE(bufoff, gbase, voff) do { _Pragma("unroll") for (int _i = 0; _i < 2; ++_i) \
        __builtin_amdgcn_global_load_lds((const unsigned*)((const char*)(gbase) + (voff)[_i]), (PG8_LAS unsigned*)(lds + (bufoff) + ldsw + _i * 8192), 16, 0, 0); } while (0)
#define PG8_LDA(dst, b, h) do { _Pragma("unroll") for (int m = 0; m < 4; ++m) _Pragma("unroll") for (int k = 0; k < 2; ++k) dst[m][k] = *(const PG8_LAS bf16x8*)(lds + PG8_SA(b, h) + aoff + m * 2048 + k * 1024); } while (0)
#define PG8_LDB(dst, b, h) do { _Pragma("unroll") for (int n = 0; n < 2; ++n) _Pragma("unroll") for (int k = 0; k < 2; ++k) dst[n][k] = *(const PG8_LAS bf16x8*)(lds + PG8_SB(b, h) + boff + n * 2048 + k * 1024); } while (0)
#define PG8_MMA(ai, bj, At, Bt) do { __builtin_amdgcn_s_setprio(1); _Pragma("unroll") for (int m = 0; m < 4; ++m) _Pragma("unroll") for (int n = 0; n < 2; ++n) _Pragma("unroll") for (int k = 0; k < 2; ++k) \
        acc[ai][bj][m][n] = __builtin_amdgcn_mfma_f32_16x16x32_bf16(Bt[n][k], At[m][k], acc[ai][bj][m][n], 0, 0, 0); __builtin_amdgcn_s_setprio(0); } while (0)
#define PG8_WAIT_V(n) asm volatile("s_waitcnt vmcnt(" #n ")" ::: "memory")
#define PG8_WAIT_L(n) asm volatile("s_waitcnt lgkmcnt(" #n ")" ::: "memory")
#define PG8_BAR __builtin_amdgcn_s_barrier()
#define PG8_SCHED __builtin_amdgcn_sched_barrier(0)
    Unit cur, nxt; int ui = 0;
    if (!S.next(0, cur)) return;
    f32x4 acc[2][2][4][2];
#pragma unroll
    for (int a = 0; a < 2; ++a)
#pragma unroll
        for (int b = 0; b < 2; ++b)
#pragma unroll
            for (int m = 0; m < 4; ++m)
#pragma unroll
                for (int n = 0; n < 2; ++n) acc[a][b][m][n] = (f32x4){0.f, 0.f, 0.f, 0.f};
    bf16x8 At[4][2], B0[2][2], B1[2][2];
    const char* cA = (const char*)g.A + (size_t)cur.pm * tstep; const char* cB = (const char*)g.Bt + (size_t)cur.pn * tstep;
    S.a_ready(cur);
    if constexpr (SP2) {
        PG8_STAGE(PG8_SB(0, 0), cB, voffB); PG8_STAGE(PG8_SB(0, 1), cB + hstep, voffB); PG8_STAGE(PG8_SA(0, 0), cA, voffA); PG8_STAGE(PG8_SA(0, 1), cA + hstep, voffA);
        if (wr == 1) PG8_BAR;
        PG8_WAIT_V(2); PG8_BAR;
        PG8_STAGE(PG8_SB(1, 0), cB + kstep, voffB); PG8_STAGE(PG8_SA(1, 0), cA + kstep, voffA); PG8_STAGE(PG8_SB(1, 1), cB + hstep + kstep, voffB);
        PG8_WAIT_V(6); PG8_BAR;
    } else {
        PG8_STAGE(PG8_SB(0, 0), cB, voffB); PG8_STAGE(PG8_SA(0, 0), cA, voffA); PG8_STAGE(PG8_SB(0, 1), cB + hstep, voffB); PG8_STAGE(PG8_SA(0, 1), cA + hstep, voffA);
        if (wr == 1) PG8_BAR;
        PG8_WAIT_V(4); PG8_BAR;
        PG8_STAGE(PG8_SB(1, 0), cB + kstep, voffB); PG8_STAGE(PG8_SA(1, 0), cA + kstep, voffA); PG8_STAGE(PG8_SB(1, 1), cB + hstep + kstep, voffB);
        PG8_WAIT_V(6); PG8_BAR;
    }
    for (;;) {
        const bool has_next = S.next(ui + 1, nxt);
        const char* nA = has_next ? (const char*)g.A + (size_t)nxt.pm * tstep : cA; const char* nB = has_next ? (const char*)g.Bt + (size_t)nxt.pn * tstep : cB;
        for (int t = 0; t < nt; t += 2) {
            const bool last = (t == nt - 2);
            const char* a1 = cA + (size_t)(t + 1) * kstep;
            const char* a2 = last ? nA : cA + (size_t)(t + 2) * kstep; const char* b2 = last ? nB : cB + (size_t)(t + 2) * kstep;
            const char* a3 = a2 + kstep; const char* b3 = b2 + kstep;
            if (last && has_next) S.a_ready(nxt);
            if constexpr (SP2) {
            PG8_LDB(B0, 0, 0); PG8_LDB(B1, 0, 1); PG8_SCHED; PG8_LDA(At, 0, 0); PG8_STAGE(PG8_SA(1, 1), a1 + hstep, voffA);
            PG8_WAIT_V(8); PG8_WAIT_L(0); PG8_BAR; PG8_MMA(0, 0, At, B0); PG8_MMA(0, 1, At, B1); PG8_BAR; PG8_SCHED;
            PG8_LDA(At, 0, 1); PG8_STAGE(PG8_SB(0, 0), b2, voffB); PG8_STAGE(PG8_SB(0, 1), b2 + hstep, voffB); PG8_STAGE(PG8_SA(0, 0), a2, voffA);
            PG8_WAIT_V(8); PG8_WAIT_L(0); PG8_BAR; PG8_MMA(1, 0, At, B0); PG8_MMA(1, 1, At, B1); PG8_BAR; PG8_SCHED;
            PG8_LDB(B0, 1, 0); PG8_LDB(B1, 1, 1); PG8_SCHED; PG8_LDA(At, 1, 0); PG8_STAGE(PG8_SA(0, 1), a2 + hstep, voffA);
            PG8_WAIT_V(8); PG8_WAIT_L(0); PG8_BAR; PG8_MMA(0, 0, At, B0); PG8_MMA(0, 1, At, B1); PG8_BAR; PG8_SCHED;
            PG8_LDA(At, 1, 1); PG8_STAGE(PG8_SB(1, 0), b3, voffB); PG8_STAGE(PG8_SB(1, 1), b3 + hstep, voffB); PG8_STAGE(PG8_SA(1, 0), a3, voffA);
            PG8_WAIT_V(8); PG8_WAIT_L(0); PG8_BAR; PG8_MMA(1, 0, At, B0); PG8_MMA(1, 1, At, B1); PG8_BAR; PG8_SCHED;
            } else {
            PG8_LDB(B0, 0, 0); PG8_SCHED; PG8_LDA(At, 0, 0); PG8_STAGE(PG8_SA(1, 1), a1 + hstep, voffA);
            PG8_WAIT_L(8); PG8_BAR; PG8_WAIT_L(0); PG8_MMA(0, 0, At, B0); PG8_BAR; PG8_SCHED;
            PG8_LDB(B1, 0, 1); PG8_STAGE(PG8_SB(0, 0), b2, voffB);
            PG8_BAR; PG8_WAIT_L(0); PG8_MMA(0, 1, At, B1); PG8_BAR;
            PG8_LDA(At, 0, 1); PG8_STAGE(PG8_SA(0, 0), a2, voffA);
            PG8_BAR; PG8_WAIT_L(0); PG8_MMA(1, 0, At, B0); PG8_BAR; PG8_SCHED;
            PG8_STAGE(PG8_SB(0, 1), b2 + hstep, voffB);
            PG8_WAIT_V(6); PG8_BAR; PG8_MMA(1, 1, At, B1); PG8_BAR;
            PG8_LDB(B0, 1, 0); PG8_SCHED; PG8_LDA(At, 1, 0); PG8_STAGE(PG8_SA(0, 1), a2 + hstep, voffA);
            PG8_WAIT_L(8); PG8_BAR; PG8_WAIT_L(0); PG8_MMA(0, 0, At, B0); PG8_BAR; PG8_SCHED;
            PG8_LDB(B1, 1, 1); PG8_STAGE(PG8_SB(1, 0), b3, voffB);
            PG8_BAR; PG8_WAIT_L(0); PG8_MMA(0, 1, At, B1); PG8_BAR;
            PG8_LDA(At, 1, 1); PG8_STAGE(PG8_SA(1, 0), a3, voffA);
            PG8_BAR; PG8_WAIT_L(0); PG8_MMA(1, 0, At, B0); PG8_BAR; PG8_SCHED;
            PG8_STAGE(PG8_SB(1, 1), b3 + hstep, voffB);
            PG8_WAIT_V(6); PG8_BAR; PG8_MMA(1, 1, At, B1); PG8_BAR;
            }
        }
        if constexpr (ALIGN_EPI) { if (wr == 0) PG8_BAR; }
        if constexpr (!Epi::AFTER_DRAIN) { E(acc, cur, wr, wc, fr, fq); S.done(cur); }
        if (!has_next) break;
#pragma unroll
        for (int a = 0; a < 2; ++a)
#pragma unroll
            for (int b = 0; b < 2; ++b)
#pragma unroll
                for (int m = 0; m < 4; ++m)
#pragma unroll
                    for (int n = 0; n < 2; ++n) acc[a][b][m][n] = (f32x4){0.f, 0.f, 0.f, 0.f};
        cur = nxt; cA = nA; cB = nB; ++ui;
        if constexpr (ALIGN_EPI) { if (wr == 1) PG8_BAR; }
    }
    PG8_WAIT_V(0);
    if constexpr (!ALIGN_EPI) { if (wr == 0) PG8_BAR; }
    PG8_BAR;
    if constexpr (Epi::AFTER_DRAIN) { E.fused(acc, cur, wr, wc, fr, fq, lds, wid, lane); S.done(cur); }
#undef PG8_SA
#undef PG8_SB
#undef PG8_STAGE
#undef PG8_LDA
#undef PG8_LDB
#undef PG8_MMA
#undef PG8_WAIT_V
#undef PG8_WAIT_L
#undef PG8_BAR
#undef PG8_SCHED
}
}
#define XB_TMO      128
#define XB_XCNT(j)  (256  + 64 * (j))
#define XB_XSUB(j)  (1280 + 64 * (j))
#define XB_XGEN(j)  (2304 + 64 * (j))
#define XB_TOP      3328
#define XB_TOPGEN   3392
#define XCD_BAR_WORDS 3456
#define XB_SPIN_CAP (1u << 18)

__device__ __forceinline__ unsigned xb_ld(unsigned* p)              { return __hip_atomic_load(p, __ATOMIC_RELAXED, __HIP_MEMORY_SCOPE_AGENT); }
__device__ __forceinline__ unsigned xb_add(unsigned* p, unsigned v) { return __hip_atomic_fetch_add(p, v, __ATOMIC_RELAXED, __HIP_MEMORY_SCOPE_AGENT); }
__device__ __forceinline__ unsigned xb_xcc_id() { return (unsigned)__builtin_amdgcn_s_getreg((3 << 11) | 20) & 0xFu; }
#define XB_SPIN(cond, bar) do { unsigned _sp = 0; while (cond) { __builtin_amdgcn_s_sleep(1); \
    if ((++_sp & 255u) == 0u) { if (xb_ld(&(bar)[XB_TMO])) break; if (_sp > XB_SPIN_CAP) { atomicAdd(&(bar)[XB_TMO], 1u); break; } } } } while (0)

struct XcdBarrier {
    unsigned* bar; unsigned x;
    volatile LAS unsigned* st;
};

__device__ __forceinline__ XcdBarrier xcd_barrier_post(unsigned* bar, volatile LAS unsigned* st) {
    XcdBarrier b; b.bar = bar; b.x = xb_xcc_id(); b.st = st;
    if (threadIdx.x == 0) (void)xb_add(&bar[XB_XCNT(b.x)], 1u);
    return b;
}
__device__ __forceinline__ void xcd_barrier_complete(unsigned* bar, unsigned x, unsigned& nloc, unsigned& nx) {
    const unsigned G = gridDim.x * gridDim.y * gridDim.z;
    unsigned sum, cnt, mine, sp = 0u;
    for (;;) {
        sum = 0u; cnt = 0u; mine = 0u;
#pragma unroll
        for (unsigned j = 0; j < 16; ++j) { const unsigned c = xb_ld(&bar[XB_XCNT(j)]); sum += c; cnt += (c > 0u) ? 1u : 0u; mine = (j == x) ? c : mine; }
        if (sum == G) break;
        __builtin_amdgcn_s_sleep(1);
        if ((++sp & 255u) == 0u) { if (xb_ld(&bar[XB_TMO])) break; if (sp > XB_SPIN_CAP) { atomicAdd(&bar[XB_TMO], 1u); break; } }
    }
    nloc = mine > 0u ? mine : 1u; nx = cnt > 0u ? cnt : 1u;
}

__device__ __forceinline__ void xcd_barrier(const XcdBarrier& b) {
    asm volatile("s_waitcnt vmcnt(0)" ::: "memory");
    __syncthreads();
    if (threadIdx.x == 0) {
        unsigned* bar = b.bar;
        __builtin_amdgcn_s_waitcnt(0);
        unsigned nloc = b.st[0], nx = b.st[1];
        if (nloc == 0u) { xcd_barrier_complete(bar, b.x, nloc, nx); b.st[0] = nloc; b.st[1] = nx; }
        const unsigned old = xb_add(&bar[XB_XSUB(b.x)], 1u);
        const unsigned gen = old / nloc;
        if (old + 1u == (gen + 1u) * nloc) {
            __builtin_amdgcn_fence(__ATOMIC_RELEASE, "agent");
            asm volatile("s_waitcnt vmcnt(0)" ::: "memory");
            const unsigned og = xb_add(&bar[XB_TOP], 1u);
            const unsigned tg = og / nx;
            if (og + 1u == (tg + 1u) * nx) xb_add(&bar[XB_TOPGEN], 1u);
            else XB_SPIN(xb_ld(&bar[XB_TOPGEN]) == tg, bar);
            __builtin_amdgcn_fence(__ATOMIC_ACQUIRE, "agent");
            xb_add(&bar[XB_XGEN(b.x)], 1u);
            asm volatile("s_waitcnt vmcnt(0)" ::: "memory");
        } else {
            XB_SPIN(xb_ld(&bar[XB_XGEN(b.x)]) == gen, bar);
            __builtin_amdgcn_fence(__ATOMIC_ACQUIRE, "agent");
            asm volatile("s_waitcnt vmcnt(0)" ::: "memory");
        }
    }
    __syncthreads();
}

constexpr int NWAVES = 8, NTHR = 512;
__device__ __forceinline__ float wave_sum(float v) {
#pragma unroll
    for (int o = 1; o < 64; o <<= 1) v += __shfl_xor(v, o);
    return v;
}
__device__ __forceinline__ float silu_f(float v) { return v / (1.f + __expf(-v)); }

__device__ __forceinline__ void tr_item(const float* __restrict__ W, int N, bf16* WT, int ldk, int row_off, const float* __restrict__ kscale, LAS float* scr, int item, int lane) {
    const int nblk = (N + 31) >> 5, kb = item / nblk, nb = item - kb * nblk, k0 = 64 * kb, n0 = 32 * nb;
    const int nn = n0 + (lane & 31);
#pragma unroll 8
    for (int i = 0; i < 32; ++i) { const int kk = 2 * i + (lane >> 5); float v = (nn < N) ? W[(size_t)(k0 + kk) * N + nn] : 0.f; if (kscale) v *= kscale[k0 + kk]; scr[kk * 33 + (lane & 31)] = v; }
    LDS_WAIT();
    const int c = lane & 7;
#pragma unroll
    for (int j = 0; j < 4; ++j) { const int n = (lane >> 3) + 8 * j; const LAS float* s = scr + (8 * c) * 33 + n;
        v4u o; o.x = pk2(s[0 * 33], s[1 * 33]); o.y = pk2(s[2 * 33], s[3 * 33]); o.z = pk2(s[4 * 33], s[5 * 33]); o.w = pk2(s[6 * 33], s[7 * 33]);
        if (n0 + n < N) *(v4u*)(WT + (size_t)(row_off + n0 + n) * ldk + k0 + 8 * c) = o; }
    LDS_WAIT();
}

struct Args {
    const float* x_prompt; const float* x_sample; const float* state_ssm; const float* state_conv; const float* cache_cmp; const float* cache_sel; const float* cache_win; const int* page_table;
    const float* ln_g; const float* ln_b; const float* m_in_w; const float* m_conv_w; const float* m_conv_b; const float* m_dt_bias; const float* m_a_log; const float* m_d; const float* m_norm_w; const float* m_out_w;
    const float* kv_w; const float* cmp_w1; const float* cmp_pe; const float* cmp_w2; const float* q_w; const float* o_w; const float* rel_bias; const float* mlp_w1; const float* mlp_w2;
    float* out; unsigned char* ws; int ph_lo, ph_hi, li, pad;
};

__device__ __forceinline__ void p0_prologue(const Args& a, LAS unsigned char* lds, int G) {
    using namespace cfg;
    const int tid = threadIdx.x, lane = tid & 63, wave = tid >> 6;
    LAS float* scr = (LAS float*)(lds + wave * 16384);
    unsigned char* ws = a.ws;
    const int gw = blockIdx.x * NWAVES + wave, NGW = G * NWAVES;
    constexpr int I_IN = 16 * 161, I_OUT = 32 * 32, I_W1 = 16 * 128, I_W2 = 64 * 32, I_KV = 16 * 48, I_Q = 16 * 34, I_O = 16 * 32, I_C = 16 * 4;
    constexpr int NIT = I_IN + I_OUT + 2 * I_W1 + 2 * I_W2 + I_KV + I_Q + I_O + 4 * I_C;
    for (int it = gw; it < NIT; it += NGW) {
        int r = it;
        if (r < I_IN) { tr_item(a.m_in_w, INDIM, (bf16*)(ws + WS_WIN), DM, 0, nullptr, scr, r, lane); continue; } r -= I_IN;
        if (r < I_OUT) { tr_item(a.m_out_w, DM, (bf16*)(ws + WS_WOUT), DIN, 0, a.m_norm_w, scr, r, lane); continue; } r -= I_OUT;
        if (r < 2 * I_W1) { const int l = r / I_W1; tr_item(a.mlp_w1 + (size_t)l * DM * DFF, DFF, (bf16*)(ws + WS_W1) + (size_t)l * DFF * DM, DM, 0, nullptr, scr, r - l * I_W1, lane); continue; } r -= 2 * I_W1;
        if (r < 2 * I_W2) { const int l = r / I_W2; tr_item(a.mlp_w2 + (size_t)l * DM * DFF, DM, (bf16*)(ws + WS_W2) + (size_t)l * DFF * DM, DFF, 0, nullptr, scr, r - l * I_W2, lane); continue; } r -= 2 * I_W2;
        if (r < I_KV) { tr_item(a.kv_w, KVW, (bf16*)(ws + WS_WKVQ), DM, 0, nullptr, scr, r, lane); continue; } r -= I_KV;
        if (r < I_Q) { tr_item(a.q_w, QGW, (bf16*)(ws + WS_WKVQ), DM, KVW, nullptr, scr, r, lane); continue; } r -= I_Q;
        if (r < I_O) { tr_item(a.o_w, DM, (bf16*)(ws + WS_WO), DM, 0, nullptr, scr, r, lane); continue; } r -= I_O;
        { const int q = r / I_C; tr_item(a.cmp_w1 + (size_t)q * 1024 * 128, 128, (bf16*)(ws + WS_WC1), 1024, q * 128, nullptr, scr, r - q * I_C, lane); }
    }
    const size_t gt = (size_t)blockIdx.x * NTHR + tid, NT = (size_t)G * NTHR;
    { v4u z = {0u, 0u, 0u, 0u};
      v4u* p1 = (v4u*)((bf16*)(ws + WS_WIN) + (size_t)INDIM * DM); for (size_t i = gt; i < (size_t)(INPAD - INDIM) * DM / 8; i += NT) p1[i] = z;
      v4u* p2 = (v4u*)((bf16*)(ws + WS_WKVQ) + (size_t)(KVW + QGW) * DM); for (size_t i = gt; i < (size_t)(KVQN - KVW - QGW) * DM / 8; i += NT) p2[i] = z; }
    { v4u* xb = (v4u*)(ws + WS_XB);
      for (size_t i = gt; i < (size_t)M * DM / 8; i += NT) { const size_t e = i * 8; const float* src = e < (size_t)MP * DM ? a.x_prompt + e : a.x_sample + (e - (size_t)MP * DM);
          const f32x4 v0 = *(const f32x4*)src, v1 = *(const f32x4*)(src + 4); v4u o; o.x = pk2(v0[0], v0[1]); o.y = pk2(v0[2], v0[3]); o.z = pk2(v1[0], v1[1]); o.w = pk2(v1[2], v1[3]); xb[i] = o; } }
    { bf16* ac = (bf16*)(ws + WS_ACMP);
      for (size_t i = gt; i < (size_t)DB * PAST * 64; i += NT) { const int ch = (int)(i & 63); const size_t tok = i >> 6; const int b = (int)(tok >> 11), t = (int)(tok & 2047);
          const int page = a.page_table[b * NPAGE + (t >> 7)]; const float* src = a.cache_cmp + ((size_t)page * PAGE + (t & 127)) * 512 + ch * 8;
          const f32x4 v0 = *(const f32x4*)src, v1 = *(const f32x4*)(src + 4); v4u o; o.x = pk2(v0[0], v0[1]); o.y = pk2(v0[2], v0[3]); o.z = pk2(v1[0], v1[1]); o.w = pk2(v1[2], v1[3]);
          const int kv = ch >> 5, g = (ch >> 3) & 3, d0 = (ch & 7) * 8;
          *(v4u*)(ac + ((size_t)kv * NCMPROWS + (size_t)(b * 4 + g) * 128 + (t >> 4)) * 1024 + (t & 15) * 64 + d0) = o; } }
    { f32x4* dst = (f32x4*)(a.out + O_SWIN); const f32x4* src = (const f32x4*)a.cache_win;
      for (size_t i = gt; i < (size_t)DB * 504 * 128; i += NT) { const size_t b = i / (504 * 128), r = i - b * (504 * 128); dst[b * 512 * 128 + r] = src[b * 512 * 128 + 8 * 128 + r]; } }
    { float* pec = (float*)(ws + WS_PEC);
      for (size_t i = gt; i < 32 * 256; i += NT) { const int sl = (int)(i >> 8), kve = (int)(i & 255), kv = kve >> 7, e = kve & 127; float s = 0.f;
          for (int k = 64 * sl; k < 64 * sl + 64; ++k) s += a.cmp_pe[(size_t)kv * 2048 + k] * a.cmp_w1[((size_t)kv * 2048 + k) * 128 + e];
          pec[i] = s; } }
}

__device__ __forceinline__ void scan_phase(const Args& a, LAS unsigned char* lds, int G) {
    using namespace cfg;
    const int tid = threadIdx.x, lane = tid & 63, wave = tid >> 6, p = tid >> 3, nq = tid & 7;
    LAS float* cv = (LAS float*)lds;
    LAS float* dts = cv + 16 * 320;
    LAS float* dAs = dts + 16;
    LAS float* ygs = dAs + 16;
    const bf16* ZX = (const bf16*)(a.ws + WS_ZX); const float* DT = (const float*)(a.ws + WS_DT);
    bf16* YG = (bf16*)(a.ws + WS_YG); float* SSQ = (float*)(a.ws + WS_SSQ);
    for (int u = blockIdx.x; u < NPB * NH + DB * NH; u += G) {
        const bool prompt = u < NPB * NH; const int su = prompt ? u : u - NPB * NH; const int b = su >> 5, hd = su & 31, g = hd >> 3;
        const int L = prompt ? SEQ : DS; const int row0 = prompt ? b * SEQ : MP + b * DS;
        float h[16];
        float* sdst = a.out + (prompt ? O_PSSM : O_SSSM) + ((size_t)(b * NH + hd) * HD + p) * DST + nq * 16;
        if (prompt) {
#pragma unroll
            for (int i = 0; i < 16; ++i) h[i] = 0.f;
        } else { const float* s0 = a.state_ssm + ((size_t)(b * NH + hd) * HD + p) * DST + nq * 16;
#pragma unroll
            for (int i4 = 0; i4 < 4; ++i4) { const f32x4 v = *(const f32x4*)(s0 + 4 * i4); h[4 * i4] = v[0]; h[4 * i4 + 1] = v[1]; h[4 * i4 + 2] = v[2]; h[4 * i4 + 3] = v[3]; } }
        const float dtb = a.m_dt_bias[hd], Aneg = -__expf(a.m_a_log[hd]), Dh = a.m_d[hd];
        for (int t0 = 0; t0 < L; t0 += 16) {
            const int nt = (L - t0) < 16 ? (L - t0) : 16;
            __syncthreads();
            for (int idx = tid; idx < nt * 320; idx += NTHR) { const int tt = idx / 320, cl = idx - tt * 320;
                const int cx = cl < 64 ? hd * 64 + cl : (cl < 192 ? 2048 + g * 128 + (cl - 64) : 2560 + g * 128 + (cl - 192));
                float acc = a.m_conv_b[cx];
#pragma unroll
                for (int k = 0; k < 4; ++k) { const int t = t0 + tt - 3 + k;
                    const float xv = t >= 0 ? bf2f(ZX[(size_t)(row0 + t) * ZXW + DIN + cx]) : (prompt ? 0.f : a.state_conv[(size_t)(b * 3 + t + 3) * CONVD + cx]);
                    acc += a.m_conv_w[k * CONVD + cx] * xv; }
                cv[tt * 320 + cl] = silu_f(acc); }
            if (tid < nt) { const float dtr = DT[(size_t)(row0 + t0 + tid) * 32 + hd] + dtb; const float dtv = dtr > 20.f ? dtr : log1pf(__expf(dtr)); dts[tid] = dtv; dAs[tid] = __expf(dtv * Aneg); }
            __syncthreads();
            for (int tt = 0; tt < nt; ++tt) {
                const float x = cv[tt * 320 + p], dtv = dts[tt], dA = dAs[tt], xdt = x * dtv;
                const LAS f32x4* Bp = (const LAS f32x4*)(cv + tt * 320 + 64 + nq * 16); const LAS f32x4* Cp = (const LAS f32x4*)(cv + tt * 320 + 192 + nq * 16);
                float acc = 0.f;
#pragma unroll
                for (int i4 = 0; i4 < 4; ++i4) { const f32x4 Bv = Bp[i4], Cv = Cp[i4];
#pragma unroll
                    for (int j = 0; j < 4; ++j) { h[4 * i4 + j] = dA * h[4 * i4 + j] + xdt * Bv[j]; acc += h[4 * i4 + j] * Cv[j]; } }
                acc += __shfl_xor(acc, 1); acc += __shfl_xor(acc, 2); acc += __shfl_xor(acc, 4);
                if (nq == 0) { const float y = acc + Dh * x; const float z = bf2f(ZX[(size_t)(row0 + t0 + tt) * ZXW + hd * 64 + p]); ygs[tt * 64 + p] = y * silu_f(z); }
            }
            __syncthreads();
            for (int idx = tid; idx < nt * 32; idx += NTHR) { const int tt = idx >> 5, pp = (idx & 31) * 2;
                *(unsigned*)(YG + (size_t)(row0 + t0 + tt) * DIN + hd * 64 + pp) = pk2(ygs[tt * 64 + pp], ygs[tt * 64 + pp + 1]); }
            for (int tt = wave; tt < nt; tt += NWAVES) { const float v = ygs[tt * 64 + lane]; const float s = wave_sum(v * v); if (lane == 0) SSQ[(size_t)(row0 + t0 + tt) * 32 + hd] = s; }
        }
#pragma unroll
        for (int i4 = 0; i4 < 4; ++i4) { f32x4 v = {h[4 * i4], h[4 * i4 + 1], h[4 * i4 + 2], h[4 * i4 + 3]}; *(f32x4*)(sdst + 4 * i4) = v; }
    }
}

__device__ __forceinline__ void norm_phase(const Args& a, int G) {
    using namespace cfg;
    const bf16* YG = (const bf16*)(a.ws + WS_YG); const float* SSQ = (const float*)(a.ws + WS_SSQ); bf16* YN = (bf16*)(a.ws + WS_YN);
    const size_t gt = (size_t)blockIdx.x * NTHR + threadIdx.x, NT = (size_t)G * NTHR;
    for (size_t i = gt; i < (size_t)M * DIN / 8; i += NT) { const size_t row = i >> 8; const int c8 = (int)(i & 255), g = c8 >> 6;
        const f32x4 s0 = *(const f32x4*)(SSQ + row * 32 + g * 8), s1 = *(const f32x4*)(SSQ + row * 32 + g * 8 + 4);
        const float ms = ((s0[0] + s0[1]) + (s0[2] + s0[3]) + (s1[0] + s1[1]) + (s1[2] + s1[3])) * (1.f / 512.f);
        const float r = 1.f / sqrtf(ms + RMS_EPS);
        const v4u v = *(const v4u*)(YG + i * 8); v4u o;
        o.x = pk2(bflo(v.x) * r, bfhi(v.x) * r); o.y = pk2(bflo(v.y) * r, bfhi(v.y) * r); o.z = pk2(bflo(v.z) * r, bfhi(v.z) * r); o.w = pk2(bflo(v.w) * r, bfhi(v.w) * r);
        *(v4u*)(YN + i * 8) = o; }
}

__device__ __forceinline__ void ln_phase(const float* PRE, const float* gam, const float* bet, float* outF, bf16* outB, int G) {
    using namespace cfg;
    const int lane = threadIdx.x & 63, wave = threadIdx.x >> 6;
    f32x4 gv[4], bv[4];
#pragma unroll
    for (int j = 0; j < 4; ++j) { gv[j] = *(const f32x4*)(gam + 4 * lane + 256 * j); bv[j] = *(const f32x4*)(bet + 4 * lane + 256 * j); }
    for (int row = blockIdx.x * NWAVES + wave; row < M; row += G * NWAVES) {
        const float* xr = PRE + (size_t)row * DM + 4 * lane; f32x4 v[4]; float s = 0.f;
#pragma unroll
        for (int j = 0; j < 4; ++j) { v[j] = *(const f32x4*)(xr + 256 * j); s += (v[j][0] + v[j][1]) + (v[j][2] + v[j][3]); }
        const float mean = wave_sum(s) * (1.f / DM); float s2 = 0.f;
#pragma unroll
        for (int j = 0; j < 4; ++j) { v[j] = v[j] - mean; s2 += (v[j][0] * v[j][0] + v[j][1] * v[j][1]) + (v[j][2] * v[j][2] + v[j][3] * v[j][3]); }
        const float rstd = 1.f / sqrtf(wave_sum(s2) * (1.f / DM) + LN_EPS);
#pragma unroll
        for (int j = 0; j < 4; ++j) { const f32x4 o = v[j] * rstd * gv[j] + bv[j]; *(f32x4*)(outF + (size_t)row * DM + 4 * lane + 256 * j) = o;
            if (outB) { v2u w; w.x = pk2(o[0], o[1]); w.y = pk2(o[2], o[3]); *(v2u*)(outB + (size_t)row * DM + 4 * lane + 256 * j) = w; } }
    }
}

__device__ __forceinline__ void cmp2_phase(const Args& a, LAS unsigned char* lds, int G) {
    using namespace cfg;
    const int tid = threadIdx.x;
    LAS float* w2s = (LAS float*)lds;
    LAS float* pcs = w2s + 2 * 128 * 64;
    LAS float* hs = pcs + 256;
    const float* P = (const float*)(a.ws + WS_PCMP); const float* pec = (const float*)(a.ws + WS_PEC);
    for (int i = tid; i < 2 * 128 * 64; i += NTHR) w2s[i] = a.cmp_w2[i];
    if (tid < 256) { float s = 0.f; for (int sl = 0; sl < 32; ++sl) s += pec[sl * 256 + tid]; pcs[tid] = s; }
    __syncthreads();
    for (int u = blockIdx.x; u < 2 * NCMPROWS / 64; u += G) {
        const size_t r0 = (size_t)u * 64; const int kv = r0 >= (size_t)NCMPROWS ? 1 : 0;
        __syncthreads();
        for (int i = tid; i < 64 * 128; i += NTHR) { const int rl = i >> 7, e = i & 127; const size_t r = r0 + rl; const int c = (int)(r & 127);
            float hv = 0.f; if (c < 127) hv = silu_f(P[r * 256 + e] + P[(r + 1) * 256 + 128 + e] + pcs[kv * 128 + e]);
            hs[rl * 129 + e] = hv; }
        __syncthreads();
        const int rl = tid >> 3, dq = tid & 7; float o[8];
#pragma unroll
        for (int j = 0; j < 8; ++j) o[j] = 0.f;
        for (int e = 0; e < 128; ++e) { const float s = hs[rl * 129 + e]; const LAS f32x4* wp = (const LAS f32x4*)(w2s + (kv * 128 + e) * 64 + dq * 8); const f32x4 w0 = wp[0], w1 = wp[1];
            o[0] += s * w0[0]; o[1] += s * w0[1]; o[2] += s * w0[2]; o[3] += s * w0[3]; o[4] += s * w1[0]; o[5] += s * w1[1]; o[6] += s * w1[2]; o[7] += s * w1[3]; }
        bf16* dst = (bf16*)(a.ws + (kv ? WS_VC : WS_KC)) + ((r0 - (size_t)kv * NCMPROWS) + rl) * 64 + dq * 8;
        v4u w; w.x = pk2(o[0], o[1]); w.y = pk2(o[2], o[3]); w.z = pk2(o[4], o[5]); w.w = pk2(o[6], o[7]); *(v4u*)dst = w;
    }
}

__device__ __forceinline__ void ld16(const void* p, bool isf32, float (&o)[16]) {
    if (isf32) { const f32x4* q = (const f32x4*)p;
#pragma unroll
        for (int i = 0; i < 4; ++i) { const f32x4 v = q[i]; o[4 * i] = v[0]; o[4 * i + 1] = v[1]; o[4 * i + 2] = v[2]; o[4 * i + 3] = v[3]; } }
    else { const v4u* q = (const v4u*)p;
#pragma unroll
        for (int i = 0; i < 2; ++i) { const v4u v = q[i]; o[8 * i] = bflo(v.x); o[8 * i + 1] = bfhi(v.x); o[8 * i + 2] = bflo(v.y); o[8 * i + 3] = bfhi(v.y); o[8 * i + 4] = bflo(v.z); o[8 * i + 5] = bfhi(v.z); o[8 * i + 6] = bflo(v.w); o[8 * i + 7] = bfhi(v.w); } }
}
#define WSYNC() asm volatile("s_waitcnt lgkmcnt(0)" ::: "memory")

template <bool PROMPT>
__device__ __forceinline__ void attn_item(const Args& a, int b, int g, int tg, int lane, const LAS float* bt, LAS float* sc, LAS float* scoreL, LAS int* flagL) {
    using namespace cfg;
    const int tl = lane >> 4, hh = (lane >> 2) & 3, dq = lane & 3, rowl = lane >> 2;
    const int t = tg * 4 + tl, pos = PROMPT ? t : PAST + t, row = PROMPT ? b * SEQ + t : MP + b * DS + t, head = g * 4 + hh;
    const int posmax = (PROMPT ? 0 : PAST) + tg * 4 + 3, posmin = posmax - 3;
    const bf16* KVB = (const bf16*)(a.ws + WS_KVB);
    float q[16]; ld16((const bf16*)(a.ws + WS_QB) + (size_t)row * DM + head * 64 + dq * 16, false, q);
    const float* gp = (const float*)(a.ws + WS_GATES) + (size_t)row * 48 + head * 3; const float g0 = gp[0], g1 = gp[1], g2 = gp[2];
    const LAS float* btr = bt + head * 128;
    float out[16];
    {
        const size_t cb = ((size_t)((PROMPT ? DB + b : b) * 4 + g) * 128) * 64;
        const bf16* KCb = (const bf16*)(a.ws + WS_KC) + cb; const bf16* VCb = (const bf16*)(a.ws + WS_VC) + cb;
        int ncw = posmax >= 31 ? ((posmax - 31) >> 4) + 1 : 0; if (ncw > 127) ncw = 127;
        float m = -1e30f;
        for (int c = 0; c < ncw; ++c) { float k[16]; ld16(KCb + c * 64 + dq * 16, false, k); float s = 0.f;
#pragma unroll
            for (int i = 0; i < 16; ++i) s += q[i] * k[i];
            s += __shfl_xor(s, 1); s += __shfl_xor(s, 2);
            const int dist = pos - (16 * c + 31); s = dist >= 0 ? s + btr[dist < 127 ? dist : 127] : -1e30f;
            if (dq == 0) sc[rowl * 128 + c] = s; m = fmaxf(m, s); }
        WSYNC();
        float l = 0.f;
        for (int c = dq; c < ncw; c += 4) { const float s = sc[rowl * 128 + c]; const float e = s > -1e29f ? exp2f(s - m) : 0.f; sc[rowl * 128 + c] = e; l += e; }
        l += __shfl_xor(l, 1); l += __shfl_xor(l, 2);
        const float inv = l > 0.f ? 1.f / l : 0.f;
        WSYNC();
        float oc[16];
#pragma unroll
        for (int i = 0; i < 16; ++i) oc[i] = 0.f;
        for (int c = 0; c < ncw; ++c) { const float pv = sc[rowl * 128 + c] * inv; float v[16]; ld16(VCb + c * 64 + dq * 16, false, v);
#pragma unroll
            for (int i = 0; i < 16; ++i) oc[i] += pv * v[i]; }
        WSYNC();
        if (dq == 0) scoreL[144 + rowl] = inv;
        WSYNC();
        const int nsel = PROMPT ? 32 : 33, j = lane & 15, blk = pos >> 6;
        for (int s = j; s < nsel; s += 16) { float imp = 0.f;
#pragma unroll
            for (int h2 = 0; h2 < 4; ++h2) { const float iv = scoreL[144 + tl * 4 + h2]; float sm = 0.f;
#pragma unroll
                for (int c = 4 * s - 1; c <= 4 * s + 3; ++c) if (c >= 0 && c < ncw) sm += sc[(tl * 4 + h2) * 128 + c];
                imp += sm * iv; }
            const bool valid = s * 64 <= pos, forced = (s == 0) || (s == blk) || (s == blk - 1);
            scoreL[tl * 36 + s] = valid ? imp + (forced ? 1000.f : 0.f) : -1.f; }
        WSYNC();
        for (int s = j; s < nsel; s += 16) { const float my = scoreL[tl * 36 + s]; int rank = 0;
            for (int s2 = 0; s2 < nsel; ++s2) { const float o = scoreL[tl * 36 + s2]; rank += ((o > my) || (o == my && s2 < s)) ? 1 : 0; }
            flagL[tl * 36 + s] = rank < 16 ? 1 : 0; }
        WSYNC();
#pragma unroll
        for (int i = 0; i < 16; ++i) out[i] = g0 * oc[i];
    }
    {
        float ms = -1e30f, ls = 0.f, os[16];
#pragma unroll
        for (int i = 0; i < 16; ++i) os[i] = 0.f;
        const int nblk = (posmax >> 6) + 1;
        for (int s = 0; s < nblk; ++s) {
            const int fl = flagL[tl * 36 + s];
            if (!__any(fl)) continue;
            int kend = posmax - s * 64 + 1; if (kend > 64) kend = 64;
            for (int kk = 0; kk < kend; ++kk) { const int kpos = s * 64 + kk;
                const void* kp; const void* vp; bool f32src = false;
                if (PROMPT) { const bf16* r = KVB + (size_t)(b * SEQ + kpos) * KVW + 512 + g * 64 + dq * 16; kp = r; vp = r + 256; }
                else if (kpos < PAST) { const int page = a.page_table[b * NPAGE + (kpos >> 7)]; const float* r = a.cache_sel + ((size_t)page * PAGE + (kpos & 127)) * 512 + g * 64 + dq * 16; kp = r; vp = r + 256; f32src = true; }
                else { const bf16* r = KVB + (size_t)(MP + b * DS + kpos - PAST) * KVW + 512 + g * 64 + dq * 16; kp = r; vp = r + 256; }
                float k[16]; ld16(kp, f32src, k); float sd = 0.f;
#pragma unroll
                for (int i = 0; i < 16; ++i) sd += q[i] * k[i];
                sd += __shfl_xor(sd, 1); sd += __shfl_xor(sd, 2);
                float v[16]; ld16(vp, f32src, v);
                if (fl && kpos <= pos) { const int dist = pos - kpos; const float sv = sd + btr[dist < 127 ? dist : 127];
                    if (sv > ms) { const float corr = exp2f(ms - sv); ls *= corr;
#pragma unroll
                        for (int i = 0; i < 16; ++i) os[i] *= corr;
                        ms = sv; }
                    const float pv = exp2f(sv - ms); ls += pv;
#pragma unroll
                    for (int i = 0; i < 16; ++i) os[i] += pv * v[i]; }
            }
        }
        const float sc1 = g1 / ls;
#pragma unroll
        for (int i = 0; i < 16; ++i) out[i] += sc1 * os[i];
    }
    {
        float ms = -1e30f, ls = 0.f, os[16];
#pragma unroll
        for (int i = 0; i < 16; ++i) os[i] = 0.f;
        int kstart = posmin - 511; if (kstart < 0) kstart = 0;
        for (int kpos = kstart; kpos <= posmax; ++kpos) {
            const void* kp; const void* vp; bool f32src = false;
            if (PROMPT) { const bf16* r = KVB + (size_t)(b * SEQ + kpos) * KVW + 1024 + g * 64 + dq * 16; kp = r; vp = r + 256; }
            else if (kpos < PAST) { const float* r = a.cache_win + ((size_t)b * 512 + (kpos - (PAST - 512))) * 512 + g * 64 + dq * 16; kp = r; vp = r + 256; f32src = true; }
            else { const bf16* r = KVB + (size_t)(MP + b * DS + kpos - PAST) * KVW + 1024 + g * 64 + dq * 16; kp = r; vp = r + 256; }
            float k[16]; ld16(kp, f32src, k); float sd = 0.f;
#pragma unroll
            for (int i = 0; i < 16; ++i) sd += q[i] * k[i];
            sd += __shfl_xor(sd, 1); sd += __shfl_xor(sd, 2);
            float v[16]; ld16(vp, f32src, v);
            const int dist = pos - kpos;
            if (dist >= 0 && dist < 512) { const float sv = sd + btr[dist < 127 ? dist : 127];
                if (sv > ms) { const float corr = exp2f(ms - sv); ls *= corr;
#pragma unroll
                    for (int i = 0; i < 16; ++i) os[i] *= corr;
                    ms = sv; }
                const float pv = exp2f(sv - ms); ls += pv;
#pragma unroll
                for (int i = 0; i < 16; ++i) os[i] += pv * v[i]; }
        }
        const float sc2 = g2 / ls;
#pragma unroll
        for (int i = 0; i < 16; ++i) out[i] += sc2 * os[i];
    }
    bf16* op = (bf16*)(a.ws + WS_OB) + (size_t)row * DM + head * 64 + dq * 16;
    v4u w0, w1; w0.x = pk2(out[0], out[1]); w0.y = pk2(out[2], out[3]); w0.z = pk2(out[4], out[5]); w0.w = pk2(out[6], out[7]);
    w1.x = pk2(out[8], out[9]); w1.y = pk2(out[10], out[11]); w1.z = pk2(out[12], out[13]); w1.w = pk2(out[14], out[15]);
    *(v4u*)op = w0; *(v4u*)(op + 8) = w1;
}

__device__ __forceinline__ void attn_phase(const Args& a, LAS unsigned char* lds, int G) {
    using namespace cfg;
    const int tid = threadIdx.x, lane = tid & 63, wave = tid >> 6;
    LAS float* bt = (LAS float*)lds;
    LAS float* sc = (LAS float*)(lds + 8192 + wave * 9728);
    LAS float* scoreL = sc + 16 * 128;
    LAS int* flagL = (LAS int*)(scoreL + 160);
    for (int i = tid; i < 16 * 128; i += NTHR) { const int h = i >> 7, d = i & 127;
        int bucket = d; if (d >= 16) { bucket = 16 + (int)(__logf((float)d / 16.f) / 2.0794415416798357f * 16.f); if (bucket > 31) bucket = 31; }
        bt[i] = a.rel_bias[bucket * 16 + h] * LOG2E; }
    __syncthreads();
    for (int v = blockIdx.x; v < 2048 + 128; v += G) {
        if (v < 2048) { const int j = v >> 8, k = v & 255, bg = k >> 3, r = k & 7;
            const int uidx = (j >> 1) * 16 + ((j & 1) ? 15 - r : r);
            attn_item<true>(a, bg >> 2, bg & 3, uidx * 8 + wave, lane, bt, sc, scoreL, flagL); }
        else { const int bs = v - 2048; attn_item<false>(a, bs, wave >> 1, wave & 1, lane, bt, sc, scoreL, flagL); }
    }
}

typedef short bf16x8 __attribute__((ext_vector_type(8)));
typedef short s16x4 __attribute__((ext_vector_type(4)));
typedef short v4i16_t __attribute__((ext_vector_type(4)));
typedef float f32x16 __attribute__((ext_vector_type(16)));
#define NEG_INF (-__builtin_inff())
__device__ __forceinline__ s16x4 vtr(const LAS unsigned char* p) { return __builtin_bit_cast(s16x4, __builtin_amdgcn_ds_read_tr16_b64_v4i16((LAS v4i16_t*)p)); }
__device__ __forceinline__ unsigned cvtpk(float lo, float hi) { unsigned r; asm volatile("v_cvt_pk_bf16_f32 %0, %1, %2" : "=v"(r) : "v"(lo), "v"(hi)); return r; }
constexpr int AT_BT = 0, AT_KS = 8192, AT_VS = 40960, AT_SC = 73728, AT_END = 81920;

__device__ __forceinline__ void tile_ld(const bf16* Kg, const bf16* Vg, int pitch, int wid, int lane, v4u& kr, v4u& vr) {
    kr = *(const v4u*)(Kg + (size_t)lane * pitch + wid * 8);
    vr = *(const v4u*)(Vg + (size_t)(16 * (wid & 3) + (lane >> 2)) * pitch + (wid >> 2) * 32 + (lane & 3) * 8);
}
__device__ __forceinline__ void tile_st(LAS unsigned char* lds, int slot, int wid, int lane, const v4u& kr, const v4u& vr) {
    *(LAS v4u*)(lds + AT_KS + slot * 8192 + wid * 1024 + lane * 16) = kr;
    *(LAS v4u*)(lds + AT_VS + slot * 8192 + wid * 1024 + lane * 16) = vr;
}
__device__ __forceinline__ void qk_tile(const LAS unsigned char* lds, int slot, const bf16x8 (&qf)[4], int r32, int hi, f32x16& p0, f32x16& p1) {
    const LAS unsigned char* kp = lds + AT_KS + slot * 8192 + hi * 1024 + r32 * 16;
    p0 = f32x16{}; p1 = f32x16{};
#pragma unroll
    for (int j = 0; j < 4; ++j) { const bf16x8 k0 = *(const LAS bf16x8*)(kp + j * 2048), k1 = *(const LAS bf16x8*)(kp + j * 2048 + 512);
        p0 = __builtin_amdgcn_mfma_f32_32x32x16_bf16(k0, qf[j], p0, 0, 0, 0); p1 = __builtin_amdgcn_mfma_f32_32x32x16_bf16(k1, qf[j], p1, 0, 0, 0); }
}
__device__ __forceinline__ void pv_tile(const LAS unsigned char* lds, int slot, int lane, int hi, const f32x16& p0, const f32x16& p1, f32x16 (&o)[2]) {
    const LAS unsigned char* vp = lds + AT_VS + slot * 8192 + ((lane >> 4) & 1) * 32 + (lane & 3) * 8 + (4 * hi + ((lane & 15) >> 2)) * 64;
    bf16x8 pf[4];
#pragma unroll
    for (int k = 0; k < 4; ++k) { const f32x16& p = (k < 2) ? p0 : p1; const int b0 = (k & 1) * 8; v4u w;
        w.x = cvtpk(p[b0], p[b0 + 1]); w.y = cvtpk(p[b0 + 2], p[b0 + 3]); w.z = cvtpk(p[b0 + 4], p[b0 + 5]); w.w = cvtpk(p[b0 + 6], p[b0 + 7]); pf[k] = __builtin_bit_cast(bf16x8, w); }
#pragma unroll
    for (int db = 0; db < 2; ++db)
#pragma unroll
        for (int ks = 0; ks < 4; ++ks) { const s16x4 lo = vtr(vp + db * 4096 + ks * 1024), hv = vtr(vp + db * 4096 + ks * 1024 + 512);
            const bf16x8 vf = {lo[0], lo[1], lo[2], lo[3], hv[0], hv[1], hv[2], hv[3]};
            o[db] = __builtin_amdgcn_mfma_f32_32x32x16_bf16(vf, pf[ks], o[db], 0, 0, 0); }
}

template <int MODE>
__device__ __forceinline__ void flash_branch(LAS unsigned char* lds, const bf16* Kg, const bf16* Vg, int kt0, int kt1, const bf16x8 (&qf)[4], int pos, int posmin, int posmax,
                                             const LAS float* btr, float b31, unsigned selmask, float gate, f32x16 (&oacc)[2], int wid, int lane) {
    const int r32 = lane & 31, hi = lane >> 5;
    float m = NEG_INF, l = 0.f; f32x16 o[2]; o[0] = f32x16{}; o[1] = f32x16{};
    v4u kr, vr;
    __syncthreads();
    tile_ld(Kg + (size_t)kt0 * 64 * cfg::KVW, Vg + (size_t)kt0 * 64 * cfg::KVW, cfg::KVW, wid, lane, kr, vr);
    tile_st(lds, 0, wid, lane, kr, vr);
    __syncthreads();
    for (int kt = kt0; kt <= kt1; ++kt) {
        const int slot = (kt - kt0) & 1;
        if (kt < kt1) tile_ld(Kg + (size_t)(kt + 1) * 64 * cfg::KVW, Vg + (size_t)(kt + 1) * 64 * cfg::KVW, cfg::KVW, wid, lane, kr, vr);
        const bool flag = (MODE == 1) ? ((selmask >> kt) & 1u) != 0u : true;
        const bool wave_on = (MODE == 1) ? (__any(flag) != 0) : (posmin - (kt * 64 + 63) < 512);
        if (wave_on) {
            f32x16 p0, p1; qk_tile(lds, slot, qf, r32, hi, p0, p1);
            const bool near = (posmin - (kt * 64 + 63)) < 113;
            const int dbase = pos - kt * 64 - 4 * hi;
            float tmax = NEG_INF;
            if (near) {
#pragma unroll
                for (int r = 0; r < 16; ++r) { const int d0 = dbase - ((r & 3) + 8 * (r >> 2)), d1 = d0 - 32;
                    const bool ok0 = flag && d0 >= 0 && (MODE == 1 || d0 < 512), ok1 = flag && d1 >= 0 && (MODE == 1 || d1 < 512);
                    const float b0 = btr[d0 < 0 ? 0 : (d0 > 127 ? 127 : d0)], b1 = btr[d1 < 0 ? 0 : (d1 > 127 ? 127 : d1)];
                    p0[r] = ok0 ? p0[r] + b0 : NEG_INF; p1[r] = ok1 ? p1[r] + b1 : NEG_INF;
                    tmax = fmaxf(tmax, fmaxf(p0[r], p1[r])); }
            } else {
#pragma unroll
                for (int r = 0; r < 16; ++r) { const int d0 = dbase - ((r & 3) + 8 * (r >> 2)), d1 = d0 - 32;
                    const bool ok0 = flag && (MODE == 1 || d0 < 512), ok1 = flag && (MODE == 1 || d1 < 512);
                    p0[r] = ok0 ? p0[r] + b31 : NEG_INF; p1[r] = ok1 ? p1[r] + b31 : NEG_INF;
                    tmax = fmaxf(tmax, fmaxf(p0[r], p1[r])); }
            }
            tmax = fmaxf(tmax, __shfl_xor(tmax, 32));
            const float mn = fmaxf(m, tmax), ms = (mn == NEG_INF) ? 0.f : mn;
            const float corr = __builtin_amdgcn_exp2f(m - ms);
            float sum = 0.f;
#pragma unroll
            for (int r = 0; r < 16; ++r) { p0[r] = __builtin_amdgcn_exp2f(p0[r] - ms); p1[r] = __builtin_amdgcn_exp2f(p1[r] - ms); sum += p0[r] + p1[r]; }
            l = l * corr + sum; m = mn;
#pragma unroll
            for (int r = 0; r < 16; ++r) { o[0][r] *= corr; o[1][r] *= corr; }
            pv_tile(lds, slot, lane, hi, p0, p1, o);
        }
        if (kt < kt1) tile_st(lds, slot ^ 1, wid, lane, kr, vr);
        __syncthreads();
    }
    l += __shfl_xor(l, 32);
    const float sc = l > 0.f ? gate / l : 0.f;
#pragma unroll
    for (int r = 0; r < 16; ++r) { oacc[0][r] += sc * o[0][r]; oacc[1][r] += sc * o[1][r]; }
}

__device__ __forceinline__ void attn_mfma_unit(const Args& a, int b, int g, int qt, LAS unsigned char* lds) {
    using namespace cfg;
    const int tid = threadIdx.x, lane = tid & 63, r32 = lane & 31, hi = lane >> 5;
    const int wid = __builtin_amdgcn_readfirstlane(tid >> 6);
    LAS float* scoreL = (LAS float*)(lds + AT_SC + wid * 1024);
    const int tokl = r32 >> 2, hh = r32 & 3, head = g * 4 + hh;
    const int posmin = qt * 64 + wid * 8, posmax = posmin + 7, pos = posmin + tokl, row = b * SEQ + pos;
    const LAS float* btr = (const LAS float*)(lds + AT_BT) + head * 128;
    const float b31 = btr[127];
    bf16x8 qf[4];
    { const bf16* qp = (const bf16*)(a.ws + WS_QB) + (size_t)row * DM + head * 64 + hi * 8;
#pragma unroll
      for (int s = 0; s < 4; ++s) qf[s] = *(const bf16x8*)(qp + 16 * s); }
    const float* gp = (const float*)(a.ws + WS_GATES) + (size_t)row * 48 + head * 3; const float g0 = gp[0], g1 = gp[1], g2 = gp[2];
    f32x16 oacc[2]; oacc[0] = f32x16{}; oacc[1] = f32x16{};
    unsigned selmask = 0u;
    {
        const size_t cb = ((size_t)((DB + b) * 4 + g) * 128) * 64;
        const bf16* KCb = (const bf16*)(a.ws + WS_KC) + cb; const bf16* VCb = (const bf16*)(a.ws + WS_VC) + cb;
        const int posmaxu = qt * 64 + 63; int ncu = ((posmaxu - 31) >> 4) + 1; if (ncu > 127) ncu = 127;
        const int ntile = (ncu + 63) >> 6;
        v4u kr, vr;
        __syncthreads();
        for (int tl = 0; tl < ntile; ++tl) { tile_ld(KCb + tl * 64 * 64, VCb + tl * 64 * 64, 64, wid, lane, kr, vr); tile_st(lds, tl, wid, lane, kr, vr); }
        __syncthreads();
        f32x16 p[4]; p[2] = f32x16{}; p[3] = f32x16{};
        qk_tile(lds, 0, qf, r32, hi, p[0], p[1]);
        if (ntile > 1) qk_tile(lds, 1, qf, r32, hi, p[2], p[3]);
        float mx = NEG_INF;
#pragma unroll
        for (int u = 0; u < 4; ++u)
#pragma unroll
            for (int r = 0; r < 16; ++r) { const int c = 32 * u + (r & 3) + 8 * (r >> 2) + 4 * hi; const int d = pos - 31 - 16 * c;
                const float bv = btr[d < 0 ? 0 : (d > 127 ? 127 : d)];
                p[u][r] = d >= 0 ? p[u][r] + bv : NEG_INF; mx = fmaxf(mx, p[u][r]); }
        mx = fmaxf(mx, __shfl_xor(mx, 32));
        const float ms = (mx == NEG_INF) ? 0.f : mx;
        float l = 0.f;
#pragma unroll
        for (int u = 0; u < 4; ++u)
#pragma unroll
            for (int r = 0; r < 16; ++r) { p[u][r] = __builtin_amdgcn_exp2f(p[u][r] - ms); l += p[u][r]; }
        l += __shfl_xor(l, 32);
        const float inv = l > 0.f ? 1.f / l : 0.f;
#pragma unroll
        for (int u = 0; u < 4; ++u)
#pragma unroll
            for (int r = 0; r < 16; ++r) p[u][r] *= inv;
        {
            float X[4][4];
#pragma unroll
            for (int u = 0; u < 4; ++u)
#pragma unroll
                for (int jq = 0; jq < 4; ++jq) X[u][jq] = __shfl_xor(p[u][4 * jq + 3], 32);
            const int blk = pos >> 6;
#pragma unroll
            for (int u = 0; u < 4; ++u)
#pragma unroll
                for (int jq = 0; jq < 4; ++jq) {
                    const float Gq = (p[u][4 * jq] + p[u][4 * jq + 1]) + (p[u][4 * jq + 2] + p[u][4 * jq + 3]);
                    const float xprev = (jq > 0) ? X[u][jq - 1] : (u > 0 ? X[u - 1][3] : 0.f);
                    float imp = Gq + (hi ? X[u][jq] : xprev);
                    imp += __shfl_xor(imp, 1); imp += __shfl_xor(imp, 2);
                    const int s = 8 * u + 2 * jq + hi;
                    const bool valid = s * 64 <= pos, forced = (s == 0) || (s == blk) || (s == blk - 1);
                    const float score = valid ? imp + (forced ? 1000.f : 0.f) : -1.f;
                    if (hh == 0) scoreL[tokl * 32 + s] = score;
                }
            WSYNC();
            const int tk = lane >> 3, i8 = lane & 7;
            float sc32[32];
#pragma unroll
            for (int q4 = 0; q4 < 8; ++q4) { const f32x4 v = *(const LAS f32x4*)(scoreL + tk * 32 + 4 * q4); sc32[4 * q4] = v[0]; sc32[4 * q4 + 1] = v[1]; sc32[4 * q4 + 2] = v[2]; sc32[4 * q4 + 3] = v[3]; }
#pragma unroll
            for (int j = 0; j < 4; ++j) { const int s = 8 * j + i8; const float my = scoreL[tk * 32 + s]; int rank = 0;
#pragma unroll
                for (int s2 = 0; s2 < 32; ++s2) rank += ((sc32[s2] > my) || (sc32[s2] == my && s2 < s)) ? 1 : 0;
                const unsigned long long bal = __ballot(rank < 16);
                selmask |= ((unsigned)(bal >> (8 * tokl)) & 0xffu) << (8 * j); }
            WSYNC();
        }
        f32x16 o[2]; o[0] = f32x16{}; o[1] = f32x16{};
        pv_tile(lds, 0, lane, hi, p[0], p[1], o);
        if (ntile > 1) pv_tile(lds, 1, lane, hi, p[2], p[3], o);
#pragma unroll
        for (int r = 0; r < 16; ++r) { oacc[0][r] = g0 * o[0][r]; oacc[1][r] = g0 * o[1][r]; }
    }
    const bf16* KVB = (const bf16*)(a.ws + WS_KVB) + (size_t)b * SEQ * KVW + g * 64;
    flash_branch<1>(lds, KVB + 512, KVB + 768, 0, qt, qf, pos, posmin, posmax, btr, b31, selmask, g1, oacc, wid, lane);
    flash_branch<2>(lds, KVB + 1024, KVB + 1280, qt >= 8 ? qt - 8 : 0, qt, qf, pos, posmin, posmax, btr, b31, 0u, g2, oacc, wid, lane);
    bf16* op = (bf16*)(a.ws + WS_OB) + (size_t)row * DM + head * 64 + 4 * hi;
#pragma unroll
    for (int db = 0; db < 2; ++db)
#pragma unroll
        for (int jq = 0; jq < 4; ++jq) { v2u w; w.x = cvtpk(oacc[db][4 * jq], oacc[db][4 * jq + 1]); w.y = cvtpk(oacc[db][4 * jq + 2], oacc[db][4 * jq + 3]);
            *(v2u*)(op + 32 * db + 8 * jq) = w; }
}

__device__ __forceinline__ void attn_phase2(const Args& a, LAS unsigned char* lds, int G) {
    using namespace cfg;
    const int tid = threadIdx.x, lane = tid & 63, wave = tid >> 6;
    LAS float* bt = (LAS float*)(lds + AT_BT);
    for (int i = tid; i < 16 * 128; i += NTHR) { const int h = i >> 7, d = i & 127;
        int bucket = d; if (d >= 16) { bucket = 16 + (int)(__logf((float)d / 16.f) / 2.0794415416798357f * 16.f); if (bucket > 31) bucket = 31; }
        bt[i] = a.rel_bias[bucket * 16 + h] * LOG2E; }
    __syncthreads();
    for (int v = blockIdx.x; v < 1024; v += G) { const int j = v >> 8, k = v & 255, bg = k >> 3, r = k & 7;
        const int qt = (j == 0) ? 31 - r : (j == 1) ? 16 + r : (j == 2) ? 15 - r : r;
        attn_mfma_unit(a, bg >> 2, bg & 3, qt, lds); }
    __syncthreads();
    LAS float* sc = (LAS float*)(lds + 8192 + wave * 9728); LAS float* scoreL = sc + 16 * 128; LAS int* flagL = (LAS int*)(scoreL + 160);
    for (int bs = blockIdx.x; bs < DB; bs += G) attn_item<false>(a, bs, wave >> 1, wave & 1, lane, bt, sc, scoreL, flagL);
}

constexpr int N_PHASES = 18;
__global__ void __launch_bounds__(NTHR, 2) yoco_fwd(Args args) {
    using namespace cfg;
    extern __shared__ __attribute__((aligned(16))) unsigned char lds_raw[];
    LAS unsigned char* lds = (LAS unsigned char*)lds_raw;
    const int tid = threadIdx.x, G = gridDim.x;
    unsigned char* ws = args.ws;
    for (int u = tid; u < (LDS_BYTES - RING_BYTES) / 4; u += NTHR) ((LAS unsigned*)(lds + RING_BYTES))[u] = 0u;
    __syncthreads();
    const bool one_launch = (args.ph_hi - args.ph_lo) > 1;
    XcdBarrier bar; bar.bar = (unsigned*)(ws + WS_CTL) + CW_BAR; bar.x = 0; bar.st = nullptr;
    if (one_launch) bar = xcd_barrier_post((unsigned*)(ws + WS_CTL) + CW_BAR, (volatile LAS unsigned*)(lds + MISC_OFF) + 8);
    const int lo = args.ph_lo, hi = args.ph_hi;
#define IN(k) (lo <= (k) && (k) < hi)
#define SEAM(k) do { if (IN(k) && IN((k) + 1)) xcd_barrier(bar); } while (0)
    bf16* const XB = (bf16*)(ws + WS_XB); bf16* const HAB = (bf16*)(ws + WS_HAB); bf16* const HBB = (bf16*)(ws + WS_HBB); bf16* const HFF = (bf16*)(ws + WS_HFF);
    float* const PRE = (float*)(ws + WS_PRE); float* const HA = (float*)(ws + WS_HA); float* const HB = (float*)(ws + WS_HB);

    if (IN(0)) { p0_prologue(args, lds, G); SEAM(0); }
    if (IN(1)) { pg8::Gemm g{XB, (const bf16*)(ws + WS_WIN), M, INPAD, DM}; pg8::StaticOrder S; S.init(M, INPAD, G, (int)blockIdx.x);
        pg8::EpiIn E{(bf16*)(ws + WS_ZX), (float*)(ws + WS_DT), args.out + O_PCONV, args.out + O_SCONV};
        pg8::gemm_phase<pg8::EpiIn, pg8::StaticOrder, true, true>(lds, g, S, E); SEAM(1); }
    if (IN(2)) { scan_phase(args, lds, G); SEAM(2); }
    if (IN(3)) { norm_phase(args, G); SEAM(3); }
    if (IN(4)) { pg8::Gemm g{(const bf16*)(ws + WS_YN), (const bf16*)(ws + WS_WOUT), M, DM, DIN}; pg8::StaticOrder S; S.init(M, DM, G, (int)blockIdx.x);
        pg8::EpiRes E{PRE, args.x_prompt, args.x_sample - (size_t)MP * DM};
        pg8::gemm_phase<pg8::EpiRes, pg8::StaticOrder, true, true>(lds, g, S, E); SEAM(4); }
    if (IN(5)) { ln_phase(PRE, args.ln_g + 0 * DM, args.ln_b + 0 * DM, HA, HAB, G); SEAM(5); }
    if (IN(6)) { pg8::Gemm g{HAB, (const bf16*)(ws + WS_W1), M, DFF, DM}; pg8::StaticOrder S; S.init(M, DFF, G, (int)blockIdx.x);
        pg8::EpiRelu2 E{HFF}; pg8::gemm_phase<pg8::EpiRelu2, pg8::StaticOrder, true, true>(lds, g, S, E); SEAM(6); }
    if (IN(7)) { pg8::Gemm g{HFF, (const bf16*)(ws + WS_W2), M, DM, DFF}; pg8::StaticOrder S; S.init(M, DM, G, (int)blockIdx.x);
        pg8::EpiRes E{PRE, HA, HA}; pg8::gemm_phase<pg8::EpiRes, pg8::StaticOrder, true, true>(lds, g, S, E); SEAM(7); }
    if (IN(8)) { ln_phase(PRE, args.ln_g + 1 * DM, args.ln_b + 1 * DM, HB, HBB, G); SEAM(8); }
    if (IN(9)) { pg8::Gemm g{HBB, (const bf16*)(ws + WS_WKVQ), M, KVQN, DM}; pg8::StaticOrder S; S.init(M, KVQN, G, (int)blockIdx.x);
        pg8::EpiKvq E{args.out, (bf16*)(ws + WS_KVB), (bf16*)(ws + WS_QB), (float*)(ws + WS_GATES), (bf16*)(ws + WS_ACMP)};
        pg8::gemm_phase<pg8::EpiKvq, pg8::StaticOrder, true, true>(lds, g, S, E); SEAM(9); }
    if (IN(10)) { pg8::Gemm g{(const bf16*)(ws + WS_ACMP), (const bf16*)(ws + WS_WC1), 2 * NCMPROWS, 512, 1024}; pg8::CmpOrder S{G, (int)blockIdx.x};
        pg8::EpiP E{(float*)(ws + WS_PCMP)}; pg8::gemm_phase<pg8::EpiP, pg8::CmpOrder, true, true>(lds, g, S, E); SEAM(10); }
    if (IN(11)) { cmp2_phase(args, lds, G); SEAM(11); }
    if (IN(12)) { attn_phase2(args, lds, G); SEAM(12); }
    if (IN(13)) { pg8::Gemm g{(const bf16*)(ws + WS_OB), (const bf16*)(ws + WS_WO), M, DM, DM}; pg8::StaticOrder S; S.init(M, DM, G, (int)blockIdx.x);
        pg8::EpiRes E{PRE, HB, HB}; pg8::gemm_phase<pg8::EpiRes, pg8::StaticOrder, true, true>(lds, g, S, E); SEAM(13); }
    if (IN(14)) { ln_phase(PRE, args.ln_g + 2 * DM, args.ln_b + 2 * DM, HA, HAB, G); SEAM(14); }
    if (IN(15)) { pg8::Gemm g{HAB, (const bf16*)(ws + WS_W1) + (size_t)DFF * DM, M, DFF, DM}; pg8::StaticOrder S; S.init(M, DFF, G, (int)blockIdx.x);
        pg8::EpiRelu2 E{HFF}; pg8::gemm_phase<pg8::EpiRelu2, pg8::StaticOrder, true, true>(lds, g, S, E); SEAM(15); }
    if (IN(16)) { pg8::Gemm g{HFF, (const bf16*)(ws + WS_W2) + (size_t)DFF * DM, M, DM, DFF}; pg8::StaticOrder S; S.init(M, DM, G, (int)blockIdx.x);
        pg8::EpiRes E{PRE, HA, HA}; pg8::gemm_phase<pg8::EpiRes, pg8::StaticOrder, true, true>(lds, g, S, E); SEAM(16); }
    if (IN(17)) { ln_phase(PRE, args.ln_g + 3 * DM, args.ln_b + 3 * DM, args.out + O_YP, nullptr, G); }
#undef IN
#undef SEAM
}

extern "C" void kernel_launch(void* const* d_in, const int* in_sizes, int n_in, void* d_out, int out_size, void* d_ws, size_t ws_size, hipStream_t stream) {
    using namespace cfg;
    static int grid = 0;
    if (grid == 0) {
        if (n_in != 27 || (size_t)out_size != O_END || ws_size < WS_END) { fprintf(stderr, "kernel_launch: unexpected shapes (n_in %d, out %d, ws %zu, need %zu); nothing launched\n", n_in, out_size, ws_size, (size_t)WS_END); grid = -1; return; }
        int dev = 0, cus = 0, per_cu = 0;
        if (hipGetDevice(&dev) != hipSuccess || hipDeviceGetAttribute(&cus, hipDeviceAttributeMultiprocessorCount, dev) != hipSuccess) { grid = -1; return; }
        if (hipFuncSetAttribute((const void*)yoco_fwd, hipFuncAttributeMaxDynamicSharedMemorySize, LDS_BYTES) != hipSuccess) { fprintf(stderr, "kernel_launch: hipFuncSetAttribute failed\n"); grid = -1; return; }
        if (hipOccupancyMaxActiveBlocksPerMultiprocessor(&per_cu, (const void*)yoco_fwd, NTHR, LDS_BYTES) != hipSuccess || per_cu < 1) { fprintf(stderr, "kernel_launch: occupancy query says %d blocks per CU\n", per_cu); }
        (void)hipGetLastError();
        grid = cus;
    }
    if (grid < 0) return;
    if (hipMemsetAsync((char*)d_ws + WS_CTL, 0, CTL_ZERO_BYTES, stream) != hipSuccess) { fprintf(stderr, "kernel_launch: memset failed\n"); return; }
    Args a{};
    const float* const* fin = (const float* const*)d_in;
    a.x_prompt = fin[0]; a.x_sample = fin[1]; a.state_ssm = fin[2]; a.state_conv = fin[3]; a.cache_cmp = fin[4]; a.cache_sel = fin[5]; a.cache_win = fin[6]; a.page_table = (const int*)d_in[7];
    a.ln_g = fin[8]; a.ln_b = fin[9]; a.m_in_w = fin[10]; a.m_conv_w = fin[11]; a.m_conv_b = fin[12]; a.m_dt_bias = fin[13]; a.m_a_log = fin[14]; a.m_d = fin[15]; a.m_norm_w = fin[16]; a.m_out_w = fin[17];
    a.kv_w = fin[18]; a.cmp_w1 = fin[19]; a.cmp_pe = fin[20]; a.cmp_w2 = fin[21]; a.q_w = fin[22]; a.o_w = fin[23]; a.rel_bias = fin[24]; a.mlp_w1 = fin[25]; a.mlp_w2 = fin[26];
    a.out = (float*)d_out; a.ws = (unsigned char*)d_ws; a.pad = 0;
    constexpr int NL = (MK_N_LAUNCHES == 1) ? 1 : N_PHASES;
    for (int li = 0; li < NL; ++li) {
        a.ph_lo = (NL == 1) ? 0 : li; a.ph_hi = (NL == 1) ? N_PHASES : li + 1; a.li = li;
        hipLaunchKernelGGL(yoco_fwd, dim3(grid), dim3(NTHR), LDS_BYTES, stream, a);
        const hipError_t le = hipPeekAtLastError();
        if (le != hipSuccess) { fprintf(stderr, "kernel_launch: launch %d failed: %s\n", li, hipGetErrorName(le)); break; }
    }
}
```

```cpp
#include <hip/hip_runtime.h>
#include <cstdio>
#include <cstdint>
#include <type_traits>

#ifndef MK_N_LAUNCHES
#define MK_N_LAUNCHES 1
#endif

namespace cfg {
constexpr int DM = 1024, NPB = 8, SEQ = 2048, DB = 128, DS = 8, PAST = 2048, PAGE = 128, NPAGE = PAST / PAGE;
constexpr int MP = NPB * SEQ, MS = DB * DS, M = MP + MS;
constexpr int DFF = 4096, DIN = 2048, NH = 32, HD = 64, NG = 4, HPG = 8, DST = 128, CONVD = 3072, INDIM = 5152, INPAD = 5376, ZXW = 5120;
constexpr int AH = 16, AKV = 4, AGRP = 4, KVW = 1536, QGW = 1072, KVQN = 2816, KVROW = 512;
constexpr int NCMPROWS = (DB + NPB) * AKV * 128;
constexpr float LN_EPS = 1e-5f, RMS_EPS = 1e-5f;
constexpr float ALPHA = 1.4142135623730951f;
constexpr float LOG2E = 1.4426950408889634f;
constexpr float QSCALE = 0.125f * LOG2E;
constexpr size_t O_YP = 0, O_YS = O_YP + (size_t)MP * DM, O_PSSM = O_YS + (size_t)MS * DM, O_PCONV = O_PSSM + (size_t)NPB * NH * HD * DST,
                 O_PCMP = O_PCONV + (size_t)NPB * 3 * CONVD, O_PSEL = O_PCMP + (size_t)MP * KVROW, O_PWIN = O_PSEL + (size_t)MP * KVROW,
                 O_SSSM = O_PWIN + (size_t)NPB * 512 * KVROW, O_SCONV = O_SSSM + (size_t)DB * NH * HD * DST, O_SCMP = O_SCONV + (size_t)DB * 3 * CONVD,
                 O_SSEL = O_SCMP + (size_t)MS * KVROW, O_SWIN = O_SSEL + (size_t)MS * KVROW, O_END = O_SWIN + (size_t)DB * 512 * KVROW;
static_assert(O_END == 108208128ull, "output size");
constexpr size_t MiB = 1u << 20;
constexpr size_t al(size_t x) { return (x + MiB - 1) / MiB * MiB; }
constexpr size_t WS_CTL = 0, CTL_ZERO_BYTES = MiB;
constexpr size_t WS_WIN = MiB;
constexpr size_t WS_WOUT = WS_WIN + al((size_t)INPAD * DM * 2);
constexpr size_t WS_W1 = WS_WOUT + al((size_t)DM * DIN * 2);
constexpr size_t WS_W2 = WS_W1 + 2 * al((size_t)DFF * DM * 2);
constexpr size_t WS_WKVQ = WS_W2 + 2 * al((size_t)DFF * DM * 2);
constexpr size_t WS_WO = WS_WKVQ + al((size_t)KVQN * DM * 2);
constexpr size_t WS_WC1 = WS_WO + al((size_t)DM * DM * 2);
constexpr size_t WS_PEC = WS_WC1 + al((size_t)512 * 1024 * 2);
constexpr size_t WS_XB = WS_PEC + MiB;
constexpr size_t WS_ZX = WS_XB + al((size_t)M * DM * 2);
constexpr size_t WS_DT = WS_ZX + al((size_t)M * ZXW * 2);
constexpr size_t WS_YG = WS_DT + al((size_t)M * 32 * 4);
constexpr size_t WS_SSQ = WS_YG + al((size_t)M * DIN * 2);
constexpr size_t WS_YN = WS_SSQ + al((size_t)M * 32 * 4);
constexpr size_t WS_PRE = WS_YN + al((size_t)M * DIN * 2);
constexpr size_t WS_HA = WS_PRE + al((size_t)M * DM * 4);
constexpr size_t WS_HB = WS_HA + al((size_t)M * DM * 4);
constexpr size_t WS_HAB = WS_HB + al((size_t)M * DM * 4);
constexpr size_t WS_HBB = WS_HAB + al((size_t)M * DM * 2);
constexpr size_t WS_HFF = WS_HBB + al((size_t)M * DM * 2);
constexpr size_t WS_KVB = WS_HFF + al((size_t)M * DFF * 2);
constexpr size_t WS_QB = WS_KVB + al((size_t)M * KVW * 2);
constexpr size_t WS_GATES = WS_QB + al((size_t)M * DM * 2);
constexpr size_t WS_ACMP = WS_GATES + al((size_t)M * 48 * 4);
constexpr size_t WS_PCMP = WS_ACMP + al((size_t)2 * NCMPROWS * 1024 * 2);
constexpr size_t WS_KC = WS_PCMP + al((size_t)2 * NCMPROWS * 256 * 4);
constexpr size_t WS_VC = WS_KC + al((size_t)NCMPROWS * 64 * 2);
constexpr size_t WS_OB = WS_VC + al((size_t)NCMPROWS * 64 * 2);
constexpr size_t WS_END = WS_OB + al((size_t)M * DM * 2);
constexpr int CW_BAR = 4096;
constexpr int RING_BYTES = 131072, MISC_OFF = RING_BYTES + 320, LDS_BYTES = 147456;
}

#define GAS __attribute__((address_space(1)))
#define LAS __attribute__((address_space(3)))
typedef unsigned short bf16;
typedef unsigned v4u __attribute__((ext_vector_type(4)));
typedef unsigned v2u __attribute__((ext_vector_type(2)));
typedef float f32x4 __attribute__((ext_vector_type(4)));
#define LDS_WAIT() asm volatile("s_waitcnt lgkmcnt(0)" ::: "memory")
#define VM_WAIT() asm volatile("s_waitcnt vmcnt(0)" ::: "memory")
__device__ __forceinline__ unsigned f2bf(float f) { unsigned u = __builtin_bit_cast(unsigned, f); return (u + 0x7fffu + ((u >> 16) & 1u)) >> 16; }
__device__ __forceinline__ unsigned pk2(float lo, float hi) { return f2bf(lo) | (f2bf(hi) << 16); }
__device__ __forceinline__ float bf2f(unsigned short b) { return __builtin_bit_cast(float, ((unsigned)b) << 16); }
__device__ __forceinline__ float bflo(unsigned w) { return __builtin_bit_cast(float, w << 16); }
__device__ __forceinline__ float bfhi(unsigned w) { return __builtin_bit_cast(float, w & 0xffff0000u); }

namespace pg8 {
#define PG8_LAS __attribute__((address_space(3)))
typedef unsigned short bf16_t;
typedef short bf16x8 __attribute__((ext_vector_type(8)));
typedef float f32x4 __attribute__((ext_vector_type(4)));
typedef unsigned u32x4 __attribute__((ext_vector_type(4)));
constexpr int BM = 256, BK = 64, HALF = 128, HTB = HALF * BK * 2  , STAGE_BYTES = 8 * HTB, NXCD = 8, WGM = 8;

__host__ __device__ __forceinline__ int lds_byte(int r, int c) { const int st = (r >> 4) * 2 + (c >> 5), rr = r & 15, cc = c & 31, ob = rr * 64 + cc * 2; return st * 1024 + (ob ^ (((ob >> 9) & 1) << 5)); }
__host__ __device__ __forceinline__ void stage_rc(int b, int& R, int& C) { const int st = b / 1024, sb = b % 1024, swz = sb ^ (((sb >> 9) & 1) << 5); R = (st >> 1) * 16 + swz / 64; C = (st & 1) * 32 + (swz % 64) / 2; }
__host__ __device__ __forceinline__ int perm32(int rho) { const int n = rho >> 4, i = rho & 15; return 8 * (i >> 2) + 4 * n + (i & 3); }

struct Unit { int pm, pn; };
struct Gemm { const bf16_t* A; const bf16_t* Bt; int M, N, K; };

struct StaticOrder {
    int nM, nN, nwg, G, c;
    __host__ __device__ void init(int M, int N, int G_, int c_) { nM = M / BM; nN = N / BM; nwg = nM * nN; G = G_; c = c_; }
    __host__ __device__ bool next(int i, Unit& u) const {
        const long L = (long)i * G + c; if (L >= nwg) return false;
        int wgid = (int)L; { const int q = nwg / NXCD, r = nwg % NXCD, xcd = wgid % NXCD, off = wgid / NXCD; wgid = (xcd < r ? xcd * (q + 1) : r * (q + 1) + (xcd - r) * q) + off; }
        const int nig = WGM * nN, gid = wgid / nig, fm = gid * WGM, gsz = (nM - fm) < WGM ? (nM - fm) : WGM;
        u.pm = fm + ((wgid % nig) % gsz); u.pn = (wgid % nig) / gsz; return true;
    }
    __device__ __forceinline__ void a_ready(const Unit&) const {}
    __device__ __forceinline__ void done(const Unit&) const {}
};

__device__ __forceinline__ unsigned cvt_pk_bf16(float lo, float hi) { unsigned r; asm volatile("v_cvt_pk_bf16_f32 %0, %1, %2" : "=v"(r) : "v"(lo), "v"(hi)); return r; }
typedef unsigned u32x2 __attribute__((ext_vector_type(2)));

struct CmpOrder {
    int G, c;
    __device__ bool next(int i, Unit& u) const { const int L = i * G + c; if (L >= 544) return false; u.pm = L; u.pn = L >= 272 ? 1 : 0; return true; }
    __device__ __forceinline__ void a_ready(const Unit&) const {}
    __device__ __forceinline__ void done(const Unit&) const {}
};

struct EpiIn {
    static constexpr bool PERM = false, AFTER_DRAIN = false;
    bf16_t* ZX; float* DT; float* pconv; float* sconv;
    __device__ __forceinline__ void operator()(const f32x4 (&acc)[2][2][4][2], const Unit& u, int wr, int wc, int fr, int fq) const {
        const int colt = u.pn * BM + wc * 32 + 4 * fq;
#pragma unroll
        for (int ai = 0; ai < 2; ++ai)
#pragma unroll
            for (int m = 0; m < 4; ++m) {
                const int row = u.pm * BM + ai * HALF + wr * 64 + m * 16 + fr;
                float* cptr = nullptr;
                if (row < cfg::MP) { const int t = row & 2047; if (t >= 2045) cptr = pconv + (size_t)((row >> 11) * 3 + (t - 2045)) * cfg::CONVD; }
                else { const int sr = row - cfg::MP, t = sr & 7; if (t >= 5) cptr = sconv + (size_t)((sr >> 3) * 3 + (t - 5)) * cfg::CONVD; }
#pragma unroll
                for (int bj = 0; bj < 2; ++bj)
#pragma unroll
                    for (int n = 0; n < 2; ++n) {
                        const int col = colt + bj * HALF + n * 16; const f32x4 v = acc[ai][bj][m][n];
                        if (col < cfg::ZXW) {
                            u32x2 w; w.x = cvt_pk_bf16(v[0], v[1]); w.y = cvt_pk_bf16(v[2], v[3]);
                            *(u32x2*)(ZX + (size_t)row * cfg::ZXW + col) = w;
                            if (cptr && col >= cfg::DIN) *(f32x4*)(cptr + (col - cfg::DIN)) = v;
                        } else if (col < cfg::INDIM) *(f32x4*)(DT + (size_t)row * 32 + (col - cfg::ZXW)) = v;
                    }
            }
    }
};
struct EpiRes {
    static constexpr bool PERM = false, AFTER_DRAIN = false;
    float* out; const float* resA; const float* resB;
    __device__ __forceinline__ void operator()(const f32x4 (&acc)[2][2][4][2], const Unit& u, int wr, int wc, int fr, int fq) const {
        const int colt = u.pn * BM + wc * 32 + 4 * fq;
#pragma unroll
        for (int ai = 0; ai < 2; ++ai)
#pragma unroll
            for (int m = 0; m < 4; ++m) {
                const int row = u.pm * BM + ai * HALF + wr * 64 + m * 16 + fr;
                const float* rp = (row < cfg::MP ? resA : resB) + (size_t)row * cfg::DM + colt; float* op = out + (size_t)row * cfg::DM + colt;
#pragma unroll
                for (int bj = 0; bj < 2; ++bj)
#pragma unroll
                    for (int n = 0; n < 2; ++n) { const f32x4 r = *(const f32x4*)(rp + bj * HALF + n * 16); *(f32x4*)(op + bj * HALF + n * 16) = acc[ai][bj][m][n] + r * cfg::ALPHA; }
            }
    }
};
struct EpiRelu2 {
    static constexpr bool PERM = true, AFTER_DRAIN = false;
    bf16_t* O;
    __device__ __forceinline__ void operator()(const f32x4 (&acc)[2][2][4][2], const Unit& u, int wr, int wc, int fr, int fq) const {
        const int col0 = u.pn * BM + wc * 32 + 8 * fq;
#pragma unroll
        for (int ai = 0; ai < 2; ++ai)
#pragma unroll
            for (int m = 0; m < 4; ++m) { bf16_t* rowp = O + (size_t)(u.pm * BM + ai * HALF + wr * 64 + m * 16 + fr) * cfg::DFF + col0;
#pragma unroll
                for (int bj = 0; bj < 2; ++bj) { f32x4 v0 = acc[ai][bj][m][0], v1 = acc[ai][bj][m][1];
#pragma unroll
                    for (int j = 0; j < 4; ++j) { const float a = fmaxf(v0[j], 0.f), b = fmaxf(v1[j], 0.f); v0[j] = a * a; v1[j] = b * b; }
                    u32x4 w; w.x = cvt_pk_bf16(v0[0], v0[1]); w.y = cvt_pk_bf16(v0[2], v0[3]); w.z = cvt_pk_bf16(v1[0], v1[1]); w.w = cvt_pk_bf16(v1[2], v1[3]);
                    *(u32x4*)(rowp + bj * HALF) = w; } }
    }
};
struct EpiKvq {
    static constexpr bool PERM = false, AFTER_DRAIN = false;
    float* out; bf16_t* KVB; bf16_t* QB; float* GATES; bf16_t* ACMP;
    __device__ __forceinline__ void operator()(const f32x4 (&acc)[2][2][4][2], const Unit& u, int wr, int wc, int fr, int fq) const {
        const int colt = u.pn * BM + wc * 32 + 4 * fq;
#pragma unroll
        for (int ai = 0; ai < 2; ++ai)
#pragma unroll
            for (int m = 0; m < 4; ++m) {
                const int row = u.pm * BM + ai * HALF + wr * 64 + m * 16 + fr;
                const bool prompt = row < cfg::MP; const int sr = row - cfg::MP;
                const int b = prompt ? (row >> 11) : (sr >> 3), t = prompt ? (row & 2047) : (sr & 7);
#pragma unroll
                for (int bj = 0; bj < 2; ++bj)
#pragma unroll
                    for (int n = 0; n < 2; ++n) {
                        const int col = colt + bj * HALF + n * 16; const f32x4 v = acc[ai][bj][m][n];
                        if (col < cfg::KVW) {
                            const int br = col >> 9, cc = col & 511;
                            float* dst = nullptr;
                            if (prompt) { if (br == 0) dst = out + cfg::O_PCMP + (size_t)row * 512 + cc; else if (br == 1) dst = out + cfg::O_PSEL + (size_t)row * 512 + cc;
                                          else if (t >= 1536) dst = out + cfg::O_PWIN + (size_t)(b * 512 + t - 1536) * 512 + cc; }
                            else { if (br == 0) dst = out + cfg::O_SCMP + (size_t)sr * 512 + cc; else if (br == 1) dst = out + cfg::O_SSEL + (size_t)sr * 512 + cc;
                                   else dst = out + cfg::O_SWIN + (size_t)(b * 512 + 504 + t) * 512 + cc; }
                            if (dst) *(f32x4*)dst = v;
                            u32x2 w; w.x = cvt_pk_bf16(v[0], v[1]); w.y = cvt_pk_bf16(v[2], v[3]);
                            *(u32x2*)(KVB + (size_t)row * cfg::KVW + col) = w;
                            if (prompt && br == 0) { const int kv = cc >> 8, g = (cc >> 6) & 3, d = cc & 63;
                                *(u32x2*)(ACMP + ((size_t)kv * cfg::NCMPROWS + 65536 + (size_t)(b * 4 + g) * 128 + (t >> 4)) * 1024 + (t & 15) * 64 + d) = w; }
                        } else if (col < cfg::KVW + 1024) {
                            u32x2 w; w.x = cvt_pk_bf16(v[0] * cfg::QSCALE, v[1] * cfg::QSCALE); w.y = cvt_pk_bf16(v[2] * cfg::QSCALE, v[3] * cfg::QSCALE);
                            *(u32x2*)(QB + (size_t)row * cfg::DM + (col - cfg::KVW)) = w;
                        } else if (col < cfg::KVW + cfg::QGW) {
                            f32x4 s;
#pragma unroll
                            for (int j = 0; j < 4; ++j) s[j] = 1.f / (1.f + __expf(-v[j]));
                            *(f32x4*)(GATES + (size_t)row * 48 + (col - cfg::KVW - 1024)) = s;
                        }
                    }
            }
    }
};
struct EpiP {
    static constexpr bool PERM = false, AFTER_DRAIN = false;
    float* P;
    __device__ __forceinline__ void operator()(const f32x4 (&acc)[2][2][4][2], const Unit& u, int wr, int wc, int fr, int fq) const {
        const int colt = wc * 32 + 4 * fq;
#pragma unroll
        for (int ai = 0; ai < 2; ++ai)
#pragma unroll
            for (int m = 0; m < 4; ++m) { float* op = P + (size_t)(u.pm * BM + ai * HALF + wr * 64 + m * 16 + fr) * 256 + colt;
#pragma unroll
                for (int bj = 0; bj < 2; ++bj)
#pragma unroll
                    for (int n = 0; n < 2; ++n) *(f32x4*)(op + bj * HALF + n * 16) = acc[ai][bj][m][n]; }
    }
};

template <class Epi, class Sched, bool ALIGN_EPI = false, bool SP2 = false>
__device__ __forceinline__ void gemm_phase(PG8_LAS unsigned char* lds, const Gemm g, const Sched& S, const Epi& E) {
    const int tid = threadIdx.x, wid = __builtin_amdgcn_readfirstlane(tid >> 6), lane = tid & 63, wr = wid >> 2, wc = wid & 3, fr = lane & 15, fq = lane >> 4;
    const int K = g.K, nt = K / BK;
    unsigned voffA[2], voffB[2];
#pragma unroll
    for (int i = 0; i < 2; ++i) { int R, C; stage_rc(tid * 16 + i * 8192, R, C); const int Rb = Epi::PERM ? ((R & ~31) + perm32(R & 31)) : R;
        voffA[i] = (unsigned)(R * K + C) * 2u; voffB[i] = (unsigned)(Rb * K + C) * 2u; }
    const size_t kstep = (size_t)(BK * 2);
    const size_t hstep = (size_t)HALF * K * 2;
    const size_t tstep = 2 * hstep;
    const unsigned ldsw = (unsigned)wid * 1024u;
    const int aoff = lds_byte(wr * 64 + fr, fq * 8), boff = lds_byte(wc * 32 + fr, fq * 8);
#define PG8_SA(b, h) (((b) * 2 + (h)) * HTB)
#define PG8_SB(b, h) ((4 + (b) * 2 + (h)) * HTB)
#define PG8_STAGE(bufoff, gbase, voff) do { _Pragma("unroll") for (int _i = 0; _i < 2; ++_i) \
        __builtin_amdgcn_global_load_lds((const unsigned*)((const char*)(gbase) + (voff)[_i]), (PG8_LAS unsigned*)(lds + (bufoff) + ldsw + _i * 8192), 16, 0, 0); } while (0)
#define PG8_LDA(dst, b, h) do { _Pragma("unroll") for (int m = 0; m < 4; ++m) _Pragma("unroll") for (int k = 0; k < 2; ++k) dst[m][k] = *(const PG8_LAS bf16x8*)(lds + PG8_SA(b, h) + aoff + m * 2048 + k * 1024); } while (0)
#define PG8_LDB(dst, b, h) do { _Pragma("unroll") for (int n = 0; n < 2; ++n) _Pragma("unroll") for (int k = 0; k < 2; ++k) dst[n][k] = *(const PG8_LAS bf16x8*)(lds + PG8_SB(b, h) + boff + n * 2048 + k * 1024); } while (0)
#define PG8_MMA(ai, bj, At, Bt) do { __builtin_amdgcn_s_setprio(1); _Pragma("unroll") for (int m = 0; m < 4; ++m) _Pragma("unroll") for (int n = 0; n < 2; ++n) _Pragma("unroll") for (int k = 0; k < 2; ++k) \
        acc[ai][bj][m][n] = __builtin_amdgcn_mfma_f32_16x16x32_bf16(Bt[n][k], At[m][k], acc[ai][bj][m][n], 0, 0, 0); __builtin_amdgcn_s_setprio(0); } while (0)
#define PG8_WAIT_V(n) asm volatile("s_waitcnt vmcnt(" #n ")" ::: "memory")
#define PG8_WAIT_L(n) asm volatile("s_waitcnt lgkmcnt(" #n ")" ::: "memory")
#define PG8_BAR __builtin_amdgcn_s_barrier()
#define PG8_SCHED __builtin_amdgcn_sched_barrier(0)
    Unit cur, nxt; int ui = 0;
    if (!S.next(0, cur)) return;
    f32x4 acc[2][2][4][2];
#pragma unroll
    for (int a = 0; a < 2; ++a)
#pragma unroll
        for (int b = 0; b < 2; ++b)
#pragma unroll
            for (int m = 0; m < 4; ++m)
#pragma unroll
                for (int n = 0; n < 2; ++n) acc[a][b][m][n] = (f32x4){0.f, 0.f, 0.f, 0.f};
    bf16x8 At[4][2], B0[2][2], B1[2][2];
    const char* cA = (const char*)g.A + (size_t)cur.pm * tstep; const char* cB = (const char*)g.Bt + (size_t)cur.pn * tstep;
    S.a_ready(cur);
    if constexpr (SP2) {
        PG8_STAGE(PG8_SB(0, 0), cB, voffB); PG8_STAGE(PG8_SB(0, 1), cB + hstep, voffB); PG8_STAGE(PG8_SA(0, 0), cA, voffA); PG8_STAGE(PG8_SA(0, 1), cA + hstep, voffA);
        if (wr == 1) PG8_BAR;
        PG8_WAIT_V(2); PG8_BAR;
        PG8_STAGE(PG8_SB(1, 0), cB + kstep, voffB); PG8_STAGE(PG8_SA(1, 0), cA + kstep, voffA); PG8_STAGE(PG8_SB(1, 1), cB + hstep + kstep, voffB);
        PG8_WAIT_V(6); PG8_BAR;
    } else {
        PG8_STAGE(PG8_SB(0, 0), cB, voffB); PG8_STAGE(PG8_SA(0, 0), cA, voffA); PG8_STAGE(PG8_SB(0, 1), cB + hstep, voffB); PG8_STAGE(PG8_SA(0, 1), cA + hstep, voffA);
        if (wr == 1) PG8_BAR;
        PG8_WAIT_V(4); PG8_BAR;
        PG8_STAGE(PG8_SB(1, 0), cB + kstep, voffB); PG8_STAGE(PG8_SA(1, 0), cA + kstep, voffA); PG8_STAGE(PG8_SB(1, 1), cB + hstep + kstep, voffB);
        PG8_WAIT_V(6); PG8_BAR;
    }
    for (;;) {
        const bool has_next = S.next(ui + 1, nxt);
        const char* nA = has_next ? (const char*)g.A + (size_t)nxt.pm * tstep : cA; const char* nB = has_next ? (const char*)g.Bt + (size_t)nxt.pn * tstep : cB;
        for (int t = 0; t < nt; t += 2) {
            const bool last = (t == nt - 2);
            const char* a1 = cA + (size_t)(t + 1) * kstep;
            const char* a2 = last ? nA : cA + (size_t)(t + 2) * kstep; const char* b2 = last ? nB : cB + (size_t)(t + 2) * kstep;
            const char* a3 = a2 + kstep; const char* b3 = b2 + kstep;
            if (last && has_next) S.a_ready(nxt);
            if constexpr (SP2) {
            PG8_LDB(B0, 0, 0); PG8_LDB(B1, 0, 1); PG8_SCHED; PG8_LDA(At, 0, 0); PG8_STAGE(PG8_SA(1, 1), a1 + hstep, voffA);
            PG8_WAIT_V(8); PG8_WAIT_L(0); PG8_BAR; PG8_MMA(0, 0, At, B0); PG8_MMA(0, 1, At, B1); PG8_BAR; PG8_SCHED;
            PG8_LDA(At, 0, 1); PG8_STAGE(PG8_SB(0, 0), b2, voffB); PG8_STAGE(PG8_SB(0, 1), b2 + hstep, voffB); PG8_STAGE(PG8_SA(0, 0), a2, voffA);
            PG8_WAIT_V(8); PG8_WAIT_L(0); PG8_BAR; PG8_MMA(1, 0, At, B0); PG8_MMA(1, 1, At, B1); PG8_BAR; PG8_SCHED;
            PG8_LDB(B0, 1, 0); PG8_LDB(B1, 1, 1); PG8_SCHED; PG8_LDA(At, 1, 0); PG8_STAGE(PG8_SA(0, 1), a2 + hstep, voffA);
            PG8_WAIT_V(8); PG8_WAIT_L(0); PG8_BAR; PG8_MMA(0, 0, At, B0); PG8_MMA(0, 1, At, B1); PG8_BAR; PG8_SCHED;
            PG8_LDA(At, 1, 1); PG8_STAGE(PG8_SB(1, 0), b3, voffB); PG8_STAGE(PG8_SB(1, 1), b3 + hstep, voffB); PG8_STAGE(PG8_SA(1, 0), a3, voffA);
            PG8_WAIT_V(8); PG8_WAIT_L(0); PG8_BAR; PG8_MMA(1, 0, At, B0); PG8_MMA(1, 1, At, B1); PG8_BAR; PG8_SCHED;
            } else {
            PG8_LDB(B0, 0, 0); PG8_SCHED; PG8_LDA(At, 0, 0); PG8_STAGE(PG8_SA(1, 1), a1 + hstep, voffA);
            PG8_WAIT_L(8); PG8_BAR; PG8_WAIT_L(0); PG8_MMA(0, 0, At, B0); PG8_BAR; PG8_SCHED;
            PG8_LDB(B1, 0, 1); PG8_STAGE(PG8_SB(0, 0), b2, voffB);
            PG8_BAR; PG8_WAIT_L(0); PG8_MMA(0, 1, At, B1); PG8_BAR;
            PG8_LDA(At, 0, 1); PG8_STAGE(PG8_SA(0, 0), a2, voffA);
            PG8_BAR; PG8_WAIT_L(0); PG8_MMA(1, 0, At, B0); PG8_BAR; PG8_SCHED;
            PG8_STAGE(PG8_SB(0, 1), b2 + hstep, voffB);
            PG8_WAIT_V(6); PG8_BAR; PG8_MMA(1, 1, At, B1); PG8_BAR;
            PG8_LDB(B0, 1, 0); PG8_SCHED; PG8_LDA(At, 1, 0); PG8_STAGE(PG8_SA(0, 1), a2 + hstep, voffA);
            PG8_WAIT_L(8); PG8_BAR; PG8_WAIT_L(0); PG8_MMA(0, 0, At, B0); PG8_BAR; PG8_SCHED;
            PG8_LDB(B1, 1, 1); PG8_STAGE(PG8_SB(1, 0), b3, voffB);
            PG8_BAR; PG8_WAIT_L(0); PG8_MMA(0, 1, At, B1); PG8_BAR;
            PG8_LDA(At, 1, 1); PG8_STAGE(PG8_SA(1, 0), a3, voffA);
            PG8_BAR; PG8_WAIT_L(0); PG8_MMA(1, 0, At, B0); PG8_BAR; PG8_SCHED;
            PG8_STAGE(PG8_SB(1, 1), b3 + hstep, voffB);
            PG8_WAIT_V(6); PG8_BAR; PG8_MMA(1, 1, At, B1); PG8_BAR;
            }
        }
        if constexpr (ALIGN_EPI) { if (wr == 0) PG8_BAR; }
        if constexpr (!Epi::AFTER_DRAIN) { E(acc, cur, wr, wc, fr, fq); S.done(cur); }
        if (!has_next) break;
#pragma unroll
        for (int a = 0; a < 2; ++a)
#pragma unroll
            for (int b = 0; b < 2; ++b)
#pragma unroll
                for (int m = 0; m < 4; ++m)
#pragma unroll
                    for (int n = 0; n < 2; ++n) acc[a][b][m][n] = (f32x4){0.f, 0.f, 0.f, 0.f};
        cur = nxt; cA = nA; cB = nB; ++ui;
        if constexpr (ALIGN_EPI) { if (wr == 1) PG8_BAR; }
    }
    PG8_WAIT_V(0);
    if constexpr (!ALIGN_EPI) { if (wr == 0) PG8_BAR; }
    PG8_BAR;
    if constexpr (Epi::AFTER_DRAIN) { E.fused(acc, cur, wr, wc, fr, fq, lds, wid, lane); S.done(cur); }
#undef PG8_SA
#undef PG8_SB
#undef PG8_STAGE
#undef PG8_LDA
#undef PG8_LDB
#undef PG8_MMA
#undef PG8_WAIT_V
#undef PG8_WAIT_L
#undef PG8_BAR
#undef PG8_SCHED
}
}
#define XB_TMO      128
#define XB_XCNT(j)  (256  + 64 * (j))
#define XB_XSUB(j)  (1280 + 64 * (j))
#define XB_XGEN(j)  (2304 + 64 * (j))
#define XB_TOP      3328
#define XB_TOPGEN   3392
#define XCD_BAR_WORDS 3456
#define XB_SPIN_CAP (1u << 18)

__device__ __forceinline__ unsigned xb_ld(unsigned* p)              { return __hip_atomic_load(p, __ATOMIC_RELAXED, __HIP_MEMORY_SCOPE_AGENT); }
__device__ __forceinline__ unsigned xb_add(unsigned* p, unsigned v) { return __hip_atomic_fetch_add(p, v, __ATOMIC_RELAXED, __HIP_MEMORY_SCOPE_AGENT); }
__device__ __forceinline__ unsigned xb_xcc_id() { return (unsigned)__builtin_amdgcn_s_getreg((3 << 11) | 20) & 0xFu; }
#define XB_SPIN(cond, bar) do { unsigned _sp = 0; while (cond) { __builtin_amdgcn_s_sleep(1); \
    if ((++_sp & 255u) == 0u) { if (xb_ld(&(bar)[XB_TMO])) break; if (_sp > XB_SPIN_CAP) { atomicAdd(&(bar)[XB_TMO], 1u); break; } } } } while (0)

struct XcdBarrier {
    unsigned* bar; unsigned x;
    volatile LAS unsigned* st;
};

__device__ __forceinline__ XcdBarrier xcd_barrier_post(unsigned* bar, volatile LAS unsigned* st) {
    XcdBarrier b; b.bar = bar; b.x = xb_xcc_id(); b.st = st;
    if (threadIdx.x == 0) (void)xb_add(&bar[XB_XCNT(b.x)], 1u);
    return b;
}
__device__ __forceinline__ void xcd_barrier_complete(unsigned* bar, unsigned x, unsigned& nloc, unsigned& nx) {
    const unsigned G = gridDim.x * gridDim.y * gridDim.z;
    unsigned sum, cnt, mine, sp = 0u;
    for (;;) {
        sum = 0u; cnt = 0u; mine = 0u;
#pragma unroll
        for (unsigned j = 0; j < 16; ++j) { const unsigned c = xb_ld(&bar[XB_XCNT(j)]); sum += c; cnt += (c > 0u) ? 1u : 0u; mine = (j == x) ? c : mine; }
        if (sum == G) break;
        __builtin_amdgcn_s_sleep(1);
        if ((++sp & 255u) == 0u) { if (xb_ld(&bar[XB_TMO])) break; if (sp > XB_SPIN_CAP) { atomicAdd(&bar[XB_TMO], 1u); break; } }
    }
    nloc = mine > 0u ? mine : 1u; nx = cnt > 0u ? cnt : 1u;
}

__device__ __forceinline__ void xcd_barrier(const XcdBarrier& b) {
    asm volatile("s_waitcnt vmcnt(0)" ::: "memory");
    __syncthreads();
    if (threadIdx.x == 0) {
        unsigned* bar = b.bar;
        __builtin_amdgcn_s_waitcnt(0);
        unsigned nloc = b.st[0], nx = b.st[1];
        if (nloc == 0u) { xcd_barrier_complete(bar, b.x, nloc, nx); b.st[0] = nloc; b.st[1] = nx; }
        const unsigned old = xb_add(&bar[XB_XSUB(b.x)], 1u);
        const unsigned gen = old / nloc;
        if (old + 1u == (gen + 1u) * nloc) {
            __builtin_amdgcn_fence(__ATOMIC_RELEASE, "agent");
            asm volatile("s_waitcnt vmcnt(0)" ::: "memory");
            const unsigned og = xb_add(&bar[XB_TOP], 1u);
            const unsigned tg = og / nx;
            if (og + 1u == (tg + 1u) * nx) xb_add(&bar[XB_TOPGEN], 1u);
            else XB_SPIN(xb_ld(&bar[XB_TOPGEN]) == tg, bar);
            __builtin_amdgcn_fence(__ATOMIC_ACQUIRE, "agent");
            xb_add(&bar[XB_XGEN(b.x)], 1u);
            asm volatile("s_waitcnt vmcnt(0)" ::: "memory");
        } else {
            XB_SPIN(xb_ld(&bar[XB_XGEN(b.x)]) == gen, bar);
            __builtin_amdgcn_fence(__ATOMIC_ACQUIRE, "agent");
            asm volatile("s_waitcnt vmcnt(0)" ::: "memory");
        }
    }
    __syncthreads();
}

constexpr int NWAVES = 8, NTHR = 512;
__device__ __forceinline__ float wave_sum(float v) {
#pragma unroll
    for (int o = 1; o < 64; o <<= 1) v += __shfl_xor(v, o);
    return v;
}
__device__ __forceinline__ float silu_f(float v) { return v / (1.f + __expf(-v)); }

__device__ __forceinline__ void tr_item(const float* __restrict__ W, int N, bf16* WT, int ldk, int row_off, const float* __restrict__ kscale, LAS float* scr, int item, int lane) {
    const int nblk = (N + 31) >> 5, kb = item / nblk, nb = item - kb * nblk, k0 = 64 * kb, n0 = 32 * nb;
    const int nn = n0 + (lane & 31);
#pragma unroll 8
    for (int i = 0; i < 32; ++i) { const int kk = 2 * i + (lane >> 5); float v = (nn < N) ? W[(size_t)(k0 + kk) * N + nn] : 0.f; if (kscale) v *= kscale[k0 + kk]; scr[kk * 33 + (lane & 31)] = v; }
    LDS_WAIT();
    const int c = lane & 7;
#pragma unroll
    for (int j = 0; j < 4; ++j) { const int n = (lane >> 3) + 8 * j; const LAS float* s = scr + (8 * c) * 33 + n;
        v4u o; o.x = pk2(s[0 * 33], s[1 * 33]); o.y = pk2(s[2 * 33], s[3 * 33]); o.z = pk2(s[4 * 33], s[5 * 33]); o.w = pk2(s[6 * 33], s[7 * 33]);
        if (n0 + n < N) *(v4u*)(WT + (size_t)(row_off + n0 + n) * ldk + k0 + 8 * c) = o; }
    LDS_WAIT();
}

struct Args {
    const float* x_prompt; const float* x_sample; const float* state_ssm; const float* state_conv; const float* cache_cmp; const float* cache_sel; const float* cache_win; const int* page_table;
    const float* ln_g; const float* ln_b; const float* m_in_w; const float* m_conv_w; const float* m_conv_b; const float* m_dt_bias; const float* m_a_log; const float* m_d; const float* m_norm_w; const float* m_out_w;
    const float* kv_w; const float* cmp_w1; const float* cmp_pe; const float* cmp_w2; const float* q_w; const float* o_w; const float* rel_bias; const float* mlp_w1; const float* mlp_w2;
    float* out; unsigned char* ws; int ph_lo, ph_hi, li, pad;
};

__device__ __forceinline__ void p0_prologue(const Args& a, LAS unsigned char* lds, int G) {
    using namespace cfg;
    const int tid = threadIdx.x, lane = tid & 63, wave = tid >> 6;
    LAS float* scr = (LAS float*)(lds + wave * 16384);
    unsigned char* ws = a.ws;
    const int gw = blockIdx.x * NWAVES + wave, NGW = G * NWAVES;
    constexpr int I_IN = 16 * 161, I_OUT = 32 * 32, I_W1 = 16 * 128, I_W2 = 64 * 32, I_KV = 16 * 48, I_Q = 16 * 34, I_O = 16 * 32, I_C = 16 * 4;
    constexpr int NIT = I_IN + I_OUT + 2 * I_W1 + 2 * I_W2 + I_KV + I_Q + I_O + 4 * I_C;
    for (int it = gw; it < NIT; it += NGW) {
        int r = it;
        if (r < I_IN) { tr_item(a.m_in_w, INDIM, (bf16*)(ws + WS_WIN), DM, 0, nullptr, scr, r, lane); continue; } r -= I_IN;
        if (r < I_OUT) { tr_item(a.m_out_w, DM, (bf16*)(ws + WS_WOUT), DIN, 0, a.m_norm_w, scr, r, lane); continue; } r -= I_OUT;
        if (r < 2 * I_W1) { const int l = r / I_W1; tr_item(a.mlp_w1 + (size_t)l * DM * DFF, DFF, (bf16*)(ws + WS_W1) + (size_t)l * DFF * DM, DM, 0, nullptr, scr, r - l * I_W1, lane); continue; } r -= 2 * I_W1;
        if (r < 2 * I_W2) { const int l = r / I_W2; tr_item(a.mlp_w2 + (size_t)l * DM * DFF, DM, (bf16*)(ws + WS_W2) + (size_t)l * DFF * DM, DFF, 0, nullptr, scr, r - l * I_W2, lane); continue; } r -= 2 * I_W2;
        if (r < I_KV) { tr_item(a.kv_w, KVW, (bf16*)(ws + WS_WKVQ), DM, 0, nullptr, scr, r, lane); continue; } r -= I_KV;
        if (r < I_Q) { tr_item(a.q_w, QGW, (bf16*)(ws + WS_WKVQ), DM, KVW, nullptr, scr, r, lane); continue; } r -= I_Q;
        if (r < I_O) { tr_item(a.o_w, DM, (bf16*)(ws + WS_WO), DM, 0, nullptr, scr, r, lane); continue; } r -= I_O;
        { const int q = r / I_C; tr_item(a.cmp_w1 + (size_t)q * 1024 * 128, 128, (bf16*)(ws + WS_WC1), 1024, q * 128, nullptr, scr, r - q * I_C, lane); }
    }
    const size_t gt = (size_t)blockIdx.x * NTHR + tid, NT = (size_t)G * NTHR;
    { v4u z = {0u, 0u, 0u, 0u};
      v4u* p1 = (v4u*)((bf16*)(ws + WS_WIN) + (size_t)INDIM * DM); for (size_t i = gt; i < (size_t)(INPAD - INDIM) * DM / 8; i += NT) p1[i] = z;
      v4u* p2 = (v4u*)((bf16*)(ws + WS_WKVQ) + (size_t)(KVW + QGW) * DM); for (size_t i = gt; i < (size_t)(KVQN - KVW - QGW) * DM / 8; i += NT) p2[i] = z; }
    { v4u* xb = (v4u*)(ws + WS_XB);
      for (size_t i = gt; i < (size_t)M * DM / 8; i += NT) { const size_t e = i * 8; const float* src = e < (size_t)MP * DM ? a.x_prompt + e : a.x_sample + (e - (size_t)MP * DM);
          const f32x4 v0 = *(const f32x4*)src, v1 = *(const f32x4*)(src + 4); v4u o; o.x = pk2(v0[0], v0[1]); o.y = pk2(v0[2], v0[3]); o.z = pk2(v1[0], v1[1]); o.w = pk2(v1[2], v1[3]); xb[i] = o; } }
    { bf16* ac = (bf16*)(ws + WS_ACMP);
      for (size_t i = gt; i < (size_t)DB * PAST * 64; i += NT) { const int ch = (int)(i & 63); const size_t tok = i >> 6; const int b = (int)(tok >> 11), t = (int)(tok & 2047);
          const int page = a.page_table[b * NPAGE + (t >> 7)]; const float* src = a.cache_cmp + ((size_t)page * PAGE + (t & 127)) * 512 + ch * 8;
          const f32x4 v0 = *(const f32x4*)src, v1 = *(const f32x4*)(src + 4); v4u o; o.x = pk2(v0[0], v0[1]); o.y = pk2(v0[2], v0[3]); o.z = pk2(v1[0], v1[1]); o.w = pk2(v1[2], v1[3]);
          const int kv = ch >> 5, g = (ch >> 3) & 3, d0 = (ch & 7) * 8;
          *(v4u*)(ac + ((size_t)kv * NCMPROWS + (size_t)(b * 4 + g) * 128 + (t >> 4)) * 1024 + (t & 15) * 64 + d0) = o; } }
    { f32x4* dst = (f32x4*)(a.out + O_SWIN); const f32x4* src = (const f32x4*)a.cache_win;
      for (size_t i = gt; i < (size_t)DB * 504 * 128; i += NT) { const size_t b = i / (504 * 128), r = i - b * (504 * 128); dst[b * 512 * 128 + r] = src[b * 512 * 128 + 8 * 128 + r]; } }
    { float* pec = (float*)(ws + WS_PEC);
      for (size_t i = gt; i < 32 * 256; i += NT) { const int sl = (int)(i >> 8), kve = (int)(i & 255), kv = kve >> 7, e = kve & 127; float s = 0.f;
          for (int k = 64 * sl; k < 64 * sl + 64; ++k) s += a.cmp_pe[(size_t)kv * 2048 + k] * a.cmp_w1[((size_t)kv * 2048 + k) * 128 + e];
          pec[i] = s; } }
}

__device__ __forceinline__ void scan_phase(const Args& a, LAS unsigned char* lds, int G) {
    using namespace cfg;
    const int tid = threadIdx.x, lane = tid & 63, wave = tid >> 6, p = tid >> 3, nq = tid & 7;
    LAS float* cv = (LAS float*)lds;
    LAS float* dts = cv + 16 * 320;
    LAS float* dAs = dts + 16;
    LAS float* ygs = dAs + 16;
    const bf16* ZX = (const bf16*)(a.ws + WS_ZX); const float* DT = (const float*)(a.ws + WS_DT);
    bf16* YG = (bf16*)(a.ws + WS_YG); float* SSQ = (float*)(a.ws + WS_SSQ);
    for (int u = blockIdx.x; u < NPB * NH + DB * NH; u += G) {
        const bool prompt = u < NPB * NH; const int su = prompt ? u : u - NPB * NH; const int b = su >> 5, hd = su & 31, g = hd >> 3;
        const int L = prompt ? SEQ : DS; const int row0 = prompt ? b * SEQ : MP + b * DS;
        float h[16];
        float* sdst = a.out + (prompt ? O_PSSM : O_SSSM) + ((size_t)(b * NH + hd) * HD + p) * DST + nq * 16;
        if (prompt) {
#pragma unroll
            for (int i = 0; i < 16; ++i) h[i] = 0.f;
        } else { const float* s0 = a.state_ssm + ((size_t)(b * NH + hd) * HD + p) * DST + nq * 16;
#pragma unroll
            for (int i4 = 0; i4 < 4; ++i4) { const f32x4 v = *(const f32x4*)(s0 + 4 * i4); h[4 * i4] = v[0]; h[4 * i4 + 1] = v[1]; h[4 * i4 + 2] = v[2]; h[4 * i4 + 3] = v[3]; } }
        const float dtb = a.m_dt_bias[hd], Aneg = -__expf(a.m_a_log[hd]), Dh = a.m_d[hd];
        for (int t0 = 0; t0 < L; t0 += 16) {
            const int nt = (L - t0) < 16 ? (L - t0) : 16;
            __syncthreads();
            for (int idx = tid; idx < nt * 320; idx += NTHR) { const int tt = idx / 320, cl = idx - tt * 320;
                const int cx = cl < 64 ? hd * 64 + cl : (cl < 192 ? 2048 + g * 128 + (cl - 64) : 2560 + g * 128 + (cl - 192));
                float acc = a.m_conv_b[cx];
#pragma unroll
                for (int k = 0; k < 4; ++k) { const int t = t0 + tt - 3 + k;
                    const float xv = t >= 0 ? bf2f(ZX[(size_t)(row0 + t) * ZXW + DIN + cx]) : (prompt ? 0.f : a.state_conv[(size_t)(b * 3 + t + 3) * CONVD + cx]);
                    acc += a.m_conv_w[k * CONVD + cx] * xv; }
                cv[tt * 320 + cl] = silu_f(acc); }
            if (tid < nt) { const float dtr = DT[(size_t)(row0 + t0 + tid) * 32 + hd] + dtb; const float dtv = dtr > 20.f ? dtr : log1pf(__expf(dtr)); dts[tid] = dtv; dAs[tid] = __expf(dtv * Aneg); }
            __syncthreads();
            for (int tt = 0; tt < nt; ++tt) {
                const float x = cv[tt * 320 + p], dtv = dts[tt], dA = dAs[tt], xdt = x * dtv;
                const LAS f32x4* Bp = (const LAS f32x4*)(cv + tt * 320 + 64 + nq * 16); const LAS f32x4* Cp = (const LAS f32x4*)(cv + tt * 320 + 192 + nq * 16);
                float acc = 0.f;
#pragma unroll
                for (int i4 = 0; i4 < 4; ++i4) { const f32x4 Bv = Bp[i4], Cv = Cp[i4];
#pragma unroll
                    for (int j = 0; j < 4; ++j) { h[4 * i4 + j] = dA * h[4 * i4 + j] + xdt * Bv[j]; acc += h[4 * i4 + j] * Cv[j]; } }
                acc += __shfl_xor(acc, 1); acc += __shfl_xor(acc, 2); acc += __shfl_xor(acc, 4);
                if (nq == 0) { const float y = acc + Dh * x; const float z = bf2f(ZX[(size_t)(row0 + t0 + tt) * ZXW + hd * 64 + p]); ygs[tt * 64 + p] = y * silu_f(z); }
            }
            __syncthreads();
            for (int idx = tid; idx < nt * 32; idx += NTHR) { const int tt = idx >> 5, pp = (idx & 31) * 2;
                *(unsigned*)(YG + (size_t)(row0 + t0 + tt) * DIN + hd * 64 + pp) = pk2(ygs[tt * 64 + pp], ygs[tt * 64 + pp + 1]); }
            for (int tt = wave; tt < nt; tt += NWAVES) { const float v = ygs[tt * 64 + lane]; const float s = wave_sum(v * v); if (lane == 0) SSQ[(size_t)(row0 + t0 + tt) * 32 + hd] = s; }
        }
#pragma unroll
        for (int i4 = 0; i4 < 4; ++i4) { f32x4 v = {h[4 * i4], h[4 * i4 + 1], h[4 * i4 + 2], h[4 * i4 + 3]}; *(f32x4*)(sdst + 4 * i4) = v; }
    }
}

__device__ __forceinline__ void norm_phase(const Args& a, int G) {
    using namespace cfg;
    const bf16* YG = (const bf16*)(a.ws + WS_YG); const float* SSQ = (const float*)(a.ws + WS_SSQ); bf16* YN = (bf16*)(a.ws + WS_YN);
    const size_t gt = (size_t)blockIdx.x * NTHR + threadIdx.x, NT = (size_t)G * NTHR;
    for (size_t i = gt; i < (size_t)M * DIN / 8; i += NT) { const size_t row = i >> 8; const int c8 = (int)(i & 255), g = c8 >> 6;
        const f32x4 s0 = *(const f32x4*)(SSQ + row * 32 + g * 8), s1 = *(const f32x4*)(SSQ + row * 32 + g * 8 + 4);
        const float ms = ((s0[0] + s0[1]) + (s0[2] + s0[3]) + (s1[0] + s1[1]) + (s1[2] + s1[3])) * (1.f / 512.f);
        const float r = 1.f / sqrtf(ms + RMS_EPS);
        const v4u v = *(const v4u*)(YG + i * 8); v4u o;
        o.x = pk2(bflo(v.x) * r, bfhi(v.x) * r); o.y = pk2(bflo(v.y) * r, bfhi(v.y) * r); o.z = pk2(bflo(v.z) * r, bfhi(v.z) * r); o.w = pk2(bflo(v.w) * r, bfhi(v.w) * r);
        *(v4u*)(YN + i * 8) = o; }
}

__device__ __forceinline__ void ln_phase(const float* PRE, const float* gam, const float* bet, float* outF, bf16* outB, int G) {
    using namespace cfg;
    const int lane = threadIdx.x & 63, wave = threadIdx.x >> 6;
    f32x4 gv[4], bv[4];
#pragma unroll
    for (int j = 0; j < 4; ++j) { gv[j] = *(const f32x4*)(gam + 4 * lane + 256 * j); bv[j] = *(const f32x4*)(bet + 4 * lane + 256 * j); }
    for (int row = blockIdx.x * NWAVES + wave; row < M; row += G * NWAVES) {
        const float* xr = PRE + (size_t)row * DM + 4 * lane; f32x4 v[4]; float s = 0.f;
#pragma unroll
        for (int j = 0; j < 4; ++j) { v[j] = *(const f32x4*)(xr + 256 * j); s += (v[j][0] + v[j][1]) + (v[j][2] + v[j][3]); }
        const float mean = wave_sum(s) * (1.f / DM); float s2 = 0.f;
#pragma unroll
        for (int j = 0; j < 4; ++j) { v[j] = v[j] - mean; s2 += (v[j][0] * v[j][0] + v[j][1] * v[j][1]) + (v[j][2] * v[j][2] + v[j][3] * v[j][3]); }
        const float rstd = 1.f / sqrtf(wave_sum(s2) * (1.f / DM) + LN_EPS);
#pragma unroll
        for (int j = 0; j < 4; ++j) { const f32x4 o = v[j] * rstd * gv[j] + bv[j]; *(f32x4*)(outF + (size_t)row * DM + 4 * lane + 256 * j) = o;
            if (outB) { v2u w; w.x = pk2(o[0], o[1]); w.y = pk2(o[2], o[3]); *(v2u*)(outB + (size_t)row * DM + 4 * lane + 256 * j) = w; } }
    }
}

__device__ __forceinline__ void cmp2_phase(const Args& a, LAS unsigned char* lds, int G) {
    using namespace cfg;
    const int tid = threadIdx.x;
    LAS float* w2s = (LAS float*)lds;
    LAS float* pcs = w2s + 2 * 128 * 64;
    LAS float* hs = pcs + 256;
    const float* P = (const float*)(a.ws + WS_PCMP); const float* pec = (const float*)(a.ws + WS_PEC);
    for (int i = tid; i < 2 * 128 * 64; i += NTHR) w2s[i] = a.cmp_w2[i];
    if (tid < 256) { float s = 0.f; for (int sl = 0; sl < 32; ++sl) s += pec[sl * 256 + tid]; pcs[tid] = s; }
    __syncthreads();
    for (int u = blockIdx.x; u < 2 * NCMPROWS / 64; u += G) {
        const size_t r0 = (size_t)u * 64; const int kv = r0 >= (size_t)NCMPROWS ? 1 : 0;
        __syncthreads();
        for (int i = tid; i < 64 * 128; i += NTHR) { const int rl = i >> 7, e = i & 127; const size_t r = r0 + rl; const int c = (int)(r & 127);
            float hv = 0.f; if (c < 127) hv = silu_f(P[r * 256 + e] + P[(r + 1) * 256 + 128 + e] + pcs[kv * 128 + e]);
            hs[rl * 129 + e] = hv; }
        __syncthreads();
        const int rl = tid >> 3, dq = tid & 7; float o[8];
#pragma unroll
        for (int j = 0; j < 8; ++j) o[j] = 0.f;
        for (int e = 0; e < 128; ++e) { const float s = hs[rl * 129 + e]; const LAS f32x4* wp = (const LAS f32x4*)(w2s + (kv * 128 + e) * 64 + dq * 8); const f32x4 w0 = wp[0], w1 = wp[1];
            o[0] += s * w0[0]; o[1] += s * w0[1]; o[2] += s * w0[2]; o[3] += s * w0[3]; o[4] += s * w1[0]; o[5] += s * w1[1]; o[6] += s * w1[2]; o[7] += s * w1[3]; }
        bf16* dst = (bf16*)(a.ws + (kv ? WS_VC : WS_KC)) + ((r0 - (size_t)kv * NCMPROWS) + rl) * 64 + dq * 8;
        v4u w; w.x = pk2(o[0], o[1]); w.y = pk2(o[2], o[3]); w.z = pk2(o[4], o[5]); w.w = pk2(o[6], o[7]); *(v4u*)dst = w;
    }
}

__device__ __forceinline__ void ld16(const void* p, bool isf32, float (&o)[16]) {
    if (isf32) { const f32x4* q = (const f32x4*)p;
#pragma unroll
        for (int i = 0; i < 4; ++i) { const f32x4 v = q[i]; o[4 * i] = v[0]; o[4 * i + 1] = v[1]; o[4 * i + 2] = v[2]; o[4 * i + 3] = v[3]; } }
    else { const v4u* q = (const v4u*)p;
#pragma unroll
        for (int i = 0; i < 2; ++i) { const v4u v = q[i]; o[8 * i] = bflo(v.x); o[8 * i + 1] = bfhi(v.x); o[8 * i + 2] = bflo(v.y); o[8 * i + 3] = bfhi(v.y); o[8 * i + 4] = bflo(v.z); o[8 * i + 5] = bfhi(v.z); o[8 * i + 6] = bflo(v.w); o[8 * i + 7] = bfhi(v.w); } }
}
#define WSYNC() asm volatile("s_waitcnt lgkmcnt(0)" ::: "memory")

template <bool PROMPT>
__device__ __forceinline__ void attn_item(const Args& a, int b, int g, int tg, int lane, const LAS float* bt, LAS float* sc, LAS float* scoreL, LAS int* flagL) {
    using namespace cfg;
    const int tl = lane >> 4, hh = (lane >> 2) & 3, dq = lane & 3, rowl = lane >> 2;
    const int t = tg * 4 + tl, pos = PROMPT ? t : PAST + t, row = PROMPT ? b * SEQ + t : MP + b * DS + t, head = g * 4 + hh;
    const int posmax = (PROMPT ? 0 : PAST) + tg * 4 + 3, posmin = posmax - 3;
    const bf16* KVB = (const bf16*)(a.ws + WS_KVB);
    float q[16]; ld16((const bf16*)(a.ws + WS_QB) + (size_t)row * DM + head * 64 + dq * 16, false, q);
    const float* gp = (const float*)(a.ws + WS_GATES) + (size_t)row * 48 + head * 3; const float g0 = gp[0], g1 = gp[1], g2 = gp[2];
    const LAS float* btr = bt + head * 128;
    float out[16];
    {
        const size_t cb = ((size_t)((PROMPT ? DB + b : b) * 4 + g) * 128) * 64;
        const bf16* KCb = (const bf16*)(a.ws + WS_KC) + cb; const bf16* VCb = (const bf16*)(a.ws + WS_VC) + cb;
        int ncw = posmax >= 31 ? ((posmax - 31) >> 4) + 1 : 0; if (ncw > 127) ncw = 127;
        float m = -1e30f;
        for (int c = 0; c < ncw; ++c) { float k[16]; ld16(KCb + c * 64 + dq * 16, false, k); float s = 0.f;
#pragma unroll
            for (int i = 0; i < 16; ++i) s += q[i] * k[i];
            s += __shfl_xor(s, 1); s += __shfl_xor(s, 2);
            const int dist = pos - (16 * c + 31); s = dist >= 0 ? s + btr[dist < 127 ? dist : 127] : -1e30f;
            if (dq == 0) sc[rowl * 128 + c] = s; m = fmaxf(m, s); }
        WSYNC();
        float l = 0.f;
        for (int c = dq; c < ncw; c += 4) { const float s = sc[rowl * 128 + c]; const float e = s > -1e29f ? exp2f(s - m) : 0.f; sc[rowl * 128 + c] = e; l += e; }
        l += __shfl_xor(l, 1); l += __shfl_xor(l, 2);
        const float inv = l > 0.f ? 1.f / l : 0.f;
        WSYNC();
        float oc[16];
#pragma unroll
        for (int i = 0; i < 16; ++i) oc[i] = 0.f;
        for (int c = 0; c < ncw; ++c) { const float pv = sc[rowl * 128 + c] * inv; float v[16]; ld16(VCb + c * 64 + dq * 16, false, v);
#pragma unroll
            for (int i = 0; i < 16; ++i) oc[i] += pv * v[i]; }
        WSYNC();
        if (dq == 0) scoreL[144 + rowl] = inv;
        WSYNC();
        const int nsel = PROMPT ? 32 : 33, j = lane & 15, blk = pos >> 6;
        for (int s = j; s < nsel; s += 16) { float imp = 0.f;
#pragma unroll
            for (int h2 = 0; h2 < 4; ++h2) { const float iv = scoreL[144 + tl * 4 + h2]; float sm = 0.f;
#pragma unroll
                for (int c = 4 * s - 1; c <= 4 * s + 3; ++c) if (c >= 0 && c < ncw) sm += sc[(tl * 4 + h2) * 128 + c];
                imp += sm * iv; }
            const bool valid = s * 64 <= pos, forced = (s == 0) || (s == blk) || (s == blk - 1);
            scoreL[tl * 36 + s] = valid ? imp + (forced ? 1000.f : 0.f) : -1.f; }
        WSYNC();
        for (int s = j; s < nsel; s += 16) { const float my = scoreL[tl * 36 + s]; int rank = 0;
            for (int s2 = 0; s2 < nsel; ++s2) { const float o = scoreL[tl * 36 + s2]; rank += ((o > my) || (o == my && s2 < s)) ? 1 : 0; }
            flagL[tl * 36 + s] = rank < 16 ? 1 : 0; }
        WSYNC();
#pragma unroll
        for (int i = 0; i < 16; ++i) out[i] = g0 * oc[i];
    }
    {
        float ms = -1e30f, ls = 0.f, os[16];
#pragma unroll
        for (int i = 0; i < 16; ++i) os[i] = 0.f;
        const int nblk = (posmax >> 6) + 1;
        for (int s = 0; s < nblk; ++s) {
            const int fl = flagL[tl * 36 + s];
            if (!__any(fl)) continue;
            int kend = posmax - s * 64 + 1; if (kend > 64) kend = 64;
            for (int kk = 0; kk < kend; ++kk) { const int kpos = s * 64 + kk;
                const void* kp; const void* vp; bool f32src = false;
                if (PROMPT) { const bf16* r = KVB + (size_t)(b * SEQ + kpos) * KVW + 512 + g * 64 + dq * 16; kp = r; vp = r + 256; }
                else if (kpos < PAST) { const int page = a.page_table[b * NPAGE + (kpos >> 7)]; const float* r = a.cache_sel + ((size_t)page * PAGE + (kpos & 127)) * 512 + g * 64 + dq * 16; kp = r; vp = r + 256; f32src = true; }
                else { const bf16* r = KVB + (size_t)(MP + b * DS + kpos - PAST) * KVW + 512 + g * 64 + dq * 16; kp = r; vp = r + 256; }
                float k[16]; ld16(kp, f32src, k); float sd = 0.f;
#pragma unroll
                for (int i = 0; i < 16; ++i) sd += q[i] * k[i];
                sd += __shfl_xor(sd, 1); sd += __shfl_xor(sd, 2);
                float v[16]; ld16(vp, f32src, v);
                if (fl && kpos <= pos) { const int dist = pos - kpos; const float sv = sd + btr[dist < 127 ? dist : 127];
                    if (sv > ms) { const float corr = exp2f(ms - sv); ls *= corr;
#pragma unroll
                        for (int i = 0; i < 16; ++i) os[i] *= corr;
                        ms = sv; }
                    const float pv = exp2f(sv - ms); ls += pv;
#pragma unroll
                    for (int i = 0; i < 16; ++i) os[i] += pv * v[i]; }
            }
        }
        const float sc1 = g1 / ls;
#pragma unroll
        for (int i = 0; i < 16; ++i) out[i] += sc1 * os[i];
    }
    {
        float ms = -1e30f, ls = 0.f, os[16];
#pragma unroll
        for (int i = 0; i < 16; ++i) os[i] = 0.f;
        int kstart = posmin - 511; if (kstart < 0) kstart = 0;
        for (int kpos = kstart; kpos <= posmax; ++kpos) {
            const void* kp; const void* vp; bool f32src = false;
            if (PROMPT) { const bf16* r = KVB + (size_t)(b * SEQ + kpos) * KVW + 1024 + g * 64 + dq * 16; kp = r; vp = r + 256; }
            else if (kpos < PAST) { const float* r = a.cache_win + ((size_t)b * 512 + (kpos - (PAST - 512))) * 512 + g * 64 + dq * 16; kp = r; vp = r + 256; f32src = true; }
            else { const bf16* r = KVB + (size_t)(MP + b * DS + kpos - PAST) * KVW + 1024 + g * 64 + dq * 16; kp = r; vp = r + 256; }
            float k[16]; ld16(kp, f32src, k); float sd = 0.f;
#pragma unroll
            for (int i = 0; i < 16; ++i) sd += q[i] * k[i];
            sd += __shfl_xor(sd, 1); sd += __shfl_xor(sd, 2);
            float v[16]; ld16(vp, f32src, v);
            const int dist = pos - kpos;
            if (dist >= 0 && dist < 512) { const float sv = sd + btr[dist < 127 ? dist : 127];
                if (sv > ms) { const float corr = exp2f(ms - sv); ls *= corr;
#pragma unroll
                    for (int i = 0; i < 16; ++i) os[i] *= corr;
                    ms = sv; }
                const float pv = exp2f(sv - ms); ls += pv;
#pragma unroll
                for (int i = 0; i < 16; ++i) os[i] += pv * v[i]; }
        }
        const float sc2 = g2 / ls;
#pragma unroll
        for (int i = 0; i < 16; ++i) out[i] += sc2 * os[i];
    }
    bf16* op = (bf16*)(a.ws + WS_OB) + (size_t)row * DM + head * 64 + dq * 16;
    v4u w0, w1; w0.x = pk2(out[0], out[1]); w0.y = pk2(out[2], out[3]); w0.z = pk2(out[4], out[5]); w0.w = pk2(out[6], out[7]);
    w1.x = pk2(out[8], out[9]); w1.y = pk2(out[10], out[11]); w1.z = pk2(out[12], out[13]); w1.w = pk2(out[14], out[15]);
    *(v4u*)op = w0; *(v4u*)(op + 8) = w1;
}

__device__ __forceinline__ void attn_phase(const Args& a, LAS unsigned char* lds, int G) {
    using namespace cfg;
    const int tid = threadIdx.x, lane = tid & 63, wave = tid >> 6;
    LAS float* bt = (LAS float*)lds;
    LAS float* sc = (LAS float*)(lds + 8192 + wave * 9728);
    LAS float* scoreL = sc + 16 * 128;
    LAS int* flagL = (LAS int*)(scoreL + 160);
    for (int i = tid; i < 16 * 128; i += NTHR) { const int h = i >> 7, d = i & 127;
        int bucket = d; if (d >= 16) { bucket = 16 + (int)(__logf((float)d / 16.f) / 2.0794415416798357f * 16.f); if (bucket > 31) bucket = 31; }
        bt[i] = a.rel_bias[bucket * 16 + h] * LOG2E; }
    __syncthreads();
    for (int v = blockIdx.x; v < 2048 + 128; v += G) {
        if (v < 2048) { const int j = v >> 8, k = v & 255, bg = k >> 3, r = k & 7;
            const int uidx = (j >> 1) * 16 + ((j & 1) ? 15 - r : r);
            attn_item<true>(a, bg >> 2, bg & 3, uidx * 8 + wave, lane, bt, sc, scoreL, flagL); }
        else { const int bs = v - 2048; attn_item<false>(a, bs, wave >> 1, wave & 1, lane, bt, sc, scoreL, flagL); }
    }
}

typedef short bf16x8 __attribute__((ext_vector_type(8)));
typedef short s16x4 __attribute__((ext_vector_type(4)));
typedef short v4i16_t __attribute__((ext_vector_type(4)));
typedef float f32x16 __attribute__((ext_vector_type(16)));
#define NEG_INF (-__builtin_inff())
__device__ __forceinline__ s16x4 vtr(const LAS unsigned char* p) { return __builtin_bit_cast(s16x4, __builtin_amdgcn_ds_read_tr16_b64_v4i16((LAS v4i16_t*)p)); }
__device__ __forceinline__ unsigned cvtpk(float lo, float hi) { unsigned r; asm volatile("v_cvt_pk_bf16_f32 %0, %1, %2" : "=v"(r) : "v"(lo), "v"(hi)); return r; }
constexpr int AT_BT = 0, AT_KS = 8192, AT_VS = 40960, AT_SC = 73728, AT_END = 81920;

__device__ __forceinline__ void tile_ld(const bf16* Kg, const bf16* Vg, int pitch, int wid, int lane, v4u& kr, v4u& vr) {
    kr = *(const v4u*)(Kg + (size_t)lane * pitch + wid * 8);
    vr = *(const v4u*)(Vg + (size_t)(16 * (wid & 3) + (lane >> 2)) * pitch + (wid >> 2) * 32 + (lane & 3) * 8);
}
__device__ __forceinline__ void tile_st(LAS unsigned char* lds, int slot, int wid, int lane, const v4u& kr, const v4u& vr) {
    *(LAS v4u*)(lds + AT_KS + slot * 8192 + wid * 1024 + lane * 16) = kr;
    *(LAS v4u*)(lds + AT_VS + slot * 8192 + wid * 1024 + lane * 16) = vr;
}
__device__ __forceinline__ void qk_tile(const LAS unsigned char* lds, int slot, const bf16x8 (&qf)[4], int r32, int hi, f32x16& p0, f32x16& p1) {
    const LAS unsigned char* kp = lds + AT_KS + slot * 8192 + hi * 1024 + r32 * 16;
    p0 = f32x16{}; p1 = f32x16{};
#pragma unroll
    for (int j = 0; j < 4; ++j) { const bf16x8 k0 = *(const LAS bf16x8*)(kp + j * 2048), k1 = *(const LAS bf16x8*)(kp + j * 2048 + 512);
        p0 = __builtin_amdgcn_mfma_f32_32x32x16_bf16(k0, qf[j], p0, 0, 0, 0); p1 = __builtin_amdgcn_mfma_f32_32x32x16_bf16(k1, qf[j], p1, 0, 0, 0); }
}
__device__ __forceinline__ void pv_img(const LAS unsigned char* vimg, int lane, int hi, const f32x16& p0, const f32x16& p1, f32x16 (&o)[2]) {
    const LAS unsigned char* vp = vimg + ((lane >> 4) & 1) * 32 + (lane & 3) * 8 + (4 * hi + ((lane & 15) >> 2)) * 64;
    bf16x8 pf[4];
#pragma unroll
    for (int k = 0; k < 4; ++k) { const f32x16& p = (k < 2) ? p0 : p1; const int b0 = (k & 1) * 8; v4u w;
        w.x = cvtpk(p[b0], p[b0 + 1]); w.y = cvtpk(p[b0 + 2], p[b0 + 3]); w.z = cvtpk(p[b0 + 4], p[b0 + 5]); w.w = cvtpk(p[b0 + 6], p[b0 + 7]); pf[k] = __builtin_bit_cast(bf16x8, w); }
#pragma unroll
    for (int db = 0; db < 2; ++db)
#pragma unroll
        for (int ks = 0; ks < 4; ++ks) { const s16x4 lo = vtr(vp + db * 4096 + ks * 1024), hv = vtr(vp + db * 4096 + ks * 1024 + 512);
            const bf16x8 vf = {lo[0], lo[1], lo[2], lo[3], hv[0], hv[1], hv[2], hv[3]};
            o[db] = __builtin_amdgcn_mfma_f32_32x32x16_bf16(vf, pf[ks], o[db], 0, 0, 0); }
}

__device__ __forceinline__ void pv_tile(const LAS unsigned char* lds, int slot, int lane, int hi, const f32x16& p0, const f32x16& p1, f32x16 (&o)[2]) { pv_img(lds + AT_VS + slot * 8192, lane, hi, p0, p1, o); }
template <int MODE>
__device__ __forceinline__ void bias_mask(f32x16& p0, f32x16& p1, int dbase, bool near, bool flag, const LAS float* btr, float b31) {
    if (near) {
#pragma unroll
        for (int r = 0; r < 16; ++r) { const int d0 = dbase - ((r & 3) + 8 * (r >> 2)), d1 = d0 - 32;
            const bool ok0 = flag && d0 >= 0 && (MODE == 1 || d0 < 512), ok1 = flag && d1 >= 0 && (MODE == 1 || d1 < 512);
            const float b0 = btr[d0 < 0 ? 0 : (d0 > 127 ? 127 : d0)], b1 = btr[d1 < 0 ? 0 : (d1 > 127 ? 127 : d1)];
            p0[r] = ok0 ? p0[r] + b0 : NEG_INF; p1[r] = ok1 ? p1[r] + b1 : NEG_INF; }
    } else {
#pragma unroll
        for (int r = 0; r < 16; ++r) { const int d0 = dbase - ((r & 3) + 8 * (r >> 2)), d1 = d0 - 32;
            const bool ok0 = flag && (MODE == 1 || d0 < 512), ok1 = flag && (MODE == 1 || d1 < 512);
            p0[r] = ok0 ? p0[r] + b31 : NEG_INF; p1[r] = ok1 ? p1[r] + b31 : NEG_INF; }
    }
}
__device__ __forceinline__ void online_update(f32x16& p0, f32x16& p1, float& m, float& l, f32x16 (&o)[2]) {
    float tmax = NEG_INF;
#pragma unroll
    for (int r = 0; r < 16; ++r) tmax = fmaxf(tmax, fmaxf(p0[r], p1[r]));
    tmax = fmaxf(tmax, __shfl_xor(tmax, 32));
    const float mn = fmaxf(m, tmax), ms = (mn == NEG_INF) ? 0.f : mn;
    const float corr = __builtin_amdgcn_exp2f(m - ms);
    float sum = 0.f;
#pragma unroll
    for (int r = 0; r < 16; ++r) { p0[r] = __builtin_amdgcn_exp2f(p0[r] - ms); p1[r] = __builtin_amdgcn_exp2f(p1[r] - ms); sum += p0[r] + p1[r]; }
    l = l * corr + sum; m = mn;
#pragma unroll
    for (int r = 0; r < 16; ++r) { o[0][r] *= corr; o[1][r] *= corr; }
}
template <int MODE>
__device__ __forceinline__ void flash_branch(LAS unsigned char* lds, const bf16* Kg, const bf16* Vg, int kt0, int kt1, const bf16x8 (&qf)[4], int pos, int posmin, int posmax,
                                             const LAS float* btr, float b31, unsigned selmask, float gate, f32x16 (&oacc)[2], int wid, int lane) {
    const int r32 = lane & 31, hi = lane >> 5;
    float m = NEG_INF, l = 0.f; f32x16 o[2]; o[0] = f32x16{}; o[1] = f32x16{};
    v4u kr, vr;
    __syncthreads();
    tile_ld(Kg + (size_t)kt0 * 64 * cfg::KVW, Vg + (size_t)kt0 * 64 * cfg::KVW, cfg::KVW, wid, lane, kr, vr);
    tile_st(lds, 0, wid, lane, kr, vr);
    __syncthreads();
    for (int kt = kt0; kt <= kt1; ++kt) {
        const int slot = (kt - kt0) & 1;
        if (kt < kt1) tile_ld(Kg + (size_t)(kt + 1) * 64 * cfg::KVW, Vg + (size_t)(kt + 1) * 64 * cfg::KVW, cfg::KVW, wid, lane, kr, vr);
        const bool flag = (MODE == 1) ? ((selmask >> kt) & 1u) != 0u : true;
        const bool wave_on = (MODE == 1) ? (__any(flag) != 0) : (posmin - (kt * 64 + 63) < 512);
        if (wave_on) {
            f32x16 p0, p1; qk_tile(lds, slot, qf, r32, hi, p0, p1);
            const bool near = (posmin - (kt * 64 + 63)) < 113;
            bias_mask<MODE>(p0, p1, pos - kt * 64 - 4 * hi, near, flag, btr, b31);
            online_update(p0, p1, m, l, o);
            pv_tile(lds, slot, lane, hi, p0, p1, o);
        }
        if (kt < kt1) tile_st(lds, slot ^ 1, wid, lane, kr, vr);
        __syncthreads();
    }
    l += __shfl_xor(l, 32);
    const float sc = l > 0.f ? gate / l : 0.f;
#pragma unroll
    for (int r = 0; r < 16; ++r) { oacc[0][r] += sc * o[0][r]; oacc[1][r] += sc * o[1][r]; }
}

template <bool SAMPLE>
__device__ __forceinline__ void cmp_softmax_topk(f32x16 (&p)[4], int pos, int tokl, int hh, int hi, int lane, const LAS float* btr, LAS float* scoreL, unsigned& selmask) {
        float mx = NEG_INF;
#pragma unroll
        for (int u = 0; u < 4; ++u)
#pragma unroll
            for (int r = 0; r < 16; ++r) { const int c = 32 * u + (r & 3) + 8 * (r >> 2) + 4 * hi; const int d = pos - 31 - 16 * c;
                const float bv = btr[d < 0 ? 0 : (d > 127 ? 127 : d)];
                p[u][r] = d >= 0 ? p[u][r] + bv : NEG_INF; mx = fmaxf(mx, p[u][r]); }
        mx = fmaxf(mx, __shfl_xor(mx, 32));
        const float ms = (mx == NEG_INF) ? 0.f : mx;
        float l = 0.f;
#pragma unroll
        for (int u = 0; u < 4; ++u)
#pragma unroll
            for (int r = 0; r < 16; ++r) { p[u][r] = __builtin_amdgcn_exp2f(p[u][r] - ms); l += p[u][r]; }
        l += __shfl_xor(l, 32);
        const float inv = l > 0.f ? 1.f / l : 0.f;
#pragma unroll
        for (int u = 0; u < 4; ++u)
#pragma unroll
            for (int r = 0; r < 16; ++r) p[u][r] *= inv;
        {
            float X[4][4];
#pragma unroll
            for (int u = 0; u < 4; ++u)
#pragma unroll
                for (int jq = 0; jq < 4; ++jq) X[u][jq] = __shfl_xor(p[u][4 * jq + 3], 32);
            const int blk = pos >> 6;
#pragma unroll
            for (int u = 0; u < 4; ++u)
#pragma unroll
                for (int jq = 0; jq < 4; ++jq) {
                    const float Gq = (p[u][4 * jq] + p[u][4 * jq + 1]) + (p[u][4 * jq + 2] + p[u][4 * jq + 3]);
                    const float xprev = (jq > 0) ? X[u][jq - 1] : (u > 0 ? X[u - 1][3] : 0.f);
                    float imp = Gq + (hi ? X[u][jq] : xprev);
                    imp += __shfl_xor(imp, 1); imp += __shfl_xor(imp, 2);
                    const int s = 8 * u + 2 * jq + hi;
                    const bool valid = s * 64 <= pos, forced = (s == 0) || (s == blk) || (s == blk - 1);
                    const float score = valid ? imp + (forced ? 1000.f : 0.f) : -1.f;
                    if (hh == 0) scoreL[tokl * 32 + s] = score;
                }
            WSYNC();
            const int tk = lane >> 3, i8 = lane & 7;
            float sc32[32];
#pragma unroll
            for (int q4 = 0; q4 < 8; ++q4) { const f32x4 v = *(const LAS f32x4*)(scoreL + tk * 32 + 4 * q4); sc32[4 * q4] = v[0]; sc32[4 * q4 + 1] = v[1]; sc32[4 * q4 + 2] = v[2]; sc32[4 * q4 + 3] = v[3]; }
#pragma unroll
            for (int j = 0; j < 4; ++j) { const int s = 8 * j + i8; const float my = scoreL[tk * 32 + s]; int rank = 0;
#pragma unroll
                for (int s2 = 0; s2 < 32; ++s2) rank += ((sc32[s2] > my) || (sc32[s2] == my && s2 < s)) ? 1 : 0;
                const unsigned long long bal = __ballot(rank < (SAMPLE ? 15 : 16));
                selmask |= ((unsigned)(bal >> (8 * tokl)) & 0xffu) << (8 * j); }
            WSYNC();
        }
}

__device__ __forceinline__ void attn_mfma_unit(const Args& a, int b, int g, int qt, LAS unsigned char* lds) {
    using namespace cfg;
    const int tid = threadIdx.x, lane = tid & 63, r32 = lane & 31, hi = lane >> 5;
    const int wid = __builtin_amdgcn_readfirstlane(tid >> 6);
    LAS float* scoreL = (LAS float*)(lds + AT_SC + wid * 1024);
    const int tokl = r32 >> 2, hh = r32 & 3, head = g * 4 + hh;
    const int posmin = qt * 64 + wid * 8, posmax = posmin + 7, pos = posmin + tokl, row = b * SEQ + pos;
    const LAS float* btr = (const LAS float*)(lds + AT_BT) + head * 128;
    const float b31 = btr[127];
    bf16x8 qf[4];
    { const bf16* qp = (const bf16*)(a.ws + WS_QB) + (size_t)row * DM + head * 64 + hi * 8;
#pragma unroll
      for (int s = 0; s < 4; ++s) qf[s] = *(const bf16x8*)(qp + 16 * s); }
    const float* gp = (const float*)(a.ws + WS_GATES) + (size_t)row * 48 + head * 3; const float g0 = gp[0], g1 = gp[1], g2 = gp[2];
    f32x16 oacc[2]; oacc[0] = f32x16{}; oacc[1] = f32x16{};
    unsigned selmask = 0u;
    {
        const size_t cb = ((size_t)((DB + b) * 4 + g) * 128) * 64;
        const bf16* KCb = (const bf16*)(a.ws + WS_KC) + cb; const bf16* VCb = (const bf16*)(a.ws + WS_VC) + cb;
        const int posmaxu = qt * 64 + 63; int ncu = ((posmaxu - 31) >> 4) + 1; if (ncu > 127) ncu = 127;
        const int ntile = (ncu + 63) >> 6;
        v4u kr, vr;
        __syncthreads();
        for (int tl = 0; tl < ntile; ++tl) { tile_ld(KCb + tl * 64 * 64, VCb + tl * 64 * 64, 64, wid, lane, kr, vr); tile_st(lds, tl, wid, lane, kr, vr); }
        __syncthreads();
        f32x16 p[4]; p[2] = f32x16{}; p[3] = f32x16{};
        qk_tile(lds, 0, qf, r32, hi, p[0], p[1]);
        if (ntile > 1) qk_tile(lds, 1, qf, r32, hi, p[2], p[3]);
        cmp_softmax_topk<false>(p, pos, tokl, hh, hi, lane, btr, scoreL, selmask);
        f32x16 o[2]; o[0] = f32x16{}; o[1] = f32x16{};
        pv_tile(lds, 0, lane, hi, p[0], p[1], o);
        if (ntile > 1) pv_tile(lds, 1, lane, hi, p[2], p[3], o);
#pragma unroll
        for (int r = 0; r < 16; ++r) { oacc[0][r] = g0 * o[0][r]; oacc[1][r] = g0 * o[1][r]; }
    }
    const bf16* KVB = (const bf16*)(a.ws + WS_KVB) + (size_t)b * SEQ * KVW + g * 64;
    flash_branch<1>(lds, KVB + 512, KVB + 768, 0, qt, qf, pos, posmin, posmax, btr, b31, selmask, g1, oacc, wid, lane);
    flash_branch<2>(lds, KVB + 1024, KVB + 1280, qt >= 8 ? qt - 8 : 0, qt, qf, pos, posmin, posmax, btr, b31, 0u, g2, oacc, wid, lane);
    bf16* op = (bf16*)(a.ws + WS_OB) + (size_t)row * DM + head * 64 + 4 * hi;
#pragma unroll
    for (int db = 0; db < 2; ++db)
#pragma unroll
        for (int jq = 0; jq < 4; ++jq) { v2u w; w.x = cvtpk(oacc[db][4 * jq], oacc[db][4 * jq + 1]); w.y = cvtpk(oacc[db][4 * jq + 2], oacc[db][4 * jq + 3]);
            *(v2u*)(op + 32 * db + 8 * jq) = w; }
}


template <bool F32> __device__ __forceinline__ bf16x8 ld8(const void* p) {
    if (F32) { const f32x4 a = *(const f32x4*)p, b = *((const f32x4*)p + 1); v4u w; w.x = cvtpk(a[0], a[1]); w.y = cvtpk(a[2], a[3]); w.z = cvtpk(b[0], b[1]); w.w = cvtpk(b[2], b[3]); return __builtin_bit_cast(bf16x8, w); }
    else return *(const bf16x8*)p;
}
template <bool F32, class RowFn> __device__ __forceinline__ void kfrag_load(const RowFn& rowp, int lane, bf16x8 (&kf)[8]) {
    typedef typename std::conditional<F32, float, bf16>::type T;
    const int r32 = lane & 31, hi = lane >> 5;
#pragma unroll
    for (int half = 0; half < 2; ++half) { const T* kp = (const T*)rowp(r32 + 32 * half) + 8 * hi;
#pragma unroll
        for (int j = 0; j < 4; ++j) kf[2 * j + half] = ld8<F32>(kp + 16 * j); }
}
template <bool F32, class RowFn> __device__ __forceinline__ void vimg_load(const RowFn& rowp, long voff, int lane, LAS unsigned char* vimg) {
    typedef typename std::conditional<F32, float, bf16>::type T;
    bf16x8 v[8];
#pragma unroll
    for (int i = 0; i < 8; ++i) { const T* vp = (const T*)rowp(16 * (i & 3) + (lane >> 2)) + voff + (i >> 2) * 32 + (lane & 3) * 8; v[i] = ld8<F32>(vp); }
    WSYNC();
#pragma unroll
    for (int i = 0; i < 8; ++i) *(LAS bf16x8*)(vimg + i * 1024 + lane * 16) = v[i];
    WSYNC();
}
__device__ __forceinline__ void qk_frags(const bf16x8 (&kf)[8], const bf16x8 (&qf)[4], f32x16& p0, f32x16& p1) {
    p0 = f32x16{}; p1 = f32x16{};
#pragma unroll
    for (int j = 0; j < 4; ++j) { p0 = __builtin_amdgcn_mfma_f32_32x32x16_bf16(kf[2 * j], qf[j], p0, 0, 0, 0); p1 = __builtin_amdgcn_mfma_f32_32x32x16_bf16(kf[2 * j + 1], qf[j], p1, 0, 0, 0); }
}

__device__ __forceinline__ void attn_sample_unit(const Args& a, int b, int gp, LAS unsigned char* lds) {
    using namespace cfg;
    const int tid = threadIdx.x, lane = tid & 63, r32 = lane & 31, hi = lane >> 5;
    const int wid = __builtin_amdgcn_readfirstlane(tid >> 6);
    const int g = 2 * gp + (wid >> 2), part = wid & 3;
    LAS unsigned char* vimg = lds + AT_KS + wid * 8192;
    LAS float* scoreL = (LAS float*)(lds + AT_SC + wid * 1024);
    const int tokl = r32 >> 2, hh = r32 & 3, head = g * 4 + hh;
    const int posmin = PAST, pos = PAST + tokl, row = MP + b * DS + tokl;
    const LAS float* btr = (const LAS float*)(lds + AT_BT) + head * 128;
    const float b31 = btr[127];
    bf16x8 qf[4];
    { const bf16* qp = (const bf16*)(a.ws + WS_QB) + (size_t)row * DM + head * 64 + hi * 8;
#pragma unroll
      for (int s = 0; s < 4; ++s) qf[s] = *(const bf16x8*)(qp + 16 * s); }
    const float* gpt = (const float*)(a.ws + WS_GATES) + (size_t)row * 48 + head * 3; const float g0 = gpt[0], g1 = gpt[1], g2 = gpt[2];
    LAS float* ocL = (LAS float*)(lds + AT_END + (wid >> 2) * 8192);
    unsigned selmask = 0u;
    __syncthreads();
    {
        const bf16* KCb = (const bf16*)(a.ws + WS_KC) + ((size_t)(b * 4 + g) * 128) * 64; const long voffc = (long)((WS_VC - WS_KC) / 2);
        f32x16 p[4]; bf16x8 kf[8];
        auto r0 = [&](int key) { return (const void*)(KCb + (size_t)key * 64); };
        auto r1 = [&](int key) { return (const void*)(KCb + (size_t)(64 + key) * 64); };
        kfrag_load<false>(r0, lane, kf); qk_frags(kf, qf, p[0], p[1]);
        kfrag_load<false>(r1, lane, kf); qk_frags(kf, qf, p[2], p[3]);
        cmp_softmax_topk<true>(p, pos, tokl, hh, hi, lane, btr, scoreL, selmask);
        if (part == 0) {
            f32x16 oc[2]; oc[0] = f32x16{}; oc[1] = f32x16{};
            vimg_load<false>(r0, voffc, lane, vimg); pv_img(vimg, lane, hi, p[0], p[1], oc);
            vimg_load<false>(r1, voffc, lane, vimg); pv_img(vimg, lane, hi, p[2], p[3], oc);
#pragma unroll
            for (int db = 0; db < 2; ++db)
#pragma unroll
                for (int r = 0; r < 16; ++r) ocL[(db * 16 + r) * 64 + lane] = g0 * oc[db][r];
        }
    }
    const bf16* KVBn = (const bf16*)(a.ws + WS_KVB) + (size_t)(MP + b * DS) * KVW + g * 64;
    float ms_ = NEG_INF, ls_ = 0.f; f32x16 os_[2]; os_[0] = f32x16{}; os_[1] = f32x16{};
    for (int kt = part; kt <= 32; kt += 4) {
        const bool flag = kt == 32 ? true : ((selmask >> kt) & 1u) != 0u;
        if (!__any(flag)) continue;
        f32x16 p0, p1; bf16x8 kf[8];
        const bool near = (posmin - (kt * 64 + 63)) < 113;
        if (kt < 32) {
            const int page = a.page_table[b * NPAGE + (kt >> 1)];
            const float* base = a.cache_sel + ((size_t)page * PAGE + (kt & 1) * 64) * 512 + g * 64;
            auto rf = [&](int key) { return (const void*)(base + (size_t)key * 512); };
            kfrag_load<true>(rf, lane, kf); vimg_load<true>(rf, 256, lane, vimg);
        } else {
            auto rf = [&](int key) { return (const void*)(KVBn + (size_t)(key < DS ? key : DS - 1) * KVW + 512); };
            kfrag_load<false>(rf, lane, kf); vimg_load<false>(rf, 256, lane, vimg);
        }
        qk_frags(kf, qf, p0, p1);
        bias_mask<1>(p0, p1, pos - kt * 64 - 4 * hi, near, flag, btr, b31);
        online_update(p0, p1, ms_, ls_, os_);
        pv_img(vimg, lane, hi, p0, p1, os_);
    }
    float mw_ = NEG_INF, lw_ = 0.f; f32x16 ow_[2]; ow_[0] = f32x16{}; ow_[1] = f32x16{};
    for (int i = part; i <= 8; i += 4) {
        f32x16 p0, p1; bf16x8 kf[8];
        const int key0 = (PAST - 512) + 64 * i;
        const bool near = (posmin - (key0 + 63)) < 113;
        if (i < 8) {
            const float* base = a.cache_win + ((size_t)b * 512 + 64 * i) * 512 + g * 64;
            auto rf = [&](int key) { return (const void*)(base + (size_t)key * 512); };
            kfrag_load<true>(rf, lane, kf); vimg_load<true>(rf, 256, lane, vimg);
        } else {
            auto rf = [&](int key) { return (const void*)(KVBn + (size_t)(key < DS ? key : DS - 1) * KVW + 1024); };
            kfrag_load<false>(rf, lane, kf); vimg_load<false>(rf, 256, lane, vimg);
        }
        qk_frags(kf, qf, p0, p1);
        bias_mask<2>(p0, p1, pos - key0 - 4 * hi, near, true, btr, b31);
        online_update(p0, p1, mw_, lw_, ow_);
        pv_img(vimg, lane, hi, p0, p1, ow_);
    }
    ls_ += __shfl_xor(ls_, 32); lw_ += __shfl_xor(lw_, 32);
    scoreL[lane] = ms_; scoreL[64 + lane] = ls_; scoreL[128 + lane] = mw_; scoreL[192 + lane] = lw_;
    __syncthreads();
    {
        const LAS float* st = (const LAS float*)(lds + AT_SC + (wid & 4) * 1024);
        float Ms = NEG_INF, Mw = NEG_INF;
#pragma unroll
        for (int w = 0; w < 4; ++w) { Ms = fmaxf(Ms, st[w * 256 + lane]); Mw = fmaxf(Mw, st[w * 256 + 128 + lane]); }
        float Ls = 0.f, Lw = 0.f;
#pragma unroll
        for (int w = 0; w < 4; ++w) { Ls += st[w * 256 + 64 + lane] * __builtin_amdgcn_exp2f(st[w * 256 + lane] - Ms); Lw += st[w * 256 + 192 + lane] * __builtin_amdgcn_exp2f(st[w * 256 + 128 + lane] - Mw); }
        const float fs = g1 * __builtin_amdgcn_exp2f(ms_ - Ms) / Ls, fw = g2 * __builtin_amdgcn_exp2f(mw_ - Mw) / Lw;
        LAS float* slab = (LAS float*)vimg;
#pragma unroll
        for (int db = 0; db < 2; ++db)
#pragma unroll
            for (int r = 0; r < 16; ++r) slab[(db * 16 + r) * 64 + lane] = fs * os_[db][r] + fw * ow_[db][r] + (part == 0 ? ocL[(db * 16 + r) * 64 + lane] : 0.f);
    }
    __syncthreads();
    if (part == 0) {
        const LAS float* sl = (const LAS float*)(lds + AT_KS + wid * 8192);
        bf16* op = (bf16*)(a.ws + WS_OB) + (size_t)row * DM + head * 64 + 4 * hi;
#pragma unroll
        for (int db = 0; db < 2; ++db)
#pragma unroll
            for (int jq = 0; jq < 4; ++jq) { float v[4];
#pragma unroll
                for (int e = 0; e < 4; ++e) { const int idx = (db * 16 + 4 * jq + e) * 64 + lane; v[e] = (sl[idx] + sl[2048 + idx]) + (sl[4096 + idx] + sl[6144 + idx]); }
                v2u w; w.x = cvtpk(v[0], v[1]); w.y = cvtpk(v[2], v[3]); *(v2u*)(op + 32 * db + 8 * jq) = w; }
    }
}

__device__ __forceinline__ void attn_phase2(const Args& a, LAS unsigned char* lds, int G) {
    using namespace cfg;
    const int tid = threadIdx.x, lane = tid & 63, wave = tid >> 6;
    LAS float* bt = (LAS float*)(lds + AT_BT);
    for (int i = tid; i < 16 * 128; i += NTHR) { const int h = i >> 7, d = i & 127;
        int bucket = d; if (d >= 16) { bucket = 16 + (int)(__logf((float)d / 16.f) / 2.0794415416798357f * 16.f); if (bucket > 31) bucket = 31; }
        bt[i] = a.rel_bias[bucket * 16 + h] * LOG2E; }
    __syncthreads();
    for (int v = blockIdx.x; v < 1024; v += G) { const int j = v >> 8, k = v & 255, bg = k >> 3, r = k & 7;
        const int qt = (j == 0) ? 31 - r : (j == 1) ? 16 + r : (j == 2) ? 15 - r : r;
        attn_mfma_unit(a, bg >> 2, bg & 3, qt, lds); }
    __syncthreads();
    for (int v = blockIdx.x; v < 2 * DB; v += G) attn_sample_unit(a, v >> 1, v & 1, lds);
}

constexpr int N_PHASES = 18;
__global__ void __launch_bounds__(NTHR, 2) yoco_fwd(Args args) {
    using namespace cfg;
    extern __shared__ __attribute__((aligned(16))) unsigned char lds_raw[];
    LAS unsigned char* lds = (LAS unsigned char*)lds_raw;
    const int tid = threadIdx.x, G = gridDim.x;
    unsigned char* ws = args.ws;
    for (int u = tid; u < (LDS_BYTES - RING_BYTES) / 4; u += NTHR) ((LAS unsigned*)(lds + RING_BYTES))[u] = 0u;
    __syncthreads();
    const bool one_launch = (args.ph_hi - args.ph_lo) > 1;
    XcdBarrier bar; bar.bar = (unsigned*)(ws + WS_CTL) + CW_BAR; bar.x = 0; bar.st = nullptr;
    if (one_launch) bar = xcd_barrier_post((unsigned*)(ws + WS_CTL) + CW_BAR, (volatile LAS unsigned*)(lds + MISC_OFF) + 8);
    const int lo = args.ph_lo, hi = args.ph_hi;
#define IN(k) (lo <= (k) && (k) < hi)
#define SEAM(k) do { if (IN(k) && IN((k) + 1)) xcd_barrier(bar); } while (0)
    bf16* const XB = (bf16*)(ws + WS_XB); bf16* const HAB = (bf16*)(ws + WS_HAB); bf16* const HBB = (bf16*)(ws + WS_HBB); bf16* const HFF = (bf16*)(ws + WS_HFF);
    float* const PRE = (float*)(ws + WS_PRE); float* const HA = (float*)(ws + WS_HA); float* const HB = (float*)(ws + WS_HB);

    if (IN(0)) { p0_prologue(args, lds, G); SEAM(0); }
    if (IN(1)) { pg8::Gemm g{XB, (const bf16*)(ws + WS_WIN), M, INPAD, DM}; pg8::StaticOrder S; S.init(M, INPAD, G, (int)blockIdx.x);
        pg8::EpiIn E{(bf16*)(ws + WS_ZX), (float*)(ws + WS_DT), args.out + O_PCONV, args.out + O_SCONV};
        pg8::gemm_phase<pg8::EpiIn, pg8::StaticOrder, true, true>(lds, g, S, E); SEAM(1); }
    if (IN(2)) { scan_phase(args, lds, G); SEAM(2); }
    if (IN(3)) { norm_phase(args, G); SEAM(3); }
    if (IN(4)) { pg8::Gemm g{(const bf16*)(ws + WS_YN), (const bf16*)(ws + WS_WOUT), M, DM, DIN}; pg8::StaticOrder S; S.init(M, DM, G, (int)blockIdx.x);
        pg8::EpiRes E{PRE, args.x_prompt, args.x_sample - (size_t)MP * DM};
        pg8::gemm_phase<pg8::EpiRes, pg8::StaticOrder, true, true>(lds, g, S, E); SEAM(4); }
    if (IN(5)) { ln_phase(PRE, args.ln_g + 0 * DM, args.ln_b + 0 * DM, HA, HAB, G); SEAM(5); }
    if (IN(6)) { pg8::Gemm g{HAB, (const bf16*)(ws + WS_W1), M, DFF, DM}; pg8::StaticOrder S; S.init(M, DFF, G, (int)blockIdx.x);
        pg8::EpiRelu2 E{HFF}; pg8::gemm_phase<pg8::EpiRelu2, pg8::StaticOrder, true, true>(lds, g, S, E); SEAM(6); }
    if (IN(7)) { pg8::Gemm g{HFF, (const bf16*)(ws + WS_W2), M, DM, DFF}; pg8::StaticOrder S; S.init(M, DM, G, (int)blockIdx.x);
        pg8::EpiRes E{PRE, HA, HA}; pg8::gemm_phase<pg8::EpiRes, pg8::StaticOrder, true, true>(lds, g, S, E); SEAM(7); }
    if (IN(8)) { ln_phase(PRE, args.ln_g + 1 * DM, args.ln_b + 1 * DM, HB, HBB, G); SEAM(8); }
    if (IN(9)) { pg8::Gemm g{HBB, (const bf16*)(ws + WS_WKVQ), M, KVQN, DM}; pg8::StaticOrder S; S.init(M, KVQN, G, (int)blockIdx.x);
        pg8::EpiKvq E{args.out, (bf16*)(ws + WS_KVB), (bf16*)(ws + WS_QB), (float*)(ws + WS_GATES), (bf16*)(ws + WS_ACMP)};
        pg8::gemm_phase<pg8::EpiKvq, pg8::StaticOrder, true, true>(lds, g, S, E); SEAM(9); }
    if (IN(10)) { pg8::Gemm g{(const bf16*)(ws + WS_ACMP), (const bf16*)(ws + WS_WC1), 2 * NCMPROWS, 512, 1024}; pg8::CmpOrder S{G, (int)blockIdx.x};
        pg8::EpiP E{(float*)(ws + WS_PCMP)}; pg8::gemm_phase<pg8::EpiP, pg8::CmpOrder, true, true>(lds, g, S, E); SEAM(10); }
    if (IN(11)) { cmp2_phase(args, lds, G); SEAM(11); }
    if (IN(12)) { attn_phase2(args, lds, G); SEAM(12); }
    if (IN(13)) { pg8::Gemm g{(const bf16*)(ws + WS_OB), (const bf16*)(ws + WS_WO), M, DM, DM}; pg8::StaticOrder S; S.init(M, DM, G, (int)blockIdx.x);
        pg8::EpiRes E{PRE, HB, HB}; pg8::gemm_phase<pg8::EpiRes, pg8::StaticOrder, true, true>(lds, g, S, E); SEAM(13); }
    if (IN(14)) { ln_phase(PRE, args.ln_g + 2 * DM, args.ln_b + 2 * DM, HA, HAB, G); SEAM(14); }
    if (IN(15)) { pg8::Gemm g{HAB, (const bf16*)(ws + WS_W1) + (size_t)DFF * DM, M, DFF, DM}; pg8::StaticOrder S; S.init(M, DFF, G, (int)blockIdx.x);
        pg8::EpiRelu2 E{HFF}; pg8::gemm_phase<pg8::EpiRelu2, pg8::StaticOrder, true, true>(lds, g, S, E); SEAM(15); }
    if (IN(16)) { pg8::Gemm g{HFF, (const bf16*)(ws + WS_W2) + (size_t)DFF * DM, M, DM, DFF}; pg8::StaticOrder S; S.init(M, DM, G, (int)blockIdx.x);
        pg8::EpiRes E{PRE, HA, HA}; pg8::gemm_phase<pg8::EpiRes, pg8::StaticOrder, true, true>(lds, g, S, E); SEAM(16); }
    if (IN(17)) { ln_phase(PRE, args.ln_g + 3 * DM, args.ln_b + 3 * DM, args.out + O_YP, nullptr, G); }
#undef IN
#undef SEAM
}

extern "C" void kernel_launch(void* const* d_in, const int* in_sizes, int n_in, void* d_out, int out_size, void* d_ws, size_t ws_size, hipStream_t stream) {
    using namespace cfg;
    static int grid = 0;
    if (grid == 0) {
        if (n_in != 27 || (size_t)out_size != O_END || ws_size < WS_END) { fprintf(stderr, "kernel_launch: unexpected shapes (n_in %d, out %d, ws %zu, need %zu); nothing launched\n", n_in, out_size, ws_size, (size_t)WS_END); grid = -1; return; }
        int dev = 0, cus = 0, per_cu = 0;
        if (hipGetDevice(&dev) != hipSuccess || hipDeviceGetAttribute(&cus, hipDeviceAttributeMultiprocessorCount, dev) != hipSuccess) { grid = -1; return; }
        if (hipFuncSetAttribute((const void*)yoco_fwd, hipFuncAttributeMaxDynamicSharedMemorySize, LDS_BYTES) != hipSuccess) { fprintf(stderr, "kernel_launch: hipFuncSetAttribute failed\n"); grid = -1; return; }
        if (hipOccupancyMaxActiveBlocksPerMultiprocessor(&per_cu, (const void*)yoco_fwd, NTHR, LDS_BYTES) != hipSuccess || per_cu < 1) { fprintf(stderr, "kernel_launch: occupancy query says %d blocks per CU\n", per_cu); }
        (void)hipGetLastError();
        grid = cus;
    }
    if (grid < 0) return;
    if (hipMemsetAsync((char*)d_ws + WS_CTL, 0, CTL_ZERO_BYTES, stream) != hipSuccess) { fprintf(stderr, "kernel_launch: memset failed\n"); return; }
    Args a{};
    const float* const* fin = (const float* const*)d_in;
    a.x_prompt = fin[0]; a.x_sample = fin[1]; a.state_ssm = fin[2]; a.state_conv = fin[3]; a.cache_cmp = fin[4]; a.cache_sel = fin[5]; a.cache_win = fin[6]; a.page_table = (const int*)d_in[7];
    a.ln_g = fin[8]; a.ln_b = fin[9]; a.m_in_w = fin[10]; a.m_conv_w = fin[11]; a.m_conv_b = fin[12]; a.m_dt_bias = fin[13]; a.m_a_log = fin[14]; a.m_d = fin[15]; a.m_norm_w = fin[16]; a.m_out_w = fin[17];
    a.kv_w = fin[18]; a.cmp_w1 = fin[19]; a.cmp_pe = fin[20]; a.cmp_w2 = fin[21]; a.q_w = fin[22]; a.o_w = fin[23]; a.rel_bias = fin[24]; a.mlp_w1 = fin[25]; a.mlp_w2 = fin[26];
    a.out = (float*)d_out; a.ws = (unsigned char*)d_ws; a.pad = 0;
    constexpr int NL = (MK_N_LAUNCHES == 1) ? 1 : N_PHASES;
    for (int li = 0; li < NL; ++li) {
        a.ph_lo = (NL == 1) ? 0 : li; a.ph_hi = (NL == 1) ? N_PHASES : li + 1; a.li = li;
        hipLaunchKernelGGL(yoco_fwd, dim3(grid), dim3(NTHR), LDS_BYTES, stream, a);
        const hipError_t le = hipPeekAtLastError();
        if (le != hipSuccess) { fprintf(stderr, "kernel_launch: launch %d failed: %s\n", li, hipGetErrorName(le)); break; }
    }
}
```

```cpp
#include <hip/hip_runtime.h>
#include <cstdio>
#include <cstdint>
#include <type_traits>

#ifndef MK_N_LAUNCHES
#define MK_N_LAUNCHES 1
#endif

namespace cfg {
constexpr int DM = 1024, NPB = 8, SEQ = 2048, DB = 128, DS = 8, PAST = 2048, PAGE = 128, NPAGE = PAST / PAGE;
constexpr int MP = NPB * SEQ, MS = DB * DS, M = MP + MS;
constexpr int DFF = 4096, DIN = 2048, NH = 32, HD = 64, NG = 4, HPG = 8, DST = 128, CONVD = 3072, INDIM = 5152, INPAD = 5376, ZXW = 5120;
constexpr int AH = 16, AKV = 4, AGRP = 4, KVW = 1536, QGW = 1072, KVQN = 2816, KVROW = 512;
constexpr int NCMPROWS = (DB + NPB) * AKV * 128;
constexpr float LN_EPS = 1e-5f, RMS_EPS = 1e-5f;
constexpr float ALPHA = 1.4142135623730951f;
constexpr float LOG2E = 1.4426950408889634f;
constexpr float QSCALE = 0.125f * LOG2E;
constexpr size_t O_YP = 0, O_YS = O_YP + (size_t)MP * DM, O_PSSM = O_YS + (size_t)MS * DM, O_PCONV = O_PSSM + (size_t)NPB * NH * HD * DST,
                 O_PCMP = O_PCONV + (size_t)NPB * 3 * CONVD, O_PSEL = O_PCMP + (size_t)MP * KVROW, O_PWIN = O_PSEL + (size_t)MP * KVROW,
                 O_SSSM = O_PWIN + (size_t)NPB * 512 * KVROW, O_SCONV = O_SSSM + (size_t)DB * NH * HD * DST, O_SCMP = O_SCONV + (size_t)DB * 3 * CONVD,
                 O_SSEL = O_SCMP + (size_t)MS * KVROW, O_SWIN = O_SSEL + (size_t)MS * KVROW, O_END = O_SWIN + (size_t)DB * 512 * KVROW;
static_assert(O_END == 108208128ull, "output size");
constexpr size_t MiB = 1u << 20;
constexpr size_t al(size_t x) { return (x + MiB - 1) / MiB * MiB; }
constexpr size_t WS_CTL = 0, CTL_ZERO_BYTES = MiB;
constexpr size_t WS_WIN = MiB;
constexpr size_t WS_WOUT = WS_WIN + al((size_t)INPAD * DM * 2);
constexpr size_t WS_W1 = WS_WOUT + al((size_t)DM * DIN * 2);
constexpr size_t WS_W2 = WS_W1 + 2 * al((size_t)DFF * DM * 2);
constexpr size_t WS_WKVQ = WS_W2 + 2 * al((size_t)DFF * DM * 2);
constexpr size_t WS_WO = WS_WKVQ + al((size_t)KVQN * DM * 2);
constexpr size_t WS_WC1 = WS_WO + al((size_t)DM * DM * 2);
constexpr size_t WS_PEC = WS_WC1 + al((size_t)512 * 1024 * 2);
constexpr size_t WS_XB = WS_PEC + MiB;
constexpr size_t WS_ZX = WS_XB + al((size_t)M * DM * 2);
constexpr size_t WS_DT = WS_ZX + al((size_t)M * ZXW * 2);
constexpr size_t WS_YG = WS_DT + al((size_t)M * 32 * 4);
constexpr size_t WS_SSQ = WS_YG + al((size_t)M * DIN * 2);
constexpr size_t WS_YN = WS_SSQ + al((size_t)M * 32 * 4);
constexpr size_t WS_PRE = WS_YN + al((size_t)M * DIN * 2);
constexpr size_t WS_HA = WS_PRE + al((size_t)M * DM * 4);
constexpr size_t WS_HB = WS_HA + al((size_t)M * DM * 4);
constexpr size_t WS_HAB = WS_HB + al((size_t)M * DM * 4);
constexpr size_t WS_HBB = WS_HAB + al((size_t)M * DM * 2);
constexpr size_t WS_HFF = WS_HBB + al((size_t)M * DM * 2);
constexpr size_t WS_KVB = WS_HFF + al((size_t)M * DFF * 2);
constexpr size_t WS_QB = WS_KVB + al((size_t)M * KVW * 2);
constexpr size_t WS_GATES = WS_QB + al((size_t)M * DM * 2);
constexpr size_t WS_ACMP = WS_GATES + al((size_t)M * 48 * 4);
constexpr size_t WS_PCMP = WS_ACMP + al((size_t)2 * NCMPROWS * 1024 * 2);
constexpr size_t WS_KC = WS_PCMP + al((size_t)2 * NCMPROWS * 256 * 4);
constexpr size_t WS_VC = WS_KC + al((size_t)NCMPROWS * 64 * 2);
constexpr size_t WS_OB = WS_VC + al((size_t)NCMPROWS * 64 * 2);
constexpr size_t WS_END = WS_OB + al((size_t)M * DM * 2);
constexpr int CW_BAR = 4096;
constexpr int RING_BYTES = 131072, MISC_OFF = RING_BYTES + 320, LDS_BYTES = 147456;
}

#define GAS __attribute__((address_space(1)))
#define LAS __attribute__((address_space(3)))
typedef unsigned short bf16;
typedef unsigned v4u __attribute__((ext_vector_type(4)));
typedef unsigned v2u __attribute__((ext_vector_type(2)));
typedef float f32x4 __attribute__((ext_vector_type(4)));
#define LDS_WAIT() asm volatile("s_waitcnt lgkmcnt(0)" ::: "memory")
#define VM_WAIT() asm volatile("s_waitcnt vmcnt(0)" ::: "memory")
__device__ __forceinline__ unsigned f2bf(float f) { unsigned u = __builtin_bit_cast(unsigned, f); return (u + 0x7fffu + ((u >> 16) & 1u)) >> 16; }
__device__ __forceinline__ unsigned pk2(float lo, float hi) { return f2bf(lo) | (f2bf(hi) << 16); }
__device__ __forceinline__ float bf2f(unsigned short b) { return __builtin_bit_cast(float, ((unsigned)b) << 16); }
__device__ __forceinline__ float bflo(unsigned w) { return __builtin_bit_cast(float, w << 16); }
__device__ __forceinline__ float bfhi(unsigned w) { return __builtin_bit_cast(float, w & 0xffff0000u); }

namespace pg8 {
#define PG8_LAS __attribute__((address_space(3)))
typedef unsigned short bf16_t;
typedef short bf16x8 __attribute__((ext_vector_type(8)));
typedef float f32x4 __attribute__((ext_vector_type(4)));
typedef unsigned u32x4 __attribute__((ext_vector_type(4)));
constexpr int BM = 256, BK = 64, HALF = 128, HTB = HALF * BK * 2  , STAGE_BYTES = 8 * HTB, NXCD = 8, WGM = 8;

__host__ __device__ __forceinline__ int lds_byte(int r, int c) { const int st = (r >> 4) * 2 + (c >> 5), rr = r & 15, cc = c & 31, ob = rr * 64 + cc * 2; return st * 1024 + (ob ^ (((ob >> 9) & 1) << 5)); }
__host__ __device__ __forceinline__ void stage_rc(int b, int& R, int& C) { const int st = b / 1024, sb = b % 1024, swz = sb ^ (((sb >> 9) & 1) << 5); R = (st >> 1) * 16 + swz / 64; C = (st & 1) * 32 + (swz % 64) / 2; }
__host__ __device__ __forceinline__ int perm32(int rho) { const int n = rho >> 4, i = rho & 15; return 8 * (i >> 2) + 4 * n + (i & 3); }

struct Unit { int pm, pn; };
struct Gemm { const bf16_t* A; const bf16_t* Bt; int M, N, K; };

struct StaticOrder {
    int nM, nN, nwg, G, c;
    __host__ __device__ void init(int M, int N, int G_, int c_) { nM = M / BM; nN = N / BM; nwg = nM * nN; G = G_; c = c_; }
    __host__ __device__ bool next(int i, Unit& u) const {
        const long L = (long)i * G + c; if (L >= nwg) return false;
        int wgid = (int)L; { const int q = nwg / NXCD, r = nwg % NXCD, xcd = wgid % NXCD, off = wgid / NXCD; wgid = (xcd < r ? xcd * (q + 1) : r * (q + 1) + (xcd - r) * q) + off; }
        const int nig = WGM * nN, gid = wgid / nig, fm = gid * WGM, gsz = (nM - fm) < WGM ? (nM - fm) : WGM;
        u.pm = fm + ((wgid % nig) % gsz); u.pn = (wgid % nig) / gsz; return true;
    }
    __device__ __forceinline__ void a_ready(const Unit&) const {}
    __device__ __forceinline__ void done(const Unit&) const {}
};

__device__ __forceinline__ unsigned cvt_pk_bf16(float lo, float hi) { unsigned r; asm volatile("v_cvt_pk_bf16_f32 %0, %1, %2" : "=v"(r) : "v"(lo), "v"(hi)); return r; }
typedef unsigned u32x2 __attribute__((ext_vector_type(2)));

struct CmpOrder {
    int G, c;
    __device__ bool next(int i, Unit& u) const { const int L = i * G + c; if (L >= 544) return false; u.pm = L; u.pn = L >= 272 ? 1 : 0; return true; }
    __device__ __forceinline__ void a_ready(const Unit&) const {}
    __device__ __forceinline__ void done(const Unit&) const {}
};

struct EpiIn {
    static constexpr bool PERM = false, AFTER_DRAIN = false;
    bf16_t* ZX; float* DT; float* pconv; float* sconv;
    __device__ __forceinline__ void operator()(const f32x4 (&acc)[2][2][4][2], const Unit& u, int wr, int wc, int fr, int fq) const {
        const int colt = u.pn * BM + wc * 32 + 4 * fq;
#pragma unroll
        for (int ai = 0; ai < 2; ++ai)
#pragma unroll
            for (int m = 0; m < 4; ++m) {
                const int row = u.pm * BM + ai * HALF + wr * 64 + m * 16 + fr;
                float* cptr = nullptr;
                if (row < cfg::MP) { const int t = row & 2047; if (t >= 2045) cptr = pconv + (size_t)((row >> 11) * 3 + (t - 2045)) * cfg::CONVD; }
                else { const int sr = row - cfg::MP, t = sr & 7; if (t >= 5) cptr = sconv + (size_t)((sr >> 3) * 3 + (t - 5)) * cfg::CONVD; }
#pragma unroll
                for (int bj = 0; bj < 2; ++bj)
#pragma unroll
                    for (int n = 0; n < 2; ++n) {
                        const int col = colt + bj * HALF + n * 16; const f32x4 v = acc[ai][bj][m][n];
                        if (col < cfg::ZXW) {
                            u32x2 w; w.x = cvt_pk_bf16(v[0], v[1]); w.y = cvt_pk_bf16(v[2], v[3]);
                            *(u32x2*)(ZX + (size_t)row * cfg::ZXW + col) = w;
                            if (cptr && col >= cfg::DIN) *(f32x4*)(cptr + (col - cfg::DIN)) = v;
                        } else if (col < cfg::INDIM) *(f32x4*)(DT + (size_t)row * 32 + (col - cfg::ZXW)) = v;
                    }
            }
    }
};
struct EpiRes {
    static constexpr bool PERM = false, AFTER_DRAIN = false;
    float* out; const float* resA; const float* resB;
    __device__ __forceinline__ void operator()(const f32x4 (&acc)[2][2][4][2], const Unit& u, int wr, int wc, int fr, int fq) const {
        const int colt = u.pn * BM + wc * 32 + 4 * fq;
#pragma unroll
        for (int ai = 0; ai < 2; ++ai)
#pragma unroll
            for (int m = 0; m < 4; ++m) {
                const int row = u.pm * BM + ai * HALF + wr * 64 + m * 16 + fr;
                const float* rp = (row < cfg::MP ? resA : resB) + (size_t)row * cfg::DM + colt; float* op = out + (size_t)row * cfg::DM + colt;
#pragma unroll
                for (int bj = 0; bj < 2; ++bj)
#pragma unroll
                    for (int n = 0; n < 2; ++n) { const f32x4 r = *(const f32x4*)(rp + bj * HALF + n * 16); *(f32x4*)(op + bj * HALF + n * 16) = acc[ai][bj][m][n] + r * cfg::ALPHA; }
            }
    }
};
struct EpiRelu2 {
    static constexpr bool PERM = true, AFTER_DRAIN = false;
    bf16_t* O;
    __device__ __forceinline__ void operator()(const f32x4 (&acc)[2][2][4][2], const Unit& u, int wr, int wc, int fr, int fq) const {
        const int col0 = u.pn * BM + wc * 32 + 8 * fq;
#pragma unroll
        for (int ai = 0; ai < 2; ++ai)
#pragma unroll
            for (int m = 0; m < 4; ++m) { bf16_t* rowp = O + (size_t)(u.pm * BM + ai * HALF + wr * 64 + m * 16 + fr) * cfg::DFF + col0;
#pragma unroll
                for (int bj = 0; bj < 2; ++bj) { f32x4 v0 = acc[ai][bj][m][0], v1 = acc[ai][bj][m][1];
#pragma unroll
                    for (int j = 0; j < 4; ++j) { const float a = fmaxf(v0[j], 0.f), b = fmaxf(v1[j], 0.f); v0[j] = a * a; v1[j] = b * b; }
                    u32x4 w; w.x = cvt_pk_bf16(v0[0], v0[1]); w.y = cvt_pk_bf16(v0[2], v0[3]); w.z = cvt_pk_bf16(v1[0], v1[1]); w.w = cvt_pk_bf16(v1[2], v1[3]);
                    *(u32x4*)(rowp + bj * HALF) = w; } }
    }
};
struct EpiKvq {
    static constexpr bool PERM = false, AFTER_DRAIN = false;
    float* out; bf16_t* KVB; bf16_t* QB; float* GATES; bf16_t* ACMP;
    __device__ __forceinline__ void operator()(const f32x4 (&acc)[2][2][4][2], const Unit& u, int wr, int wc, int fr, int fq) const {
        const int colt = u.pn * BM + wc * 32 + 4 * fq;
#pragma unroll
        for (int ai = 0; ai < 2; ++ai)
#pragma unroll
            for (int m = 0; m < 4; ++m) {
                const int row = u.pm * BM + ai * HALF + wr * 64 + m * 16 + fr;
                const bool prompt = row < cfg::MP; const int sr = row - cfg::MP;
                const int b = prompt ? (row >> 11) : (sr >> 3), t = prompt ? (row & 2047) : (sr & 7);
#pragma unroll
                for (int bj = 0; bj < 2; ++bj)
#pragma unroll
                    for (int n = 0; n < 2; ++n) {
                        const int col = colt + bj * HALF + n * 16; const f32x4 v = acc[ai][bj][m][n];
                        if (col < cfg::KVW) {
                            const int br = col >> 9, cc = col & 511;
                            float* dst = nullptr;
                            if (prompt) { if (br == 0) dst = out + cfg::O_PCMP + (size_t)row * 512 + cc; else if (br == 1) dst = out + cfg::O_PSEL + (size_t)row * 512 + cc;
                                          else if (t >= 1536) dst = out + cfg::O_PWIN + (size_t)(b * 512 + t - 1536) * 512 + cc; }
                            else { if (br == 0) dst = out + cfg::O_SCMP + (size_t)sr * 512 + cc; else if (br == 1) dst = out + cfg::O_SSEL + (size_t)sr * 512 + cc;
                                   else dst = out + cfg::O_SWIN + (size_t)(b * 512 + 504 + t) * 512 + cc; }
                            if (dst) *(f32x4*)dst = v;
                            u32x2 w; w.x = cvt_pk_bf16(v[0], v[1]); w.y = cvt_pk_bf16(v[2], v[3]);
                            *(u32x2*)(KVB + (size_t)row * cfg::KVW + col) = w;
                            if (prompt && br == 0) { const int kv = cc >> 8, g = (cc >> 6) & 3, d = cc & 63;
                                *(u32x2*)(ACMP + ((size_t)kv * cfg::NCMPROWS + 65536 + (size_t)(b * 4 + g) * 128 + (t >> 4)) * 1024 + (t & 15) * 64 + d) = w; }
                        } else if (col < cfg::KVW + 1024) {
                            u32x2 w; w.x = cvt_pk_bf16(v[0] * cfg::QSCALE, v[1] * cfg::QSCALE); w.y = cvt_pk_bf16(v[2] * cfg::QSCALE, v[3] * cfg::QSCALE);
                            *(u32x2*)(QB + (size_t)row * cfg::DM + (col - cfg::KVW)) = w;
                        } else if (col < cfg::KVW + cfg::QGW) {
                            f32x4 s;
#pragma unroll
                            for (int j = 0; j < 4; ++j) s[j] = 1.f / (1.f + __expf(-v[j]));
                            *(f32x4*)(GATES + (size_t)row * 48 + (col - cfg::KVW - 1024)) = s;
                        }
                    }
            }
    }
};
struct EpiP {
    static constexpr bool PERM = false, AFTER_DRAIN = false;
    float* P;
    __device__ __forceinline__ void operator()(const f32x4 (&acc)[2][2][4][2], const Unit& u, int wr, int wc, int fr, int fq) const {
        const int colt = wc * 32 + 4 * fq;
#pragma unroll
        for (int ai = 0; ai < 2; ++ai)
#pragma unroll
            for (int m = 0; m < 4; ++m) { float* op = P + (size_t)(u.pm * BM + ai * HALF + wr * 64 + m * 16 + fr) * 256 + colt;
#pragma unroll
                for (int bj = 0; bj < 2; ++bj)
#pragma unroll
                    for (int n = 0; n < 2; ++n) *(f32x4*)(op + bj * HALF + n * 16) = acc[ai][bj][m][n]; }
    }
};

template <class Epi, class Sched, bool ALIGN_EPI = false, bool SP2 = false>
__device__ __forceinline__ void gemm_phase(PG8_LAS unsigned char* lds, const Gemm g, const Sched& S, const Epi& E) {
    const int tid = threadIdx.x, wid = __builtin_amdgcn_readfirstlane(tid >> 6), lane = tid & 63, wr = wid >> 2, wc = wid & 3, fr = lane & 15, fq = lane >> 4;
    const int K = g.K, nt = K / BK;
    unsigned voffA[2], voffB[2];
#pragma unroll
    for (int i = 0; i < 2; ++i) { int R, C; stage_rc(tid * 16 + i * 8192, R, C); const int Rb = Epi::PERM ? ((R & ~31) + perm32(R & 31)) : R;
        voffA[i] = (unsigned)(R * K + C) * 2u; voffB[i] = (unsigned)(Rb * K + C) * 2u; }
    const size_t kstep = (size_t)(BK * 2);
    const size_t hstep = (size_t)HALF * K * 2;
    const size_t tstep = 2 * hstep;
    const unsigned ldsw = (unsigned)wid * 1024u;
    const int aoff = lds_byte(wr * 64 + fr, fq * 8), boff = lds_byte(wc * 32 + fr, fq * 8);
#define PG8_SA(b, h) (((b) * 2 + (h)) * HTB)
#define PG8_SB(b, h) ((4 + (b) * 2 + (h)) * HTB)
#define PG8_STAGE(bufoff, gbase, voff) do { _Pragma("unroll") for (int _i = 0; _i < 2; ++_i) \
        __builtin_amdgcn_global_load_lds((const unsigned*)((const char*)(gbase) + (voff)[_i]), (PG8_LAS unsigned*)(lds + (bufoff) + ldsw + _i * 8192), 16, 0, 0); } while (0)
#define PG8_LDA(dst, b, h) do { _Pragma("unroll") for (int m = 0; m < 4; ++m) _Pragma("unroll") for (int k = 0; k < 2; ++k) dst[m][k] = *(const PG8_LAS bf16x8*)(lds + PG8_SA(b, h) + aoff + m * 2048 + k * 1024); } while (0)
#define PG8_LDB(dst, b, h) do { _Pragma("unroll") for (int n = 0; n < 2; ++n) _Pragma("unroll") for (int k = 0; k < 2; ++k) dst[n][k] = *(const PG8_LAS bf16x8*)(lds + PG8_SB(b, h) + boff + n * 2048 + k * 1024); } while (0)
#define PG8_MMA(ai, bj, At, Bt) do { __builtin_amdgcn_s_setprio(1); _Pragma("unroll") for (int m = 0; m < 4; ++m) _Pragma("unroll") for (int n = 0; n < 2; ++n) _Pragma("unroll") for (int k = 0; k < 2; ++k) \
        acc[ai][bj][m][n] = __builtin_amdgcn_mfma_f32_16x16x32_bf16(Bt[n][k], At[m][k], acc[ai][bj][m][n], 0, 0, 0); __builtin_amdgcn_s_setprio(0); } while (0)
#define PG8_WAIT_V(n) asm volatile("s_waitcnt vmcnt(" #n ")" ::: "memory")
#define PG8_WAIT_L(n) asm volatile("s_waitcnt lgkmcnt(" #n ")" ::: "memory")
#define PG8_BAR __builtin_amdgcn_s_barrier()
#define PG8_SCHED __builtin_amdgcn_sched_barrier(0)
    Unit cur, nxt; int ui = 0;
    if (!S.next(0, cur)) return;
    f32x4 acc[2][2][4][2];
#pragma unroll
    for (int a = 0; a < 2; ++a)
#pragma unroll
        for (int b = 0; b < 2; ++b)
#pragma unroll
            for (int m = 0; m < 4; ++m)
#pragma unroll
                for (int n = 0; n < 2; ++n) acc[a][b][m][n] = (f32x4){0.f, 0.f, 0.f, 0.f};
    bf16x8 At[4][2], B0[2][2], B1[2][2];
    const char* cA = (const char*)g.A + (size_t)cur.pm * tstep; const char* cB = (const char*)g.Bt + (size_t)cur.pn * tstep;
    S.a_ready(cur);
    if constexpr (SP2) {
        PG8_STAGE(PG8_SB(0, 0), cB, voffB); PG8_STAGE(PG8_SB(0, 1), cB + hstep, voffB); PG8_STAGE(PG8_SA(0, 0), cA, voffA); PG8_STAGE(PG8_SA(0, 1), cA + hstep, voffA);
        if (wr == 1) PG8_BAR;
        PG8_WAIT_V(2); PG8_BAR;
        PG8_STAGE(PG8_SB(1, 0), cB + kstep, voffB); PG8_STAGE(PG8_SA(1, 0), cA + kstep, voffA); PG8_STAGE(PG8_SB(1, 1), cB + hstep + kstep, voffB);
        PG8_WAIT_V(6); PG8_BAR;
    } else {
        PG8_STAGE(PG8_SB(0, 0), cB, voffB); PG8_STAGE(PG8_SA(0, 0), cA, voffA); PG8_STAGE(PG8_SB(0, 1), cB + hstep, voffB); PG8_STAGE(PG8_SA(0, 1), cA + hstep, voffA);
        if (wr == 1) PG8_BAR;
        PG8_WAIT_V(4); PG8_BAR;
        PG8_STAGE(PG8_SB(1, 0), cB + kstep, voffB); PG8_STAGE(PG8_SA(1, 0), cA + kstep, voffA); PG8_STAGE(PG8_SB(1, 1), cB + hstep + kstep, voffB);
        PG8_WAIT_V(6); PG8_BAR;
    }
    for (;;) {
        const bool has_next = S.next(ui + 1, nxt);
        const char* nA = has_next ? (const char*)g.A + (size_t)nxt.pm * tstep : cA; const char* nB = has_next ? (const char*)g.Bt + (size_t)nxt.pn * tstep : cB;
        for (int t = 0; t < nt; t += 2) {
            const bool last = (t == nt - 2);
            const char* a1 = cA + (size_t)(t + 1) * kstep;
            const char* a2 = last ? nA : cA + (size_t)(t + 2) * kstep; const char* b2 = last ? nB : cB + (size_t)(t + 2) * kstep;
            const char* a3 = a2 + kstep; const char* b3 = b2 + kstep;
            if (last && has_next) S.a_ready(nxt);
            if constexpr (SP2) {
            PG8_LDB(B0, 0, 0); PG8_LDB(B1, 0, 1); PG8_SCHED; PG8_LDA(At, 0, 0); PG8_STAGE(PG8_SA(1, 1), a1 + hstep, voffA);
            PG8_WAIT_V(8); PG8_WAIT_L(0); PG8_BAR; PG8_MMA(0, 0, At, B0); PG8_MMA(0, 1, At, B1); PG8_BAR; PG8_SCHED;
            PG8_LDA(At, 0, 1); PG8_STAGE(PG8_SB(0, 0), b2, voffB); PG8_STAGE(PG8_SB(0, 1), b2 + hstep, voffB); PG8_STAGE(PG8_SA(0, 0), a2, voffA);
            PG8_WAIT_V(8); PG8_WAIT_L(0); PG8_BAR; PG8_MMA(1, 0, At, B0); PG8_MMA(1, 1, At, B1); PG8_BAR; PG8_SCHED;
            PG8_LDB(B0, 1, 0); PG8_LDB(B1, 1, 1); PG8_SCHED; PG8_LDA(At, 1, 0); PG8_STAGE(PG8_SA(0, 1), a2 + hstep, voffA);
            PG8_WAIT_V(8); PG8_WAIT_L(0); PG8_BAR; PG8_MMA(0, 0, At, B0); PG8_MMA(0, 1, At, B1); PG8_BAR; PG8_SCHED;
            PG8_LDA(At, 1, 1); PG8_STAGE(PG8_SB(1, 0), b3, voffB); PG8_STAGE(PG8_SB(1, 1), b3 + hstep, voffB); PG8_STAGE(PG8_SA(1, 0), a3, voffA);
            PG8_WAIT_V(8); PG8_WAIT_L(0); PG8_BAR; PG8_MMA(1, 0, At, B0); PG8_MMA(1, 1, At, B1); PG8_BAR; PG8_SCHED;
            } else {
            PG8_LDB(B0, 0, 0); PG8_SCHED; PG8_LDA(At, 0, 0); PG8_STAGE(PG8_SA(1, 1), a1 + hstep, voffA);
            PG8_WAIT_L(8); PG8_BAR; PG8_WAIT_L(0); PG8_MMA(0, 0, At, B0); PG8_BAR; PG8_SCHED;
            PG8_LDB(B1, 0, 1); PG8_STAGE(PG8_SB(0, 0), b2, voffB);
            PG8_BAR; PG8_WAIT_L(0); PG8_MMA(0, 1, At, B1); PG8_BAR;
            PG8_LDA(At, 0, 1); PG8_STAGE(PG8_SA(0, 0), a2, voffA);
            PG8_BAR; PG8_WAIT_L(0); PG8_MMA(1, 0, At, B0); PG8_BAR; PG8_SCHED;
            PG8_STAGE(PG8_SB(0, 1), b2 + hstep, voffB);
            PG8_WAIT_V(6); PG8_BAR; PG8_MMA(1, 1, At, B1); PG8_BAR;
            PG8_LDB(B0, 1, 0); PG8_SCHED; PG8_LDA(At, 1, 0); PG8_STAGE(PG8_SA(0, 1), a2 + hstep, voffA);
            PG8_WAIT_L(8); PG8_BAR; PG8_WAIT_L(0); PG8_MMA(0, 0, At, B0); PG8_BAR; PG8_SCHED;
            PG8_LDB(B1, 1, 1); PG8_STAGE(PG8_SB(1, 0), b3, voffB);
            PG8_BAR; PG8_WAIT_L(0); PG8_MMA(0, 1, At, B1); PG8_BAR;
            PG8_LDA(At, 1, 1); PG8_STAGE(PG8_SA(1, 0), a3, voffA);
            PG8_BAR; PG8_WAIT_L(0); PG8_MMA(1, 0, At, B0); PG8_BAR; PG8_SCHED;
            PG8_STAGE(PG8_SB(1, 1), b3 + hstep, voffB);
            PG8_WAIT_V(6); PG8_BAR; PG8_MMA(1, 1, At, B1); PG8_BAR;
            }
        }
        if constexpr (ALIGN_EPI) { if (wr == 0) PG8_BAR; }
        if constexpr (!Epi::AFTER_DRAIN) { E(acc, cur, wr, wc, fr, fq); S.done(cur); }
        if (!has_next) break;
#pragma unroll
        for (int a = 0; a < 2; ++a)
#pragma unroll
            for (int b = 0; b < 2; ++b)
#pragma unroll
                for (int m = 0; m < 4; ++m)
#pragma unroll
                    for (int n = 0; n < 2; ++n) acc[a][b][m][n] = (f32x4){0.f, 0.f, 0.f, 0.f};
        cur = nxt; cA = nA; cB = nB; ++ui;
        if constexpr (ALIGN_EPI) { if (wr == 1) PG8_BAR; }
    }
    PG8_WAIT_V(0);
    if constexpr (!ALIGN_EPI) { if (wr == 0) PG8_BAR; }
    PG8_BAR;
    if constexpr (Epi::AFTER_DRAIN) { E.fused(acc, cur, wr, wc, fr, fq, lds, wid, lane); S.done(cur); }
#undef PG8_SA
#undef PG8_SB
#undef PG8_STAGE
#undef PG8_LDA
#undef PG8_LDB
#undef PG8_MMA
#undef PG8_WAIT_V
#undef PG8_WAIT_L
#undef PG8_BAR
#undef PG8_SCHED
}
}
#define XB_TMO      128
#define XB_XCNT(j)  (256  + 64 * (j))
#define XB_XSUB(j)  (1280 + 64 * (j))
#define XB_XGEN(j)  (2304 + 64 * (j))
#define XB_TOP      3328
#define XB_TOPGEN   3392
#define XCD_BAR_WORDS 3456
#define XB_SPIN_CAP (1u << 18)

__device__ __forceinline__ unsigned xb_ld(unsigned* p)              { return __hip_atomic_load(p, __ATOMIC_RELAXED, __HIP_MEMORY_SCOPE_AGENT); }
__device__ __forceinline__ unsigned xb_add(unsigned* p, unsigned v) { return __hip_atomic_fetch_add(p, v, __ATOMIC_RELAXED, __HIP_MEMORY_SCOPE_AGENT); }
__device__ __forceinline__ unsigned xb_xcc_id() { return (unsigned)__builtin_amdgcn_s_getreg((3 << 11) | 20) & 0xFu; }
#define XB_SPIN(cond, bar) do { unsigned _sp = 0; while (cond) { __builtin_amdgcn_s_sleep(1); \
    if ((++_sp & 255u) == 0u) { if (xb_ld(&(bar)[XB_TMO])) break; if (_sp > XB_SPIN_CAP) { atomicAdd(&(bar)[XB_TMO], 1u); break; } } } } while (0)

struct XcdBarrier {
    unsigned* bar; unsigned x;
    volatile LAS unsigned* st;
};

__device__ __forceinline__ XcdBarrier xcd_barrier_post(unsigned* bar, volatile LAS unsigned* st) {
    XcdBarrier b; b.bar = bar; b.x = xb_xcc_id(); b.st = st;
    if (threadIdx.x == 0) (void)xb_add(&bar[XB_XCNT(b.x)], 1u);
    return b;
}
__device__ __forceinline__ void xcd_barrier_complete(unsigned* bar, unsigned x, unsigned& nloc, unsigned& nx) {
    const unsigned G = gridDim.x * gridDim.y * gridDim.z;
    unsigned sum, cnt, mine, sp = 0u;
    for (;;) {
        sum = 0u; cnt = 0u; mine = 0u;
#pragma unroll
        for (unsigned j = 0; j < 16; ++j) { const unsigned c = xb_ld(&bar[XB_XCNT(j)]); sum += c; cnt += (c > 0u) ? 1u : 0u; mine = (j == x) ? c : mine; }
        if (sum == G) break;
        __builtin_amdgcn_s_sleep(1);
        if ((++sp & 255u) == 0u) { if (xb_ld(&bar[XB_TMO])) break; if (sp > XB_SPIN_CAP) { atomicAdd(&bar[XB_TMO], 1u); break; } }
    }
    nloc = mine > 0u ? mine : 1u; nx = cnt > 0u ? cnt : 1u;
}

__device__ __forceinline__ void xcd_barrier(const XcdBarrier& b) {
    asm volatile("s_waitcnt vmcnt(0)" ::: "memory");
    __syncthreads();
    if (threadIdx.x == 0) {
        unsigned* bar = b.bar;
        __builtin_amdgcn_s_waitcnt(0);
        unsigned nloc = b.st[0], nx = b.st[1];
        if (nloc == 0u) { xcd_barrier_complete(bar, b.x, nloc, nx); b.st[0] = nloc; b.st[1] = nx; }
        const unsigned old = xb_add(&bar[XB_XSUB(b.x)], 1u);
        const unsigned gen = old / nloc;
        if (old + 1u == (gen + 1u) * nloc) {
            __builtin_amdgcn_fence(__ATOMIC_RELEASE, "agent");
            asm volatile("s_waitcnt vmcnt(0)" ::: "memory");
            const unsigned og = xb_add(&bar[XB_TOP], 1u);
            const unsigned tg = og / nx;
            if (og + 1u == (tg + 1u) * nx) xb_add(&bar[XB_TOPGEN], 1u);
            else XB_SPIN(xb_ld(&bar[XB_TOPGEN]) == tg, bar);
            __builtin_amdgcn_fence(__ATOMIC_ACQUIRE, "agent");
            xb_add(&bar[XB_XGEN(b.x)], 1u);
            asm volatile("s_waitcnt vmcnt(0)" ::: "memory");
        } else {
            XB_SPIN(xb_ld(&bar[XB_XGEN(b.x)]) == gen, bar);
            __builtin_amdgcn_fence(__ATOMIC_ACQUIRE, "agent");
            asm volatile("s_waitcnt vmcnt(0)" ::: "memory");
        }
    }
    __syncthreads();
}

constexpr int NWAVES = 8, NTHR = 512;
__device__ __forceinline__ float wave_sum(float v) {
#pragma unroll
    for (int o = 1; o < 64; o <<= 1) v += __shfl_xor(v, o);
    return v;
}
__device__ __forceinline__ float silu_f(float v) { return v / (1.f + __expf(-v)); }

__device__ __forceinline__ void tr_item(const float* __restrict__ W, int N, bf16* WT, int ldk, int row_off, const float* __restrict__ kscale, LAS float* scr, int item, int lane) {
    const int nblk = (N + 31) >> 5, kb = item / nblk, nb = item - kb * nblk, k0 = 64 * kb, n0 = 32 * nb;
    const int nn = n0 + (lane & 31);
#pragma unroll 8
    for (int i = 0; i < 32; ++i) { const int kk = 2 * i + (lane >> 5); float v = (nn < N) ? W[(size_t)(k0 + kk) * N + nn] : 0.f; if (kscale) v *= kscale[k0 + kk]; scr[kk * 33 + (lane & 31)] = v; }
    LDS_WAIT();
    const int c = lane & 7;
#pragma unroll
    for (int j = 0; j < 4; ++j) { const int n = (lane >> 3) + 8 * j; const LAS float* s = scr + (8 * c) * 33 + n;
        v4u o; o.x = pk2(s[0 * 33], s[1 * 33]); o.y = pk2(s[2 * 33], s[3 * 33]); o.z = pk2(s[4 * 33], s[5 * 33]); o.w = pk2(s[6 * 33], s[7 * 33]);
        if (n0 + n < N) *(v4u*)(WT + (size_t)(row_off + n0 + n) * ldk + k0 + 8 * c) = o; }
    LDS_WAIT();
}

struct Args {
    const float* x_prompt; const float* x_sample; const float* state_ssm; const float* state_conv; const float* cache_cmp; const float* cache_sel; const float* cache_win; const int* page_table;
    const float* ln_g; const float* ln_b; const float* m_in_w; const float* m_conv_w; const float* m_conv_b; const float* m_dt_bias; const float* m_a_log; const float* m_d; const float* m_norm_w; const float* m_out_w;
    const float* kv_w; const float* cmp_w1; const float* cmp_pe; const float* cmp_w2; const float* q_w; const float* o_w; const float* rel_bias; const float* mlp_w1; const float* mlp_w2;
    float* out; unsigned char* ws; int ph_lo, ph_hi, li, pad;
};

__device__ __forceinline__ void p0_prologue(const Args& a, LAS unsigned char* lds, int G) {
    using namespace cfg;
    const int tid = threadIdx.x, lane = tid & 63, wave = tid >> 6;
    LAS float* scr = (LAS float*)(lds + wave * 16384);
    unsigned char* ws = a.ws;
    const int gw = blockIdx.x * NWAVES + wave, NGW = G * NWAVES;
    constexpr int I_IN = 16 * 161, I_OUT = 32 * 32, I_W1 = 16 * 128, I_W2 = 64 * 32, I_KV = 16 * 48, I_Q = 16 * 34, I_O = 16 * 32, I_C = 16 * 4;
    constexpr int NIT = I_IN + I_OUT + 2 * I_W1 + 2 * I_W2 + I_KV + I_Q + I_O + 4 * I_C;
    for (int it = gw; it < NIT; it += NGW) {
        int r = it;
        if (r < I_IN) { tr_item(a.m_in_w, INDIM, (bf16*)(ws + WS_WIN), DM, 0, nullptr, scr, r, lane); continue; } r -= I_IN;
        if (r < I_OUT) { tr_item(a.m_out_w, DM, (bf16*)(ws + WS_WOUT), DIN, 0, a.m_norm_w, scr, r, lane); continue; } r -= I_OUT;
        if (r < 2 * I_W1) { const int l = r / I_W1; tr_item(a.mlp_w1 + (size_t)l * DM * DFF, DFF, (bf16*)(ws + WS_W1) + (size_t)l * DFF * DM, DM, 0, nullptr, scr, r - l * I_W1, lane); continue; } r -= 2 * I_W1;
        if (r < 2 * I_W2) { const int l = r / I_W2; tr_item(a.mlp_w2 + (size_t)l * DM * DFF, DM, (bf16*)(ws + WS_W2) + (size_t)l * DFF * DM, DFF, 0, nullptr, scr, r - l * I_W2, lane); continue; } r -= 2 * I_W2;
        if (r < I_KV) { tr_item(a.kv_w, KVW, (bf16*)(ws + WS_WKVQ), DM, 0, nullptr, scr, r, lane); continue; } r -= I_KV;
        if (r < I_Q) { tr_item(a.q_w, QGW, (bf16*)(ws + WS_WKVQ), DM, KVW, nullptr, scr, r, lane); continue; } r -= I_Q;
        if (r < I_O) { tr_item(a.o_w, DM, (bf16*)(ws + WS_WO), DM, 0, nullptr, scr, r, lane); continue; } r -= I_O;
        { const int q = r / I_C; tr_item(a.cmp_w1 + (size_t)q * 1024 * 128, 128, (bf16*)(ws + WS_WC1), 1024, q * 128, nullptr, scr, r - q * I_C, lane); }
    }
    const size_t gt = (size_t)blockIdx.x * NTHR + tid, NT = (size_t)G * NTHR;
    { v4u z = {0u, 0u, 0u, 0u};
      v4u* p1 = (v4u*)((bf16*)(ws + WS_WIN) + (size_t)INDIM * DM); for (size_t i = gt; i < (size_t)(INPAD - INDIM) * DM / 8; i += NT) p1[i] = z;
      v4u* p2 = (v4u*)((bf16*)(ws + WS_WKVQ) + (size_t)(KVW + QGW) * DM); for (size_t i = gt; i < (size_t)(KVQN - KVW - QGW) * DM / 8; i += NT) p2[i] = z; }
    { v4u* xb = (v4u*)(ws + WS_XB);
      for (size_t i = gt; i < (size_t)M * DM / 8; i += NT) { const size_t e = i * 8; const float* src = e < (size_t)MP * DM ? a.x_prompt + e : a.x_sample + (e - (size_t)MP * DM);
          const f32x4 v0 = *(const f32x4*)src, v1 = *(const f32x4*)(src + 4); v4u o; o.x = pk2(v0[0], v0[1]); o.y = pk2(v0[2], v0[3]); o.z = pk2(v1[0], v1[1]); o.w = pk2(v1[2], v1[3]); xb[i] = o; } }
    { bf16* ac = (bf16*)(ws + WS_ACMP);
      for (size_t i = gt; i < (size_t)DB * PAST * 64; i += NT) { const int ch = (int)(i & 63); const size_t tok = i >> 6; const int b = (int)(tok >> 11), t = (int)(tok & 2047);
          const int page = a.page_table[b * NPAGE + (t >> 7)]; const float* src = a.cache_cmp + ((size_t)page * PAGE + (t & 127)) * 512 + ch * 8;
          const f32x4 v0 = *(const f32x4*)src, v1 = *(const f32x4*)(src + 4); v4u o; o.x = pk2(v0[0], v0[1]); o.y = pk2(v0[2], v0[3]); o.z = pk2(v1[0], v1[1]); o.w = pk2(v1[2], v1[3]);
          const int kv = ch >> 5, g = (ch >> 3) & 3, d0 = (ch & 7) * 8;
          *(v4u*)(ac + ((size_t)kv * NCMPROWS + (size_t)(b * 4 + g) * 128 + (t >> 4)) * 1024 + (t & 15) * 64 + d0) = o; } }
    { f32x4* dst = (f32x4*)(a.out + O_SWIN); const f32x4* src = (const f32x4*)a.cache_win;
      for (size_t i = gt; i < (size_t)DB * 504 * 128; i += NT) { const size_t b = i / (504 * 128), r = i - b * (504 * 128); dst[b * 512 * 128 + r] = src[b * 512 * 128 + 8 * 128 + r]; } }
    { float* pec = (float*)(ws + WS_PEC);
      for (size_t i = gt; i < 32 * 256; i += NT) { const int sl = (int)(i >> 8), kve = (int)(i & 255), kv = kve >> 7, e = kve & 127; float s = 0.f;
          for (int k = 64 * sl; k < 64 * sl + 64; ++k) s += a.cmp_pe[(size_t)kv * 2048 + k] * a.cmp_w1[((size_t)kv * 2048 + k) * 128 + e];
          pec[i] = s; } }
}

__device__ __forceinline__ void scan_phase(const Args& a, LAS unsigned char* lds, int G) {
    using namespace cfg;
    const int tid = threadIdx.x, lane = tid & 63, wave = tid >> 6, p = tid >> 3, nq = tid & 7;
    LAS float* cv = (LAS float*)lds;
    LAS float* dts = cv + 16 * 320;
    LAS float* dAs = dts + 16;
    LAS float* ygs = dAs + 16;
    const bf16* ZX = (const bf16*)(a.ws + WS_ZX); const float* DT = (const float*)(a.ws + WS_DT);
    bf16* YG = (bf16*)(a.ws + WS_YG); float* SSQ = (float*)(a.ws + WS_SSQ);
    for (int u = blockIdx.x; u < NPB * NH + DB * NH; u += G) {
        const bool prompt = u < NPB * NH; const int su = prompt ? u : u - NPB * NH; const int b = su >> 5, hd = su & 31, g = hd >> 3;
        const int L = prompt ? SEQ : DS; const int row0 = prompt ? b * SEQ : MP + b * DS;
        float h[16];
        float* sdst = a.out + (prompt ? O_PSSM : O_SSSM) + ((size_t)(b * NH + hd) * HD + p) * DST + nq * 16;
        if (prompt) {
#pragma unroll
            for (int i = 0; i < 16; ++i) h[i] = 0.f;
        } else { const float* s0 = a.state_ssm + ((size_t)(b * NH + hd) * HD + p) * DST + nq * 16;
#pragma unroll
            for (int i4 = 0; i4 < 4; ++i4) { const f32x4 v = *(const f32x4*)(s0 + 4 * i4); h[4 * i4] = v[0]; h[4 * i4 + 1] = v[1]; h[4 * i4 + 2] = v[2]; h[4 * i4 + 3] = v[3]; } }
        const float dtb = a.m_dt_bias[hd], Aneg = -__expf(a.m_a_log[hd]), Dh = a.m_d[hd];
        for (int t0 = 0; t0 < L; t0 += 16) {
            const int nt = (L - t0) < 16 ? (L - t0) : 16;
            __syncthreads();
            for (int idx = tid; idx < nt * 320; idx += NTHR) { const int tt = idx / 320, cl = idx - tt * 320;
                const int cx = cl < 64 ? hd * 64 + cl : (cl < 192 ? 2048 + g * 128 + (cl - 64) : 2560 + g * 128 + (cl - 192));
                float acc = a.m_conv_b[cx];
#pragma unroll
                for (int k = 0; k < 4; ++k) { const int t = t0 + tt - 3 + k;
                    const float xv = t >= 0 ? bf2f(ZX[(size_t)(row0 + t) * ZXW + DIN + cx]) : (prompt ? 0.f : a.state_conv[(size_t)(b * 3 + t + 3) * CONVD + cx]);
                    acc += a.m_conv_w[k * CONVD + cx] * xv; }
                cv[tt * 320 + cl] = silu_f(acc); }
            if (tid < nt) { const float dtr = DT[(size_t)(row0 + t0 + tid) * 32 + hd] + dtb; const float dtv = dtr > 20.f ? dtr : log1pf(__expf(dtr)); dts[tid] = dtv; dAs[tid] = __expf(dtv * Aneg); }
            __syncthreads();
            for (int tt = 0; tt < nt; ++tt) {
                const float x = cv[tt * 320 + p], dtv = dts[tt], dA = dAs[tt], xdt = x * dtv;
                const LAS f32x4* Bp = (const LAS f32x4*)(cv + tt * 320 + 64 + nq * 16); const LAS f32x4* Cp = (const LAS f32x4*)(cv + tt * 320 + 192 + nq * 16);
                float acc = 0.f;
#pragma unroll
                for (int i4 = 0; i4 < 4; ++i4) { const f32x4 Bv = Bp[i4], Cv = Cp[i4];
#pragma unroll
                    for (int j = 0; j < 4; ++j) { h[4 * i4 + j] = dA * h[4 * i4 + j] + xdt * Bv[j]; acc += h[4 * i4 + j] * Cv[j]; } }
                acc += __shfl_xor(acc, 1); acc += __shfl_xor(acc, 2); acc += __shfl_xor(acc, 4);
                if (nq == 0) { const float y = acc + Dh * x; const float z = bf2f(ZX[(size_t)(row0 + t0 + tt) * ZXW + hd * 64 + p]); ygs[tt * 64 + p] = y * silu_f(z); }
            }
            __syncthreads();
            for (int idx = tid; idx < nt * 32; idx += NTHR) { const int tt = idx >> 5, pp = (idx & 31) * 2;
                *(unsigned*)(YG + (size_t)(row0 + t0 + tt) * DIN + hd * 64 + pp) = pk2(ygs[tt * 64 + pp], ygs[tt * 64 + pp + 1]); }
            for (int tt = wave; tt < nt; tt += NWAVES) { const float v = ygs[tt * 64 + lane]; const float s = wave_sum(v * v); if (lane == 0) SSQ[(size_t)(row0 + t0 + tt) * 32 + hd] = s; }
        }
#pragma unroll
        for (int i4 = 0; i4 < 4; ++i4) { f32x4 v = {h[4 * i4], h[4 * i4 + 1], h[4 * i4 + 2], h[4 * i4 + 3]}; *(f32x4*)(sdst + 4 * i4) = v; }
    }
}

__device__ __forceinline__ void norm_phase(const Args& a, int G) {
    using namespace cfg;
    const bf16* YG = (const bf16*)(a.ws + WS_YG); const float* SSQ = (const float*)(a.ws + WS_SSQ); bf16* YN = (bf16*)(a.ws + WS_YN);
    const size_t gt = (size_t)blockIdx.x * NTHR + threadIdx.x, NT = (size_t)G * NTHR;
    for (size_t i = gt; i < (size_t)M * DIN / 8; i += NT) { const size_t row = i >> 8; const int c8 = (int)(i & 255), g = c8 >> 6;
        const f32x4 s0 = *(const f32x4*)(SSQ + row * 32 + g * 8), s1 = *(const f32x4*)(SSQ + row * 32 + g * 8 + 4);
        const float ms = ((s0[0] + s0[1]) + (s0[2] + s0[3]) + (s1[0] + s1[1]) + (s1[2] + s1[3])) * (1.f / 512.f);
        const float r = 1.f / sqrtf(ms + RMS_EPS);
        const v4u v = *(const v4u*)(YG + i * 8); v4u o;
        o.x = pk2(bflo(v.x) * r, bfhi(v.x) * r); o.y = pk2(bflo(v.y) * r, bfhi(v.y) * r); o.z = pk2(bflo(v.z) * r, bfhi(v.z) * r); o.w = pk2(bflo(v.w) * r, bfhi(v.w) * r);
        *(v4u*)(YN + i * 8) = o; }
}

__device__ __forceinline__ void ln_phase(const float* PRE, const float* gam, const float* bet, float* outF, bf16* outB, int G) {
    using namespace cfg;
    const int lane = threadIdx.x & 63, wave = threadIdx.x >> 6;
    f32x4 gv[4], bv[4];
#pragma unroll
    for (int j = 0; j < 4; ++j) { gv[j] = *(const f32x4*)(gam + 4 * lane + 256 * j); bv[j] = *(const f32x4*)(bet + 4 * lane + 256 * j); }
    for (int row = blockIdx.x * NWAVES + wave; row < M; row += G * NWAVES) {
        const float* xr = PRE + (size_t)row * DM + 4 * lane; f32x4 v[4]; float s = 0.f;
#pragma unroll
        for (int j = 0; j < 4; ++j) { v[j] = *(const f32x4*)(xr + 256 * j); s += (v[j][0] + v[j][1]) + (v[j][2] + v[j][3]); }
        const float mean = wave_sum(s) * (1.f / DM); float s2 = 0.f;
#pragma unroll
        for (int j = 0; j < 4; ++j) { v[j] = v[j] - mean; s2 += (v[j][0] * v[j][0] + v[j][1] * v[j][1]) + (v[j][2] * v[j][2] + v[j][3] * v[j][3]); }
        const float rstd = 1.f / sqrtf(wave_sum(s2) * (1.f / DM) + LN_EPS);
#pragma unroll
        for (int j = 0; j < 4; ++j) { const f32x4 o = v[j] * rstd * gv[j] + bv[j]; *(f32x4*)(outF + (size_t)row * DM + 4 * lane + 256 * j) = o;
            if (outB) { v2u w; w.x = pk2(o[0], o[1]); w.y = pk2(o[2], o[3]); *(v2u*)(outB + (size_t)row * DM + 4 * lane + 256 * j) = w; } }
    }
}

__device__ __forceinline__ void cmp2_phase(const Args& a, LAS unsigned char* lds, int G) {
    using namespace cfg;
    const int tid = threadIdx.x;
    LAS float* w2s = (LAS float*)lds;
    LAS float* pcs = w2s + 2 * 128 * 64;
    LAS float* hs = pcs + 256;
    const float* P = (const float*)(a.ws + WS_PCMP); const float* pec = (const float*)(a.ws + WS_PEC);
    for (int i = tid; i < 2 * 128 * 64; i += NTHR) w2s[i] = a.cmp_w2[i];
    if (tid < 256) { float s = 0.f; for (int sl = 0; sl < 32; ++sl) s += pec[sl * 256 + tid]; pcs[tid] = s; }
    __syncthreads();
    for (int u = blockIdx.x; u < 2 * NCMPROWS / 64; u += G) {
        const size_t r0 = (size_t)u * 64; const int kv = r0 >= (size_t)NCMPROWS ? 1 : 0;
        __syncthreads();
        for (int i = tid; i < 64 * 128; i += NTHR) { const int rl = i >> 7, e = i & 127; const size_t r = r0 + rl; const int c = (int)(r & 127);
            float hv = 0.f; if (c < 127) hv = silu_f(P[r * 256 + e] + P[(r + 1) * 256 + 128 + e] + pcs[kv * 128 + e]);
            hs[rl * 129 + e] = hv; }
        __syncthreads();
        const int rl = tid >> 3, dq = tid & 7; float o[8];
#pragma unroll
        for (int j = 0; j < 8; ++j) o[j] = 0.f;
        for (int e = 0; e < 128; ++e) { const float s = hs[rl * 129 + e]; const LAS f32x4* wp = (const LAS f32x4*)(w2s + (kv * 128 + e) * 64 + dq * 8); const f32x4 w0 = wp[0], w1 = wp[1];
            o[0] += s * w0[0]; o[1] += s * w0[1]; o[2] += s * w0[2]; o[3] += s * w0[3]; o[4] += s * w1[0]; o[5] += s * w1[1]; o[6] += s * w1[2]; o[7] += s * w1[3]; }
        bf16* dst = (bf16*)(a.ws + (kv ? WS_VC : WS_KC)) + ((r0 - (size_t)kv * NCMPROWS) + rl) * 64 + dq * 8;
        v4u w; w.x = pk2(o[0], o[1]); w.y = pk2(o[2], o[3]); w.z = pk2(o[4], o[5]); w.w = pk2(o[6], o[7]); *(v4u*)dst = w;
    }
}

__device__ __forceinline__ void ld16(const void* p, bool isf32, float (&o)[16]) {
    if (isf32) { const f32x4* q = (const f32x4*)p;
#pragma unroll
        for (int i = 0; i < 4; ++i) { const f32x4 v = q[i]; o[4 * i] = v[0]; o[4 * i + 1] = v[1]; o[4 * i + 2] = v[2]; o[4 * i + 3] = v[3]; } }
    else { const v4u* q = (const v4u*)p;
#pragma unroll
        for (int i = 0; i < 2; ++i) { const v4u v = q[i]; o[8 * i] = bflo(v.x); o[8 * i + 1] = bfhi(v.x); o[8 * i + 2] = bflo(v.y); o[8 * i + 3] = bfhi(v.y); o[8 * i + 4] = bflo(v.z); o[8 * i + 5] = bfhi(v.z); o[8 * i + 6] = bflo(v.w); o[8 * i + 7] = bfhi(v.w); } }
}
#define WSYNC() asm volatile("s_waitcnt lgkmcnt(0)" ::: "memory")

template <bool PROMPT>
__device__ __forceinline__ void attn_item(const Args& a, int b, int g, int tg, int lane, const LAS float* bt, LAS float* sc, LAS float* scoreL, LAS int* flagL) {
    using namespace cfg;
    const int tl = lane >> 4, hh = (lane >> 2) & 3, dq = lane & 3, rowl = lane >> 2;
    const int t = tg * 4 + tl, pos = PROMPT ? t : PAST + t, row = PROMPT ? b * SEQ + t : MP + b * DS + t, head = g * 4 + hh;
    const int posmax = (PROMPT ? 0 : PAST) + tg * 4 + 3, posmin = posmax - 3;
    const bf16* KVB = (const bf16*)(a.ws + WS_KVB);
    float q[16]; ld16((const bf16*)(a.ws + WS_QB) + (size_t)row * DM + head * 64 + dq * 16, false, q);
    const float* gp = (const float*)(a.ws + WS_GATES) + (size_t)row * 48 + head * 3; const float g0 = gp[0], g1 = gp[1], g2 = gp[2];
    const LAS float* btr = bt + head * 128;
    float out[16];
    {
        const size_t cb = ((size_t)((PROMPT ? DB + b : b) * 4 + g) * 128) * 64;
        const bf16* KCb = (const bf16*)(a.ws + WS_KC) + cb; const bf16* VCb = (const bf16*)(a.ws + WS_VC) + cb;
        int ncw = posmax >= 31 ? ((posmax - 31) >> 4) + 1 : 0; if (ncw > 127) ncw = 127;
        float m = -1e30f;
        for (int c = 0; c < ncw; ++c) { float k[16]; ld16(KCb + c * 64 + dq * 16, false, k); float s = 0.f;
#pragma unroll
            for (int i = 0; i < 16; ++i) s += q[i] * k[i];
            s += __shfl_xor(s, 1); s += __shfl_xor(s, 2);
            const int dist = pos - (16 * c + 31); s = dist >= 0 ? s + btr[dist < 127 ? dist : 127] : -1e30f;
            if (dq == 0) sc[rowl * 128 + c] = s; m = fmaxf(m, s); }
        WSYNC();
        float l = 0.f;
        for (int c = dq; c < ncw; c += 4) { const float s = sc[rowl * 128 + c]; const float e = s > -1e29f ? exp2f(s - m) : 0.f; sc[rowl * 128 + c] = e; l += e; }
        l += __shfl_xor(l, 1); l += __shfl_xor(l, 2);
        const float inv = l > 0.f ? 1.f / l : 0.f;
        WSYNC();
        float oc[16];
#pragma unroll
        for (int i = 0; i < 16; ++i) oc[i] = 0.f;
        for (int c = 0; c < ncw; ++c) { const float pv = sc[rowl * 128 + c] * inv; float v[16]; ld16(VCb + c * 64 + dq * 16, false, v);
#pragma unroll
            for (int i = 0; i < 16; ++i) oc[i] += pv * v[i]; }
        WSYNC();
        if (dq == 0) scoreL[144 + rowl] = inv;
        WSYNC();
        const int nsel = PROMPT ? 32 : 33, j = lane & 15, blk = pos >> 6;
        for (int s = j; s < nsel; s += 16) { float imp = 0.f;
#pragma unroll
            for (int h2 = 0; h2 < 4; ++h2) { const float iv = scoreL[144 + tl * 4 + h2]; float sm = 0.f;
#pragma unroll
                for (int c = 4 * s - 1; c <= 4 * s + 3; ++c) if (c >= 0 && c < ncw) sm += sc[(tl * 4 + h2) * 128 + c];
                imp += sm * iv; }
            const bool valid = s * 64 <= pos, forced = (s == 0) || (s == blk) || (s == blk - 1);
            scoreL[tl * 36 + s] = valid ? imp + (forced ? 1000.f : 0.f) : -1.f; }
        WSYNC();
        for (int s = j; s < nsel; s += 16) { const float my = scoreL[tl * 36 + s]; int rank = 0;
            for (int s2 = 0; s2 < nsel; ++s2) { const float o = scoreL[tl * 36 + s2]; rank += ((o > my) || (o == my && s2 < s)) ? 1 : 0; }
            flagL[tl * 36 + s] = rank < 16 ? 1 : 0; }
        WSYNC();
#pragma unroll
        for (int i = 0; i < 16; ++i) out[i] = g0 * oc[i];
    }
    {
        float ms = -1e30f, ls = 0.f, os[16];
#pragma unroll
        for (int i = 0; i < 16; ++i) os[i] = 0.f;
        const int nblk = (posmax >> 6) + 1;
        for (int s = 0; s < nblk; ++s) {
            const int fl = flagL[tl * 36 + s];
            if (!__any(fl)) continue;
            int kend = posmax - s * 64 + 1; if (kend > 64) kend = 64;
            for (int kk = 0; kk < kend; ++kk) { const int kpos = s * 64 + kk;
                const void* kp; const void* vp; bool f32src = false;
                if (PROMPT) { const bf16* r = KVB + (size_t)(b * SEQ + kpos) * KVW + 512 + g * 64 + dq * 16; kp = r; vp = r + 256; }
                else if (kpos < PAST) { const int page = a.page_table[b * NPAGE + (kpos >> 7)]; const float* r = a.cache_sel + ((size_t)page * PAGE + (kpos & 127)) * 512 + g * 64 + dq * 16; kp = r; vp = r + 256; f32src = true; }
                else { const bf16* r = KVB + (size_t)(MP + b * DS + kpos - PAST) * KVW + 512 + g * 64 + dq * 16; kp = r; vp = r + 256; }
                float k[16]; ld16(kp, f32src, k); float sd = 0.f;
#pragma unroll
                for (int i = 0; i < 16; ++i) sd += q[i] * k[i];
                sd += __shfl_xor(sd, 1); sd += __shfl_xor(sd, 2);
                float v[16]; ld16(vp, f32src, v);
                if (fl && kpos <= pos) { const int dist = pos - kpos; const float sv = sd + btr[dist < 127 ? dist : 127];
                    if (sv > ms) { const float corr = exp2f(ms - sv); ls *= corr;
#pragma unroll
                        for (int i = 0; i < 16; ++i) os[i] *= corr;
                        ms = sv; }
                    const float pv = exp2f(sv - ms); ls += pv;
#pragma unroll
                    for (int i = 0; i < 16; ++i) os[i] += pv * v[i]; }
            }
        }
        const float sc1 = g1 / ls;
#pragma unroll
        for (int i = 0; i < 16; ++i) out[i] += sc1 * os[i];
    }
    {
        float ms = -1e30f, ls = 0.f, os[16];
#pragma unroll
        for (int i = 0; i < 16; ++i) os[i] = 0.f;
        int kstart = posmin - 511; if (kstart < 0) kstart = 0;
        for (int kpos = kstart; kpos <= posmax; ++kpos) {
            const void* kp; const void* vp; bool f32src = false;
            if (PROMPT) { const bf16* r = KVB + (size_t)(b * SEQ + kpos) * KVW + 1024 + g * 64 + dq * 16; kp = r; vp = r + 256; }
            else if (kpos < PAST) { const float* r = a.cache_win + ((size_t)b * 512 + (kpos - (PAST - 512))) * 512 + g * 64 + dq * 16; kp = r; vp = r + 256; f32src = true; }
            else { const bf16* r = KVB + (size_t)(MP + b * DS + kpos - PAST) * KVW + 1024 + g * 64 + dq * 16; kp = r; vp = r + 256; }
            float k[16]; ld16(kp, f32src, k); float sd = 0.f;
#pragma unroll
            for (int i = 0; i < 16; ++i) sd += q[i] * k[i];
            sd += __shfl_xor(sd, 1); sd += __shfl_xor(sd, 2);
            float v[16]; ld16(vp, f32src, v);
            const int dist = pos - kpos;
            if (dist >= 0 && dist < 512) { const float sv = sd + btr[dist < 127 ? dist : 127];
                if (sv > ms) { const float corr = exp2f(ms - sv); ls *= corr;
#pragma unroll
                    for (int i = 0; i < 16; ++i) os[i] *= corr;
                    ms = sv; }
                const float pv = exp2f(sv - ms); ls += pv;
#pragma unroll
                for (int i = 0; i < 16; ++i) os[i] += pv * v[i]; }
        }
        const float sc2 = g2 / ls;
#pragma unroll
        for (int i = 0; i < 16; ++i) out[i] += sc2 * os[i];
    }
    bf16* op = (bf16*)(a.ws + WS_OB) + (size_t)row * DM + head * 64 + dq * 16;
    v4u w0, w1; w0.x = pk2(out[0], out[1]); w0.y = pk2(out[2], out[3]); w0.z = pk2(out[4], out[5]); w0.w = pk2(out[6], out[7]);
    w1.x = pk2(out[8], out[9]); w1.y = pk2(out[10], out[11]); w1.z = pk2(out[12], out[13]); w1.w = pk2(out[14], out[15]);
    *(v4u*)op = w0; *(v4u*)(op + 8) = w1;
}

__device__ __forceinline__ void attn_phase(const Args& a, LAS unsigned char* lds, int G) {
    using namespace cfg;
    const int tid = threadIdx.x, lane = tid & 63, wave = tid >> 6;
    LAS float* bt = (LAS float*)lds;
    LAS float* sc = (LAS float*)(lds + 8192 + wave * 9728);
    LAS float* scoreL = sc + 16 * 128;
    LAS int* flagL = (LAS int*)(scoreL + 160);
    for (int i = tid; i < 16 * 128; i += NTHR) { const int h = i >> 7, d = i & 127;
        int bucket = d; if (d >= 16) { bucket = 16 + (int)(__logf((float)d / 16.f) / 2.0794415416798357f * 16.f); if (bucket > 31) bucket = 31; }
        bt[i] = a.rel_bias[bucket * 16 + h] * LOG2E; }
    __syncthreads();
    for (int v = blockIdx.x; v < 2048 + 128; v += G) {
        if (v < 2048) { const int j = v >> 8, k = v & 255, bg = k >> 3, r = k & 7;
            const int uidx = (j >> 1) * 16 + ((j & 1) ? 15 - r : r);
            attn_item<true>(a, bg >> 2, bg & 3, uidx * 8 + wave, lane, bt, sc, scoreL, flagL); }
        else { const int bs = v - 2048; attn_item<false>(a, bs, wave >> 1, wave & 1, lane, bt, sc, scoreL, flagL); }
    }
}

typedef short bf16x8 __attribute__((ext_vector_type(8)));
typedef short s16x4 __attribute__((ext_vector_type(4)));
typedef short v4i16_t __attribute__((ext_vector_type(4)));
typedef float f32x16 __attribute__((ext_vector_type(16)));
#define NEG_INF (-__builtin_inff())
__device__ __forceinline__ s16x4 vtr(const LAS unsigned char* p) { return __builtin_bit_cast(s16x4, __builtin_amdgcn_ds_read_tr16_b64_v4i16((LAS v4i16_t*)p)); }
__device__ __forceinline__ unsigned cvtpk(float lo, float hi) { unsigned r; asm volatile("v_cvt_pk_bf16_f32 %0, %1, %2" : "=v"(r) : "v"(lo), "v"(hi)); return r; }
constexpr int AT_BT = 0, AT_KS = 8192, AT_VS = 40960, AT_SC = 73728, AT_END = 81920;

__device__ __forceinline__ void tile_ld(const bf16* Kg, const bf16* Vg, int pitch, int wid, int lane, v4u& kr, v4u& vr) {
    kr = *(const v4u*)(Kg + (size_t)lane * pitch + wid * 8);
    vr = *(const v4u*)(Vg + (size_t)(16 * (wid & 3) + (lane >> 2)) * pitch + (wid >> 2) * 32 + (lane & 3) * 8);
}
__device__ __forceinline__ void tile_st(LAS unsigned char* lds, int slot, int wid, int lane, const v4u& kr, const v4u& vr) {
    *(LAS v4u*)(lds + AT_KS + slot * 8192 + wid * 1024 + lane * 16) = kr;
    *(LAS v4u*)(lds + AT_VS + slot * 8192 + wid * 1024 + lane * 16) = vr;
}
__device__ __forceinline__ void qk_tile(const LAS unsigned char* lds, int slot, const bf16x8 (&qf)[4], int r32, int hi, f32x16& p0, f32x16& p1) {
    const LAS unsigned char* kp = lds + AT_KS + slot * 8192 + hi * 1024 + r32 * 16;
    p0 = f32x16{}; p1 = f32x16{};
#pragma unroll
    for (int j = 0; j < 4; ++j) { const bf16x8 k0 = *(const LAS bf16x8*)(kp + j * 2048), k1 = *(const LAS bf16x8*)(kp + j * 2048 + 512);
        p0 = __builtin_amdgcn_mfma_f32_32x32x16_bf16(k0, qf[j], p0, 0, 0, 0); p1 = __builtin_amdgcn_mfma_f32_32x32x16_bf16(k1, qf[j], p1, 0, 0, 0); }
}
__device__ __forceinline__ void pv_img(const LAS unsigned char* vimg, int lane, int hi, const f32x16& p0, const f32x16& p1, f32x16 (&o)[2]) {
    const LAS unsigned char* vp = vimg + ((lane >> 4) & 1) * 32 + (lane & 3) * 8 + (4 * hi + ((lane & 15) >> 2)) * 64;
    bf16x8 pf[4];
#pragma unroll
    for (int k = 0; k < 4; ++k) { const f32x16& p = (k < 2) ? p0 : p1; const int b0 = (k & 1) * 8; v4u w;
        w.x = cvtpk(p[b0], p[b0 + 1]); w.y = cvtpk(p[b0 + 2], p[b0 + 3]); w.z = cvtpk(p[b0 + 4], p[b0 + 5]); w.w = cvtpk(p[b0 + 6], p[b0 + 7]); pf[k] = __builtin_bit_cast(bf16x8, w); }
#pragma unroll
    for (int db = 0; db < 2; ++db)
#pragma unroll
        for (int ks = 0; ks < 4; ++ks) { const s16x4 lo = vtr(vp + db * 4096 + ks * 1024), hv = vtr(vp + db * 4096 + ks * 1024 + 512);
            const bf16x8 vf = {lo[0], lo[1], lo[2], lo[3], hv[0], hv[1], hv[2], hv[3]};
            o[db] = __builtin_amdgcn_mfma_f32_32x32x16_bf16(vf, pf[ks], o[db], 0, 0, 0); }
}

__device__ __forceinline__ void pv_tile(const LAS unsigned char* lds, int slot, int lane, int hi, const f32x16& p0, const f32x16& p1, f32x16 (&o)[2]) { pv_img(lds + AT_VS + slot * 8192, lane, hi, p0, p1, o); }
template <int MODE>
__device__ __forceinline__ void bias_mask(f32x16& p0, f32x16& p1, int dbase, bool near, bool flag, const LAS float* btr, float b31) {
    if (near) {
#pragma unroll
        for (int r = 0; r < 16; ++r) { const int d0 = dbase - ((r & 3) + 8 * (r >> 2)), d1 = d0 - 32;
            const bool ok0 = flag && d0 >= 0 && (MODE == 1 || d0 < 512), ok1 = flag && d1 >= 0 && (MODE == 1 || d1 < 512);
            const float b0 = btr[d0 < 0 ? 0 : (d0 > 127 ? 127 : d0)], b1 = btr[d1 < 0 ? 0 : (d1 > 127 ? 127 : d1)];
            p0[r] = ok0 ? p0[r] + b0 : NEG_INF; p1[r] = ok1 ? p1[r] + b1 : NEG_INF; }
    } else {
#pragma unroll
        for (int r = 0; r < 16; ++r) { const int d0 = dbase - ((r & 3) + 8 * (r >> 2)), d1 = d0 - 32;
            const bool ok0 = flag && (MODE == 1 || d0 < 512), ok1 = flag && (MODE == 1 || d1 < 512);
            p0[r] = ok0 ? p0[r] + b31 : NEG_INF; p1[r] = ok1 ? p1[r] + b31 : NEG_INF; }
    }
}
__device__ __forceinline__ void online_update(f32x16& p0, f32x16& p1, float& m, float& l, f32x16 (&o)[2]) {
    float tmax = NEG_INF;
#pragma unroll
    for (int r = 0; r < 16; ++r) tmax = fmaxf(tmax, fmaxf(p0[r], p1[r]));
    tmax = fmaxf(tmax, __shfl_xor(tmax, 32));
    const float mn = fmaxf(m, tmax), ms = (mn == NEG_INF) ? 0.f : mn;
    const float corr = __builtin_amdgcn_exp2f(m - ms);
    float sum = 0.f;
#pragma unroll
    for (int r = 0; r < 16; ++r) { p0[r] = __builtin_amdgcn_exp2f(p0[r] - ms); p1[r] = __builtin_amdgcn_exp2f(p1[r] - ms); sum += p0[r] + p1[r]; }
    l = l * corr + sum; m = mn;
#pragma unroll
    for (int r = 0; r < 16; ++r) { o[0][r] *= corr; o[1][r] *= corr; }
}
template <int MODE>
__device__ __forceinline__ void flash_branch(LAS unsigned char* lds, const bf16* Kg, const bf16* Vg, int kt0, int kt1, const bf16x8 (&qf)[4], int pos, int posmin, int posmax,
                                             const LAS float* btr, float b31, unsigned selmask, float gate, f32x16 (&oacc)[2], int wid, int lane) {
    const int r32 = lane & 31, hi = lane >> 5;
    float m = NEG_INF, l = 0.f; f32x16 o[2]; o[0] = f32x16{}; o[1] = f32x16{};
    v4u kr, vr;
    __syncthreads();
    tile_ld(Kg + (size_t)kt0 * 64 * cfg::KVW, Vg + (size_t)kt0 * 64 * cfg::KVW, cfg::KVW, wid, lane, kr, vr);
    tile_st(lds, 0, wid, lane, kr, vr);
    __syncthreads();
    for (int kt = kt0; kt <= kt1; ++kt) {
        const int slot = (kt - kt0) & 1;
        if (kt < kt1) tile_ld(Kg + (size_t)(kt + 1) * 64 * cfg::KVW, Vg + (size_t)(kt + 1) * 64 * cfg::KVW, cfg::KVW, wid, lane, kr, vr);
        const bool flag = (MODE == 1) ? ((selmask >> kt) & 1u) != 0u : true;
        const bool wave_on = (MODE == 1) ? (__any(flag) != 0) : (posmin - (kt * 64 + 63) < 512);
        if (wave_on) {
            f32x16 p0, p1; qk_tile(lds, slot, qf, r32, hi, p0, p1);
            const bool near = (posmin - (kt * 64 + 63)) < 113;
            bias_mask<MODE>(p0, p1, pos - kt * 64 - 4 * hi, near, flag, btr, b31);
            online_update(p0, p1, m, l, o);
            pv_tile(lds, slot, lane, hi, p0, p1, o);
        }
        if (kt < kt1) tile_st(lds, slot ^ 1, wid, lane, kr, vr);
        __syncthreads();
    }
    l += __shfl_xor(l, 32);
    const float sc = l > 0.f ? gate / l : 0.f;
#pragma unroll
    for (int r = 0; r < 16; ++r) { oacc[0][r] += sc * o[0][r]; oacc[1][r] += sc * o[1][r]; }
}

template <bool SAMPLE>
__device__ __forceinline__ void cmp_softmax_topk(f32x16 (&p)[4], int pos, int tokl, int hh, int hi, int lane, const LAS float* btr, LAS float* scoreL, unsigned& selmask) {
        float mx = NEG_INF;
#pragma unroll
        for (int u = 0; u < 4; ++u)
#pragma unroll
            for (int r = 0; r < 16; ++r) { const int c = 32 * u + (r & 3) + 8 * (r >> 2) + 4 * hi; const int d = pos - 31 - 16 * c;
                const float bv = btr[d < 0 ? 0 : (d > 127 ? 127 : d)];
                p[u][r] = d >= 0 ? p[u][r] + bv : NEG_INF; mx = fmaxf(mx, p[u][r]); }
        mx = fmaxf(mx, __shfl_xor(mx, 32));
        const float ms = (mx == NEG_INF) ? 0.f : mx;
        float l = 0.f;
#pragma unroll
        for (int u = 0; u < 4; ++u)
#pragma unroll
            for (int r = 0; r < 16; ++r) { p[u][r] = __builtin_amdgcn_exp2f(p[u][r] - ms); l += p[u][r]; }
        l += __shfl_xor(l, 32);
        const float inv = l > 0.f ? 1.f / l : 0.f;
#pragma unroll
        for (int u = 0; u < 4; ++u)
#pragma unroll
            for (int r = 0; r < 16; ++r) p[u][r] *= inv;
        {
            float X[4][4];
#pragma unroll
            for (int u = 0; u < 4; ++u)
#pragma unroll
                for (int jq = 0; jq < 4; ++jq) X[u][jq] = __shfl_xor(p[u][4 * jq + 3], 32);
            const int blk = pos >> 6;
#pragma unroll
            for (int u = 0; u < 4; ++u)
#pragma unroll
                for (int jq = 0; jq < 4; ++jq) {
                    const float Gq = (p[u][4 * jq] + p[u][4 * jq + 1]) + (p[u][4 * jq + 2] + p[u][4 * jq + 3]);
                    const float xprev = (jq > 0) ? X[u][jq - 1] : (u > 0 ? X[u - 1][3] : 0.f);
                    float imp = Gq + (hi ? X[u][jq] : xprev);
                    imp += __shfl_xor(imp, 1); imp += __shfl_xor(imp, 2);
                    const int s = 8 * u + 2 * jq + hi;
                    const bool valid = s * 64 <= pos, forced = (s == 0) || (s == blk) || (s == blk - 1);
                    const float score = valid ? imp + (forced ? 1000.f : 0.f) : -1.f;
                    if (hh == 0) scoreL[tokl * 32 + s] = score;
                }
            WSYNC();
            const int tk = lane >> 3, i8 = lane & 7;
            float sc32[32];
#pragma unroll
            for (int q4 = 0; q4 < 8; ++q4) { const f32x4 v = *(const LAS f32x4*)(scoreL + tk * 32 + 4 * q4); sc32[4 * q4] = v[0]; sc32[4 * q4 + 1] = v[1]; sc32[4 * q4 + 2] = v[2]; sc32[4 * q4 + 3] = v[3]; }
#pragma unroll
            for (int j = 0; j < 4; ++j) { const int s = 8 * j + i8; const float my = scoreL[tk * 32 + s]; int rank = 0;
#pragma unroll
                for (int s2 = 0; s2 < 32; ++s2) rank += ((sc32[s2] > my) || (sc32[s2] == my && s2 < s)) ? 1 : 0;
                const unsigned long long bal = __ballot(rank < (SAMPLE ? 15 : 16));
                selmask |= ((unsigned)(bal >> (8 * tokl)) & 0xffu) << (8 * j); }
            WSYNC();
        }
}

__device__ __forceinline__ void attn_mfma_unit(const Args& a, int b, int g, int qt, LAS unsigned char* lds) {
    using namespace cfg;
    const int tid = threadIdx.x, lane = tid & 63, r32 = lane & 31, hi = lane >> 5;
    const int wid = __builtin_amdgcn_readfirstlane(tid >> 6);
    LAS float* scoreL = (LAS float*)(lds + AT_SC + wid * 1024);
    const int tokl = r32 >> 2, hh = r32 & 3, head = g * 4 + hh;
    const int posmin = qt * 64 + wid * 8, posmax = posmin + 7, pos = posmin + tokl, row = b * SEQ + pos;
    const LAS float* btr = (const LAS float*)(lds + AT_BT) + head * 128;
    const float b31 = btr[127];
    bf16x8 qf[4];
    { const bf16* qp = (const bf16*)(a.ws + WS_QB) + (size_t)row * DM + head * 64 + hi * 8;
#pragma unroll
      for (int s = 0; s < 4; ++s) qf[s] = *(const bf16x8*)(qp + 16 * s); }
    const float* gp = (const float*)(a.ws + WS_GATES) + (size_t)row * 48 + head * 3; const float g0 = gp[0], g1 = gp[1], g2 = gp[2];
    f32x16 oacc[2]; oacc[0] = f32x16{}; oacc[1] = f32x16{};
    unsigned selmask = 0u;
    {
        const size_t cb = ((size_t)((DB + b) * 4 + g) * 128) * 64;
        const bf16* KCb = (const bf16*)(a.ws + WS_KC) + cb; const bf16* VCb = (const bf16*)(a.ws + WS_VC) + cb;
        const int posmaxu = qt * 64 + 63; int ncu = ((posmaxu - 31) >> 4) + 1; if (ncu > 127) ncu = 127;
        const int ntile = (ncu + 63) >> 6;
        v4u kr, vr;
        __syncthreads();
        for (int tl = 0; tl < ntile; ++tl) { tile_ld(KCb + tl * 64 * 64, VCb + tl * 64 * 64, 64, wid, lane, kr, vr); tile_st(lds, tl, wid, lane, kr, vr); }
        __syncthreads();
        f32x16 p[4]; p[2] = f32x16{}; p[3] = f32x16{};
        qk_tile(lds, 0, qf, r32, hi, p[0], p[1]);
        if (ntile > 1) qk_tile(lds, 1, qf, r32, hi, p[2], p[3]);
        cmp_softmax_topk<false>(p, pos, tokl, hh, hi, lane, btr, scoreL, selmask);
        f32x16 o[2]; o[0] = f32x16{}; o[1] = f32x16{};
        pv_tile(lds, 0, lane, hi, p[0], p[1], o);
        if (ntile > 1) pv_tile(lds, 1, lane, hi, p[2], p[3], o);
#pragma unroll
        for (int r = 0; r < 16; ++r) { oacc[0][r] = g0 * o[0][r]; oacc[1][r] = g0 * o[1][r]; }
    }
    const bf16* KVB = (const bf16*)(a.ws + WS_KVB) + (size_t)b * SEQ * KVW + g * 64;
    flash_branch<1>(lds, KVB + 512, KVB + 768, 0, qt, qf, pos, posmin, posmax, btr, b31, selmask, g1, oacc, wid, lane);
    flash_branch<2>(lds, KVB + 1024, KVB + 1280, qt >= 8 ? qt - 8 : 0, qt, qf, pos, posmin, posmax, btr, b31, 0u, g2, oacc, wid, lane);
    bf16* op = (bf16*)(a.ws + WS_OB) + (size_t)row * DM + head * 64 + 4 * hi;
#pragma unroll
    for (int db = 0; db < 2; ++db)
#pragma unroll
        for (int jq = 0; jq < 4; ++jq) { v2u w; w.x = cvtpk(oacc[db][4 * jq], oacc[db][4 * jq + 1]); w.y = cvtpk(oacc[db][4 * jq + 2], oacc[db][4 * jq + 3]);
            *(v2u*)(op + 32 * db + 8 * jq) = w; }
}


template <bool F32> __device__ __forceinline__ bf16x8 ld8(const void* p) {
    if (F32) { const f32x4 a = *(const f32x4*)p, b = *((const f32x4*)p + 1); v4u w; w.x = cvtpk(a[0], a[1]); w.y = cvtpk(a[2], a[3]); w.z = cvtpk(b[0], b[1]); w.w = cvtpk(b[2], b[3]); return __builtin_bit_cast(bf16x8, w); }
    else return *(const bf16x8*)p;
}
template <bool F32, class RowFn> __device__ __forceinline__ void kfrag_load(const RowFn& rowp, int lane, bf16x8 (&kf)[8]) {
    typedef typename std::conditional<F32, float, bf16>::type T;
    const int r32 = lane & 31, hi = lane >> 5;
#pragma unroll
    for (int half = 0; half < 2; ++half) { const T* kp = (const T*)rowp(r32 + 32 * half) + 8 * hi;
#pragma unroll
        for (int j = 0; j < 4; ++j) kf[2 * j + half] = ld8<F32>(kp + 16 * j); }
}
template <bool F32, class RowFn> __device__ __forceinline__ void vimg_load(const RowFn& rowp, long voff, int lane, LAS unsigned char* vimg) {
    typedef typename std::conditional<F32, float, bf16>::type T;
    bf16x8 v[8];
#pragma unroll
    for (int i = 0; i < 8; ++i) { const T* vp = (const T*)rowp(16 * (i & 3) + (lane >> 2)) + voff + (i >> 2) * 32 + (lane & 3) * 8; v[i] = ld8<F32>(vp); }
    WSYNC();
#pragma unroll
    for (int i = 0; i < 8; ++i) *(LAS bf16x8*)(vimg + i * 1024 + lane * 16) = v[i];
    WSYNC();
}
__device__ __forceinline__ void qk_frags(const bf16x8 (&kf)[8], const bf16x8 (&qf)[4], f32x16& p0, f32x16& p1) {
    p0 = f32x16{}; p1 = f32x16{};
#pragma unroll
    for (int j = 0; j < 4; ++j) { p0 = __builtin_amdgcn_mfma_f32_32x32x16_bf16(kf[2 * j], qf[j], p0, 0, 0, 0); p1 = __builtin_amdgcn_mfma_f32_32x32x16_bf16(kf[2 * j + 1], qf[j], p1, 0, 0, 0); }
}

__device__ __forceinline__ void attn_sample_unit(const Args& a, int b, int gp, LAS unsigned char* lds) {
    using namespace cfg;
    const int tid = threadIdx.x, lane = tid & 63, r32 = lane & 31, hi = lane >> 5;
    const int wid = __builtin_amdgcn_readfirstlane(tid >> 6);
    const int g = 2 * gp + (wid >> 2), part = wid & 3;
    LAS unsigned char* vimg = lds + AT_KS + wid * 8192;
    LAS float* scoreL = (LAS float*)(lds + AT_SC + wid * 1024);
    const int tokl = r32 >> 2, hh = r32 & 3, head = g * 4 + hh;
    const int posmin = PAST, pos = PAST + tokl, row = MP + b * DS + tokl;
    const LAS float* btr = (const LAS float*)(lds + AT_BT) + head * 128;
    const float b31 = btr[127];
    bf16x8 qf[4];
    { const bf16* qp = (const bf16*)(a.ws + WS_QB) + (size_t)row * DM + head * 64 + hi * 8;
#pragma unroll
      for (int s = 0; s < 4; ++s) qf[s] = *(const bf16x8*)(qp + 16 * s); }
    const float* gpt = (const float*)(a.ws + WS_GATES) + (size_t)row * 48 + head * 3; const float g0 = gpt[0], g1 = gpt[1], g2 = gpt[2];
    LAS float* ocL = (LAS float*)(lds + AT_END + (wid >> 2) * 8192);
    unsigned selmask = 0u;
    __syncthreads();
    {
        const bf16* KCb = (const bf16*)(a.ws + WS_KC) + ((size_t)(b * 4 + g) * 128) * 64; const long voffc = (long)((WS_VC - WS_KC) / 2);
        f32x16 p[4]; bf16x8 kf[8];
        auto r0 = [&](int key) { return (const void*)(KCb + (size_t)key * 64); };
        auto r1 = [&](int key) { return (const void*)(KCb + (size_t)(64 + key) * 64); };
        kfrag_load<false>(r0, lane, kf); qk_frags(kf, qf, p[0], p[1]);
        kfrag_load<false>(r1, lane, kf); qk_frags(kf, qf, p[2], p[3]);
        cmp_softmax_topk<true>(p, pos, tokl, hh, hi, lane, btr, scoreL, selmask);
        if (part == 0) {
            f32x16 oc[2]; oc[0] = f32x16{}; oc[1] = f32x16{};
            vimg_load<false>(r0, voffc, lane, vimg); pv_img(vimg, lane, hi, p[0], p[1], oc);
            vimg_load<false>(r1, voffc, lane, vimg); pv_img(vimg, lane, hi, p[2], p[3], oc);
#pragma unroll
            for (int db = 0; db < 2; ++db)
#pragma unroll
                for (int r = 0; r < 16; ++r) ocL[(db * 16 + r) * 64 + lane] = g0 * oc[db][r];
        }
    }
    const bf16* KVBn = (const bf16*)(a.ws + WS_KVB) + (size_t)(MP + b * DS) * KVW + g * 64;
    float ms_ = NEG_INF, ls_ = 0.f; f32x16 os_[2]; os_[0] = f32x16{}; os_[1] = f32x16{};
    for (int kt = part; kt <= 32; kt += 4) {
        const bool flag = kt == 32 ? true : ((selmask >> kt) & 1u) != 0u;
        if (!__any(flag)) continue;
        f32x16 p0, p1; bf16x8 kf[8];
        const bool near = (posmin - (kt * 64 + 63)) < 113;
        if (kt < 32) {
            const int page = a.page_table[b * NPAGE + (kt >> 1)];
            const float* base = a.cache_sel + ((size_t)page * PAGE + (kt & 1) * 64) * 512 + g * 64;
            auto rf = [&](int key) { return (const void*)(base + (size_t)key * 512); };
            kfrag_load<true>(rf, lane, kf); vimg_load<true>(rf, 256, lane, vimg);
        } else {
            auto rf = [&](int key) { return (const void*)(KVBn + (size_t)(key < DS ? key : DS - 1) * KVW + 512); };
            kfrag_load<false>(rf, lane, kf); vimg_load<false>(rf, 256, lane, vimg);
        }
        qk_frags(kf, qf, p0, p1);
        bias_mask<1>(p0, p1, pos - kt * 64 - 4 * hi, near, flag, btr, b31);
        online_update(p0, p1, ms_, ls_, os_);
        pv_img(vimg, lane, hi, p0, p1, os_);
    }
    float mw_ = NEG_INF, lw_ = 0.f; f32x16 ow_[2]; ow_[0] = f32x16{}; ow_[1] = f32x16{};
    for (int i = part; i <= 8; i += 4) {
        f32x16 p0, p1; bf16x8 kf[8];
        const int key0 = (PAST - 512) + 64 * i;
        const bool near = (posmin - (key0 + 63)) < 113;
        if (i < 8) {
            const float* base = a.cache_win + ((size_t)b * 512 + 64 * i) * 512 + g * 64;
            auto rf = [&](int key) { return (const void*)(base + (size_t)key * 512); };
            kfrag_load<true>(rf, lane, kf); vimg_load<true>(rf, 256, lane, vimg);
        } else {
            auto rf = [&](int key) { return (const void*)(KVBn + (size_t)(key < DS ? key : DS - 1) * KVW + 1024); };
            kfrag_load<false>(rf, lane, kf); vimg_load<false>(rf, 256, lane, vimg);
        }
        qk_frags(kf, qf, p0, p1);
        bias_mask<2>(p0, p1, pos - key0 - 4 * hi, near, true, btr, b31);
        online_update(p0, p1, mw_, lw_, ow_);
        pv_img(vimg, lane, hi, p0, p1, ow_);
    }
    ls_ += __shfl_xor(ls_, 32); lw_ += __shfl_xor(lw_, 32);
    scoreL[lane] = ms_; scoreL[64 + lane] = ls_; scoreL[128 + lane] = mw_; scoreL[192 + lane] = lw_;
    __syncthreads();
    {
        const LAS float* st = (const LAS float*)(lds + AT_SC + (wid & 4) * 1024);
        float Ms = NEG_INF, Mw = NEG_INF;
#pragma unroll
        for (int w = 0; w < 4; ++w) { Ms = fmaxf(Ms, st[w * 256 + lane]); Mw = fmaxf(Mw, st[w * 256 + 128 + lane]); }
        float Ls = 0.f, Lw = 0.f;
#pragma unroll
        for (int w = 0; w < 4; ++w) { Ls += st[w * 256 + 64 + lane] * __builtin_amdgcn_exp2f(st[w * 256 + lane] - Ms); Lw += st[w * 256 + 192 + lane] * __builtin_amdgcn_exp2f(st[w * 256 + 128 + lane] - Mw); }
        const float fs = g1 * __builtin_amdgcn_exp2f(ms_ - Ms) / Ls, fw = g2 * __builtin_amdgcn_exp2f(mw_ - Mw) / Lw;
        LAS float* slab = (LAS float*)vimg;
#pragma unroll
        for (int db = 0; db < 2; ++db)
#pragma unroll
            for (int r = 0; r < 16; ++r) slab[(db * 16 + r) * 64 + lane] = fs * os_[db][r] + fw * ow_[db][r] + (part == 0 ? ocL[(db * 16 + r) * 64 + lane] : 0.f);
    }
    __syncthreads();
    if (part == 0) {
        const LAS float* sl = (const LAS float*)(lds + AT_KS + wid * 8192);
        bf16* op = (bf16*)(a.ws + WS_OB) + (size_t)row * DM + head * 64 + 4 * hi;
#pragma unroll
        for (int db = 0; db < 2; ++db)
#pragma unroll
            for (int jq = 0; jq < 4; ++jq) { float v[4];
#pragma unroll
                for (int e = 0; e < 4; ++e) { const int idx = (db * 16 + 4 * jq + e) * 64 + lane; v[e] = (sl[idx] + sl[2048 + idx]) + (sl[4096 + idx] + sl[6144 + idx]); }
                v2u w; w.x = cvtpk(v[0], v[1]); w.y = cvtpk(v[2], v[3]); *(v2u*)(op + 32 * db + 8 * jq) = w; }
    }
}

__device__ __forceinline__ void attn_phase2(const Args& a, LAS unsigned char* lds, int G) {
    using namespace cfg;
    const int tid = threadIdx.x, lane = tid & 63, wave = tid >> 6;
    LAS float* bt = (LAS float*)(lds + AT_BT);
    for (int i = tid; i < 16 * 128; i += NTHR) { const int h = i >> 7, d = i & 127;
        int bucket = d; if (d >= 16) { bucket = 16 + (int)(__logf((float)d / 16.f) / 2.0794415416798357f * 16.f); if (bucket > 31) bucket = 31; }
        bt[i] = a.rel_bias[bucket * 16 + h] * LOG2E; }
    __syncthreads();
    for (int v = blockIdx.x; v < 1024; v += G) { const int j = v >> 8, k = v & 255, bg = k >> 3, r = k & 7;
        const int qt = (j == 0) ? 31 - r : (j == 1) ? 16 + r : (j == 2) ? 15 - r : r;
        attn_mfma_unit(a, bg >> 2, bg & 3, qt, lds); }
    __syncthreads();
    for (int v = blockIdx.x; v < 2 * DB; v += G) attn_sample_unit(a, v >> 1, v & 1, lds);
}

constexpr int SC_BROW = 0, SC_BTW = 32768, SC_CIMG = 65536, SC_XIMG = 98304, SC_HIMG = 114688, SC_UP = 132096;
__device__ __forceinline__ float softplus_f(float x) { return x > 20.f ? x : log1pf(__expf(x)); }

__device__ __forceinline__ void ssd_dt_stage(const Args& a, int row_first, int hd, float dtb, float Aneg, LAS float* up  , int tid) {
    if (tid < 128) {
        const float* DT = (const float*)(a.ws + cfg::WS_DT);
        const int l = tid, lo = tid ^ 64;
        const float dtv = softplus_f(DT[(size_t)(row_first + l) * 32 + hd] + dtb), dto = softplus_f(DT[(size_t)(row_first + lo) * 32 + hd] + dtb);
        const float av = dtv * Aneg, ao = dto * Aneg;
        float sc = av; const int lane = tid & 63;
#pragma unroll
        for (int o = 1; o < 64; o <<= 1) { const float t = __shfl_up(sc, o); if (lane >= o) sc += t; }
        const float mytot = __shfl(sc, 63), othtot = wave_sum(ao);
        const float acum = sc + (tid >= 64 ? othtot : 0.f), total = mytot + othtot;
        up[l] = acum; up[128 + l] = dtv; up[256 + l] = __expf(total - acum);
    }
}

__device__ __forceinline__ void ssd_prompt_unit(const Args& a, int b, int hd, LAS unsigned char* lds) {
    using namespace cfg;
    const int tid = threadIdx.x, lane = tid & 63, r32 = lane & 31, hi = lane >> 5;
    const int wid = __builtin_amdgcn_readfirstlane(tid >> 6);
    const int pb = wid >> 2, lb = wid & 3, g = hd >> 3, row0 = b * SEQ;
    const bf16* ZX = (const bf16*)(a.ws + WS_ZX); bf16* YG = (bf16*)(a.ws + WS_YG); float* SSQ = (float*)(a.ws + WS_SSQ);
    LAS float* upb = (LAS float*)(lds + SC_UP); LAS float* ssqx = upb + 768;
    const float dtb = a.m_dt_bias[hd], Aneg = -__expf(a.m_a_log[hd]), Dh = a.m_d[hd];
    const int seg = tid / 80, grp = tid - seg * 80; const bool stager = tid < 480;
    const int sr0 = seg * 21 + (seg < 2 ? seg : 2), snr = 21 + (seg < 2 ? 1 : 0);
    const int cl0 = grp * 4;
    const int cx0 = cl0 < 64 ? hd * 64 + cl0 : (cl0 < 192 ? 2048 + g * 128 + (cl0 - 64) : 2560 + g * 128 + (cl0 - 192));
    float cw[4][4], cbias[4];
    if (stager) {
#pragma unroll
        for (int k = 0; k < 4; ++k) { const f32x4 w = *(const f32x4*)(a.m_conv_w + k * CONVD + cx0); cw[k][0] = w[0]; cw[k][1] = w[1]; cw[k][2] = w[2]; cw[k][3] = w[3]; }
        const f32x4 bb = *(const f32x4*)(a.m_conv_b + cx0); cbias[0] = bb[0]; cbias[1] = bb[1]; cbias[2] = bb[2]; cbias[3] = bb[3];
    }
    f32x16 hT = f32x16{};
    __syncthreads();
    ssd_dt_stage(a, row0, hd, dtb, Aneg, upb, tid);
    __syncthreads();
    for (int ci = 0; ci < SEQ / 128; ++ci) {
        const int t0 = ci * 128; LAS float* up = upb + (ci & 1) * 384;
        if (stager) {
            float xm3[4], xm2[4], xm1[4];
            { const int tr = t0 + sr0 - 3;
              v2u r0 = {0u, 0u}, r1 = {0u, 0u}, r2 = {0u, 0u};
              if (tr >= 0) r0 = *(const v2u*)(ZX + (size_t)(row0 + tr) * ZXW + DIN + cx0);
              if (tr + 1 >= 0) r1 = *(const v2u*)(ZX + (size_t)(row0 + tr + 1) * ZXW + DIN + cx0);
              if (tr + 2 >= 0) r2 = *(const v2u*)(ZX + (size_t)(row0 + tr + 2) * ZXW + DIN + cx0);
              xm3[0] = bflo(r0.x); xm3[1] = bfhi(r0.x); xm3[2] = bflo(r0.y); xm3[3] = bfhi(r0.y);
              xm2[0] = bflo(r1.x); xm2[1] = bfhi(r1.x); xm2[2] = bflo(r1.y); xm2[3] = bfhi(r1.y);
              xm1[0] = bflo(r2.x); xm1[1] = bfhi(r2.x); xm1[2] = bflo(r2.y); xm1[3] = bfhi(r2.y); }
            for (int i = 0; i < snr; ++i) {
                const int s = sr0 + i;
                const v2u rr = *(const v2u*)(ZX + (size_t)(row0 + t0 + s) * ZXW + DIN + cx0);
                float xc[4] = {bflo(rr.x), bfhi(rr.x), bflo(rr.y), bfhi(rr.y)}, v[4];
#pragma unroll
                for (int c = 0; c < 4; ++c) { v[c] = silu_f(cbias[c] + cw[0][c] * xm3[c] + cw[1][c] * xm2[c] + cw[2][c] * xm1[c] + cw[3][c] * xc[c]); xm3[c] = xm2[c]; xm2[c] = xm1[c]; xm1[c] = xc[c]; }
                if (cl0 < 64) { const float dtv = up[128 + s]; v2u w; w.x = pk2(v[0] * dtv, v[1] * dtv); w.y = pk2(v[2] * dtv, v[3] * dtv);
                    *(LAS v2u*)(lds + SC_XIMG + (cl0 >> 5) * 8192 + s * 64 + (cl0 & 31) * 2) = w; }
                else if (cl0 < 192) { const int n = cl0 - 64; v2u w; w.x = pk2(v[0], v[1]); w.y = pk2(v[2], v[3]);
                    *(LAS v2u*)(lds + SC_BROW + (n >> 3) * 2048 + s * 16 + (n & 7) * 2) = w;
                    const float ws = up[256 + s];
#pragma unroll
                    for (int c = 0; c < 4; ++c) *(LAS unsigned short*)(lds + SC_BTW + (s >> 3) * 2048 + (n + c) * 16 + (s & 7) * 2) = (unsigned short)f2bf(v[c] * ws); }
                else { const int n = cl0 - 192; v2u w; w.x = pk2(v[0], v[1]); w.y = pk2(v[2], v[3]);
                    *(LAS v2u*)(lds + SC_CIMG + (n >> 3) * 2048 + s * 16 + (n & 7) * 2) = w; }
            }
        }
#pragma unroll
        for (int jq = 0; jq < 4; ++jq) { v2u w; w.x = pk2(hT[4 * jq], hT[4 * jq + 1]); w.y = pk2(hT[4 * jq + 2], hT[4 * jq + 3]);
            *(LAS v2u*)(lds + SC_HIMG + (4 * lb + jq) * 1024 + (32 * pb + r32) * 16 + hi * 8) = w; }
        if (ci > 0 && tid < 128) SSQ[(size_t)(row0 + t0 - 128 + tid) * 32 + hd] = ssqx[tid] + ssqx[128 + tid];
        if (ci + 1 < SEQ / 128) ssd_dt_stage(a, row0 + t0 + 128, hd, dtb, Aneg, upb + ((ci + 1) & 1) * 384, tid);
        __syncthreads();
        {
            const int lm = 32 * lb + r32;
            const float acl = up[lm], dtl = up[128 + lm], el = __expf(acl);
            bf16x8 cf[8];
#pragma unroll
            for (int k = 0; k < 8; ++k) cf[k] = *(const LAS bf16x8*)(lds + SC_CIMG + (2 * k + hi) * 2048 + lm * 16);
            f32x16 acc = f32x16{};
#pragma unroll
            for (int k = 0; k < 8; ++k) { const bf16x8 hf = *(const LAS bf16x8*)(lds + SC_HIMG + (2 * k + hi) * 1024 + (32 * pb + r32) * 16);
                acc = __builtin_amdgcn_mfma_f32_32x32x16_bf16(hf, cf[k], acc, 0, 0, 0); }
#pragma unroll
            for (int r = 0; r < 16; ++r) acc[r] *= el;
            const LAS unsigned char* xtr = lds + SC_XIMG + pb * 8192 + ((lane >> 4) & 1) * 32 + (lane & 3) * 8 + (4 * hi + ((lane & 15) >> 2)) * 64;
            for (int sb = 0; sb <= lb; ++sb) {
                f32x16 gt = f32x16{};
#pragma unroll
                for (int k = 0; k < 8; ++k) { const bf16x8 bfr = *(const LAS bf16x8*)(lds + SC_BROW + (2 * k + hi) * 2048 + (32 * sb + r32) * 16);
                    gt = __builtin_amdgcn_mfma_f32_32x32x16_bf16(bfr, cf[k], gt, 0, 0, 0); }
#pragma unroll
                for (int jq = 0; jq < 4; ++jq) { const f32x4 as4 = *(const LAS f32x4*)(up + 32 * sb + 8 * jq + 4 * hi);
#pragma unroll
                    for (int e = 0; e < 4; ++e) { const int s = 32 * sb + 8 * jq + 4 * hi + e; const float d = acl - as4[e];
                        gt[4 * jq + e] = (s <= lm) ? gt[4 * jq + e] * __expf(d < 0.f ? d : 0.f) : 0.f; } }
                bf16x8 pf[2];
#pragma unroll
                for (int ks = 0; ks < 2; ++ks) { v4u w; w.x = cvtpk(gt[8 * ks], gt[8 * ks + 1]); w.y = cvtpk(gt[8 * ks + 2], gt[8 * ks + 3]); w.z = cvtpk(gt[8 * ks + 4], gt[8 * ks + 5]); w.w = cvtpk(gt[8 * ks + 6], gt[8 * ks + 7]); pf[ks] = __builtin_bit_cast(bf16x8, w); }
#pragma unroll
                for (int ks = 0; ks < 2; ++ks) { const s16x4 lo = vtr(xtr + (32 * sb + 16 * ks) * 64), hv = vtr(xtr + (32 * sb + 16 * ks) * 64 + 512);
                    const bf16x8 xf = {lo[0], lo[1], lo[2], lo[3], hv[0], hv[1], hv[2], hv[3]};
                    acc = __builtin_amdgcn_mfma_f32_32x32x16_bf16(xf, pf[ks], acc, 0, 0, 0); }
            }
            { const float dod = Dh / dtl; float ssq = 0.f; const size_t grow = (size_t)(row0 + t0 + lm);
#pragma unroll
              for (int jq = 0; jq < 4; ++jq) { const int p4 = 32 * pb + 8 * jq + 4 * hi;
                  const v2u xw = *(const LAS v2u*)(lds + SC_XIMG + pb * 8192 + lm * 64 + (8 * jq + 4 * hi) * 2);
                  const v2u zw = *(const v2u*)(ZX + grow * ZXW + hd * 64 + p4);
                  const float y0 = (acc[4 * jq] + dod * bflo(xw.x)) * silu_f(bflo(zw.x)), y1 = (acc[4 * jq + 1] + dod * bfhi(xw.x)) * silu_f(bfhi(zw.x));
                  const float y2 = (acc[4 * jq + 2] + dod * bflo(xw.y)) * silu_f(bflo(zw.y)), y3 = (acc[4 * jq + 3] + dod * bfhi(xw.y)) * silu_f(bfhi(zw.y));
                  ssq += (y0 * y0 + y1 * y1) + (y2 * y2 + y3 * y3);
                  v2u w; w.x = pk2(y0, y1); w.y = pk2(y2, y3); *(v2u*)(YG + grow * DIN + hd * 64 + p4) = w; }
              ssq += __shfl_xor(ssq, 32);
              if (hi == 0) ssqx[pb * 128 + lm] = ssq; }
            { const float etot = __expf(up[127]);
#pragma unroll
              for (int r = 0; r < 16; ++r) hT[r] *= etot;
              const LAS unsigned char* xn = lds + SC_XIMG + pb * 8192 + ((lane >> 4) & 1) * 32 + (lane & 3) * 8 + (8 * hi + ((lane & 15) >> 2)) * 64;
#pragma unroll
              for (int k = 0; k < 8; ++k) { const bf16x8 bt = *(const LAS bf16x8*)(lds + SC_BTW + (2 * k + hi) * 2048 + (32 * lb + r32) * 16);
                  const s16x4 lo = vtr(xn + (16 * k) * 64), hv = vtr(xn + (16 * k) * 64 + 256);
                  const bf16x8 xf = {lo[0], lo[1], lo[2], lo[3], hv[0], hv[1], hv[2], hv[3]};
                  hT = __builtin_amdgcn_mfma_f32_32x32x16_bf16(bt, xf, hT, 0, 0, 0); } }
        }
        __syncthreads();
    }
    if (tid < 128) SSQ[(size_t)(row0 + SEQ - 128 + tid) * 32 + hd] = ssqx[tid] + ssqx[128 + tid];
    { float* sd = a.out + O_PSSM + ((size_t)(b * NH + hd) * HD + 32 * pb + r32) * DST + 32 * lb + 4 * hi;
#pragma unroll
      for (int jq = 0; jq < 4; ++jq) { const f32x4 v = {hT[4 * jq], hT[4 * jq + 1], hT[4 * jq + 2], hT[4 * jq + 3]}; *(f32x4*)(sd + 8 * jq) = v; } }
    __syncthreads();
}

__device__ __forceinline__ void ssd_sample_wave(const Args& a, int b, int hd, int lane, LAS float* bc  ) {
    using namespace cfg;
    const int g = hd >> 3, row0 = MP + b * DS;
    const bf16* ZX = (const bf16*)(a.ws + WS_ZX); const float* DT = (const float*)(a.ws + WS_DT);
    bf16* YG = (bf16*)(a.ws + WS_YG); float* SSQ = (float*)(a.ws + WS_SSQ);
    const float dtb = a.m_dt_bias[hd], Aneg = -__expf(a.m_a_log[hd]), Dh = a.m_d[hd];
    float h[128];
    { const float* s0 = a.state_ssm + ((size_t)(b * NH + hd) * HD + lane) * DST;
#pragma unroll
      for (int i = 0; i < 32; ++i) { const f32x4 v = *(const f32x4*)(s0 + 4 * i); h[4 * i] = v[0]; h[4 * i + 1] = v[1]; h[4 * i + 2] = v[2]; h[4 * i + 3] = v[3]; } }
    LAS float* xsl = bc + 2048;
#pragma unroll 1
    for (int q = 0; q < 5; ++q) {
        const int cx = q == 0 ? hd * 64 + lane : (q < 3 ? 2048 + g * 128 + lane + 64 * (q - 1) : 2560 + g * 128 + lane + 64 * (q - 3));
        const float w0 = a.m_conv_w[cx], w1 = a.m_conv_w[CONVD + cx], w2 = a.m_conv_w[2 * CONVD + cx], w3 = a.m_conv_w[3 * CONVD + cx], cb = a.m_conv_b[cx];
        float xm3 = a.state_conv[(size_t)(b * 3 + 0) * CONVD + cx], xm2 = a.state_conv[(size_t)(b * 3 + 1) * CONVD + cx], xm1 = a.state_conv[(size_t)(b * 3 + 2) * CONVD + cx];
#pragma unroll
        for (int t = 0; t < 8; ++t) { const float xc = bf2f(ZX[(size_t)(row0 + t) * ZXW + DIN + cx]);
            const float v = silu_f(cb + w0 * xm3 + w1 * xm2 + w2 * xm1 + w3 * xc); xm3 = xm2; xm2 = xm1; xm1 = xc;
            if (q == 0) xsl[t * 64 + lane] = v; else bc[t * 256 + (q < 3 ? 0 : 128) + lane + 64 * ((q - 1) & 1)] = v; }
    }
    WSYNC();
#pragma unroll 1
    for (int t = 0; t < 8; ++t) {
        const float xst = xsl[t * 64 + lane];
        const float dtv = softplus_f(DT[(size_t)(row0 + t) * 32 + hd] + dtb), dA = __expf(dtv * Aneg), xdt = xst * dtv;
        float y = 0.f;
#pragma unroll
        for (int i = 0; i < 32; ++i) { const f32x4 Bv = *(const LAS f32x4*)(bc + t * 256 + 4 * i), Cv = *(const LAS f32x4*)(bc + t * 256 + 128 + 4 * i);
#pragma unroll
            for (int e = 0; e < 4; ++e) { h[4 * i + e] = dA * h[4 * i + e] + xdt * Bv[e]; y += h[4 * i + e] * Cv[e]; } }
        const float z = bf2f(ZX[(size_t)(row0 + t) * ZXW + hd * 64 + lane]);
        const float yg = (y + Dh * xst) * silu_f(z);
        YG[(size_t)(row0 + t) * DIN + hd * 64 + lane] = (bf16)f2bf(yg);
        const float ss = wave_sum(yg * yg); if (lane == 0) SSQ[(size_t)(row0 + t) * 32 + hd] = ss;
    }
    { float* sd = a.out + O_SSSM + ((size_t)(b * NH + hd) * HD + lane) * DST;
#pragma unroll
      for (int i = 0; i < 32; ++i) { const f32x4 v = {h[4 * i], h[4 * i + 1], h[4 * i + 2], h[4 * i + 3]}; *(f32x4*)(sd + 4 * i) = v; } }
    WSYNC();
}

__device__ __forceinline__ void scan_phase2(const Args& a, LAS unsigned char* lds, int G) {
    using namespace cfg;
    for (int u = blockIdx.x; u < NPB * NH; u += G) ssd_prompt_unit(a, u >> 5, u & 31, lds);
    __syncthreads();
    const int lane = threadIdx.x & 63, wave = threadIdx.x >> 6;
    LAS float* bc = (LAS float*)(lds + wave * 10240);
    for (int u = blockIdx.x * NWAVES + wave; u < DB * NH; u += G * NWAVES) ssd_sample_wave(a, u >> 5, u & 31, lane, bc);
}

constexpr int N_PHASES = 18;
__global__ void __launch_bounds__(NTHR, 2) yoco_fwd(Args args) {
    using namespace cfg;
    extern __shared__ __attribute__((aligned(16))) unsigned char lds_raw[];
    LAS unsigned char* lds = (LAS unsigned char*)lds_raw;
    const int tid = threadIdx.x, G = gridDim.x;
    unsigned char* ws = args.ws;
    for (int u = tid; u < (LDS_BYTES - RING_BYTES) / 4; u += NTHR) ((LAS unsigned*)(lds + RING_BYTES))[u] = 0u;
    __syncthreads();
    const bool one_launch = (args.ph_hi - args.ph_lo) > 1;
    XcdBarrier bar; bar.bar = (unsigned*)(ws + WS_CTL) + CW_BAR; bar.x = 0; bar.st = nullptr;
    if (one_launch) bar = xcd_barrier_post((unsigned*)(ws + WS_CTL) + CW_BAR, (volatile LAS unsigned*)(lds + MISC_OFF) + 8);
    const int lo = args.ph_lo, hi = args.ph_hi;
#define IN(k) (lo <= (k) && (k) < hi)
#define SEAM(k) do { if (IN(k) && IN((k) + 1)) xcd_barrier(bar); } while (0)
    bf16* const XB = (bf16*)(ws + WS_XB); bf16* const HAB = (bf16*)(ws + WS_HAB); bf16* const HBB = (bf16*)(ws + WS_HBB); bf16* const HFF = (bf16*)(ws + WS_HFF);
    float* const PRE = (float*)(ws + WS_PRE); float* const HA = (float*)(ws + WS_HA); float* const HB = (float*)(ws + WS_HB);

    if (IN(0)) { p0_prologue(args, lds, G); SEAM(0); }
    if (IN(1)) { pg8::Gemm g{XB, (const bf16*)(ws + WS_WIN), M, INPAD, DM}; pg8::StaticOrder S; S.init(M, INPAD, G, (int)blockIdx.x);
        pg8::EpiIn E{(bf16*)(ws + WS_ZX), (float*)(ws + WS_DT), args.out + O_PCONV, args.out + O_SCONV};
        pg8::gemm_phase<pg8::EpiIn, pg8::StaticOrder, true, true>(lds, g, S, E); SEAM(1); }
    if (IN(2)) { scan_phase2(args, lds, G); SEAM(2); }
    if (IN(3)) { norm_phase(args, G); SEAM(3); }
    if (IN(4)) { pg8::Gemm g{(const bf16*)(ws + WS_YN), (const bf16*)(ws + WS_WOUT), M, DM, DIN}; pg8::StaticOrder S; S.init(M, DM, G, (int)blockIdx.x);
        pg8::EpiRes E{PRE, args.x_prompt, args.x_sample - (size_t)MP * DM};
        pg8::gemm_phase<pg8::EpiRes, pg8::StaticOrder, true, true>(lds, g, S, E); SEAM(4); }
    if (IN(5)) { ln_phase(PRE, args.ln_g + 0 * DM, args.ln_b + 0 * DM, HA, HAB, G); SEAM(5); }
    if (IN(6)) { pg8::Gemm g{HAB, (const bf16*)(ws + WS_W1), M, DFF, DM}; pg8::StaticOrder S; S.init(M, DFF, G, (int)blockIdx.x);
        pg8::EpiRelu2 E{HFF}; pg8::gemm_phase<pg8::EpiRelu2, pg8::StaticOrder, true, true>(lds, g, S, E); SEAM(6); }
    if (IN(7)) { pg8::Gemm g{HFF, (const bf16*)(ws + WS_W2), M, DM, DFF}; pg8::StaticOrder S; S.init(M, DM, G, (int)blockIdx.x);
        pg8::EpiRes E{PRE, HA, HA}; pg8::gemm_phase<pg8::EpiRes, pg8::StaticOrder, true, true>(lds, g, S, E); SEAM(7); }
    if (IN(8)) { ln_phase(PRE, args.ln_g + 1 * DM, args.ln_b + 1 * DM, HB, HBB, G); SEAM(8); }
    if (IN(9)) { pg8::Gemm g{HBB, (const bf16*)(ws + WS_WKVQ), M, KVQN, DM}; pg8::StaticOrder S; S.init(M, KVQN, G, (int)blockIdx.x);
        pg8::EpiKvq E{args.out, (bf16*)(ws + WS_KVB), (bf16*)(ws + WS_QB), (float*)(ws + WS_GATES), (bf16*)(ws + WS_ACMP)};
        pg8::gemm_phase<pg8::EpiKvq, pg8::StaticOrder, true, true>(lds, g, S, E); SEAM(9); }
    if (IN(10)) { pg8::Gemm g{(const bf16*)(ws + WS_ACMP), (const bf16*)(ws + WS_WC1), 2 * NCMPROWS, 512, 1024}; pg8::CmpOrder S{G, (int)blockIdx.x};
        pg8::EpiP E{(float*)(ws + WS_PCMP)}; pg8::gemm_phase<pg8::EpiP, pg8::CmpOrder, true, true>(lds, g, S, E); SEAM(10); }
    if (IN(11)) { cmp2_phase(args, lds, G); SEAM(11); }
    if (IN(12)) { attn_phase2(args, lds, G); SEAM(12); }
    if (IN(13)) { pg8::Gemm g{(const bf16*)(ws + WS_OB), (const bf16*)(ws + WS_WO), M, DM, DM}; pg8::StaticOrder S; S.init(M, DM, G, (int)blockIdx.x);
        pg8::EpiRes E{PRE, HB, HB}; pg8::gemm_phase<pg8::EpiRes, pg8::StaticOrder, true, true>(lds, g, S, E); SEAM(13); }
    if (IN(14)) { ln_phase(PRE, args.ln_g + 2 * DM, args.ln_b + 2 * DM, HA, HAB, G); SEAM(14); }
    if (IN(15)) { pg8::Gemm g{HAB, (const bf16*)(ws + WS_W1) + (size_t)DFF * DM, M, DFF, DM}; pg8::StaticOrder S; S.init(M, DFF, G, (int)blockIdx.x);
        pg8::EpiRelu2 E{HFF}; pg8::gemm_phase<pg8::EpiRelu2, pg8::StaticOrder, true, true>(lds, g, S, E); SEAM(15); }
    if (IN(16)) { pg8::Gemm g{HFF, (const bf16*)(ws + WS_W2) + (size_t)DFF * DM, M, DM, DFF}; pg8::StaticOrder S; S.init(M, DM, G, (int)blockIdx.x);
        pg8::EpiRes E{PRE, HA, HA}; pg8::gemm_phase<pg8::EpiRes, pg8::StaticOrder, true, true>(lds, g, S, E); SEAM(16); }
    if (IN(17)) { ln_phase(PRE, args.ln_g + 3 * DM, args.ln_b + 3 * DM, args.out + O_YP, nullptr, G); }
#undef IN
#undef SEAM
}

extern "C" void kernel_launch(void* const* d_in, const int* in_sizes, int n_in, void* d_out, int out_size, void* d_ws, size_t ws_size, hipStream_t stream) {
    using namespace cfg;
    static int grid = 0;
    if (grid == 0) {
        if (n_in != 27 || (size_t)out_size != O_END || ws_size < WS_END) { fprintf(stderr, "kernel_launch: unexpected shapes (n_in %d, out %d, ws %zu, need %zu); nothing launched\n", n_in, out_size, ws_size, (size_t)WS_END); grid = -1; return; }
        int dev = 0, cus = 0, per_cu = 0;
        if (hipGetDevice(&dev) != hipSuccess || hipDeviceGetAttribute(&cus, hipDeviceAttributeMultiprocessorCount, dev) != hipSuccess) { grid = -1; return; }
        if (hipFuncSetAttribute((const void*)yoco_fwd, hipFuncAttributeMaxDynamicSharedMemorySize, LDS_BYTES) != hipSuccess) { fprintf(stderr, "kernel_launch: hipFuncSetAttribute failed\n"); grid = -1; return; }
        if (hipOccupancyMaxActiveBlocksPerMultiprocessor(&per_cu, (const void*)yoco_fwd, NTHR, LDS_BYTES) != hipSuccess || per_cu < 1) { fprintf(stderr, "kernel_launch: occupancy query says %d blocks per CU\n", per_cu); }
        (void)hipGetLastError();
        grid = cus;
    }
    if (grid < 0) return;
    if (hipMemsetAsync((char*)d_ws + WS_CTL, 0, CTL_ZERO_BYTES, stream) != hipSuccess) { fprintf(stderr, "kernel_launch: memset failed\n"); return; }
    Args a{};
    const float* const* fin = (const float* const*)d_in;
    a.x_prompt = fin[0]; a.x_sample = fin[1]; a.state_ssm = fin[2]; a.state_conv = fin[3]; a.cache_cmp = fin[4]; a.cache_sel = fin[5]; a.cache_win = fin[6]; a.page_table = (const int*)d_in[7];
    a.ln_g = fin[8]; a.ln_b = fin[9]; a.m_in_w = fin[10]; a.m_conv_w = fin[11]; a.m_conv_b = fin[12]; a.m_dt_bias = fin[13]; a.m_a_log = fin[14]; a.m_d = fin[15]; a.m_norm_w = fin[16]; a.m_out_w = fin[17];
    a.kv_w = fin[18]; a.cmp_w1 = fin[19]; a.cmp_pe = fin[20]; a.cmp_w2 = fin[21]; a.q_w = fin[22]; a.o_w = fin[23]; a.rel_bias = fin[24]; a.mlp_w1 = fin[25]; a.mlp_w2 = fin[26];
    a.out = (float*)d_out; a.ws = (unsigned char*)d_ws; a.pad = 0;
    constexpr int NL = (MK_N_LAUNCHES == 1) ? 1 : N_PHASES;
    for (int li = 0; li < NL; ++li) {
        a.ph_lo = (NL == 1) ? 0 : li; a.ph_hi = (NL == 1) ? N_PHASES : li + 1; a.li = li;
        hipLaunchKernelGGL(yoco_fwd, dim3(grid), dim3(NTHR), LDS_BYTES, stream, a);
        const hipError_t le = hipPeekAtLastError();
        if (le != hipSuccess) { fprintf(stderr, "kernel_launch: launch %d failed: %s\n", li, hipGetErrorName(le)); break; }
    }
}
```

```cpp
#include <hip/hip_runtime.h>
#include <cstdio>
#include <cstdint>
#include <type_traits>

#ifndef MK_N_LAUNCHES
#define MK_N_LAUNCHES 1
#endif

namespace cfg {
constexpr int DM = 1024, NPB = 8, SEQ = 2048, DB = 128, DS = 8, PAST = 2048, PAGE = 128, NPAGE = PAST / PAGE;
constexpr int MP = NPB * SEQ, MS = DB * DS, M = MP + MS;
constexpr int DFF = 4096, DIN = 2048, NH = 32, HD = 64, NG = 4, HPG = 8, DST = 128, CONVD = 3072, INDIM = 5152, INPAD = 5376, ZXW = 5120;
constexpr int AH = 16, AKV = 4, AGRP = 4, KVW = 1536, QGW = 1072, KVQN = 2816, KVROW = 512;
constexpr int NCMPROWS = (DB + NPB) * AKV * 128;
constexpr float LN_EPS = 1e-5f, RMS_EPS = 1e-5f;
constexpr float ALPHA = 1.4142135623730951f;
constexpr float LOG2E = 1.4426950408889634f;
constexpr float QSCALE = 0.125f * LOG2E;
constexpr size_t O_YP = 0, O_YS = O_YP + (size_t)MP * DM, O_PSSM = O_YS + (size_t)MS * DM, O_PCONV = O_PSSM + (size_t)NPB * NH * HD * DST,
                 O_PCMP = O_PCONV + (size_t)NPB * 3 * CONVD, O_PSEL = O_PCMP + (size_t)MP * KVROW, O_PWIN = O_PSEL + (size_t)MP * KVROW,
                 O_SSSM = O_PWIN + (size_t)NPB * 512 * KVROW, O_SCONV = O_SSSM + (size_t)DB * NH * HD * DST, O_SCMP = O_SCONV + (size_t)DB * 3 * CONVD,
                 O_SSEL = O_SCMP + (size_t)MS * KVROW, O_SWIN = O_SSEL + (size_t)MS * KVROW, O_END = O_SWIN + (size_t)DB * 512 * KVROW;
static_assert(O_END == 108208128ull, "output size");
constexpr size_t MiB = 1u << 20;
constexpr size_t al(size_t x) { return (x + MiB - 1) / MiB * MiB; }
constexpr size_t WS_CTL = 0, CTL_ZERO_BYTES = MiB;
constexpr size_t WS_WIN = MiB;
constexpr size_t WS_WOUT = WS_WIN + al((size_t)INPAD * DM * 2);
constexpr size_t WS_W1 = WS_WOUT + al((size_t)DM * DIN * 2);
constexpr size_t WS_W2 = WS_W1 + 2 * al((size_t)DFF * DM * 2);
constexpr size_t WS_WKVQ = WS_W2 + 2 * al((size_t)DFF * DM * 2);
constexpr size_t WS_WO = WS_WKVQ + al((size_t)KVQN * DM * 2);
constexpr size_t WS_WC1 = WS_WO + al((size_t)DM * DM * 2);
constexpr size_t WS_PEC = WS_WC1 + al((size_t)512 * 1024 * 2);
constexpr size_t WS_XB = WS_PEC + MiB;
constexpr size_t WS_ZX = WS_XB + al((size_t)M * DM * 2);
constexpr size_t WS_DT = WS_ZX + al((size_t)M * ZXW * 2);
constexpr size_t WS_YG = WS_DT + al((size_t)M * 32 * 4);
constexpr size_t WS_SSQ = WS_YG + al((size_t)M * DIN * 2);
constexpr size_t WS_YN = WS_SSQ + al((size_t)M * 32 * 4);
constexpr size_t WS_PRE = WS_YN + al((size_t)M * DIN * 2);
constexpr size_t WS_HA = WS_PRE + al((size_t)M * DM * 4);
constexpr size_t WS_HB = WS_HA + al((size_t)M * DM * 4);
constexpr size_t WS_HAB = WS_HB + al((size_t)M * DM * 4);
constexpr size_t WS_HBB = WS_HAB + al((size_t)M * DM * 2);
constexpr size_t WS_HFF = WS_HBB + al((size_t)M * DM * 2);
constexpr size_t WS_KVB = WS_HFF + al((size_t)M * DFF * 2);
constexpr size_t WS_QB = WS_KVB + al((size_t)M * KVW * 2);
constexpr size_t WS_GATES = WS_QB + al((size_t)M * DM * 2);
constexpr size_t WS_ACMP = WS_GATES + al((size_t)M * 48 * 4);
constexpr size_t WS_PCMP = WS_ACMP + al((size_t)2 * NCMPROWS * 1024 * 2);
constexpr size_t WS_KC = WS_PCMP + al((size_t)2 * NCMPROWS * 256 * 4);
constexpr size_t WS_VC = WS_KC + al((size_t)NCMPROWS * 64 * 2);
constexpr size_t WS_OB = WS_VC + al((size_t)NCMPROWS * 64 * 2);
constexpr size_t WS_XC = WS_OB + al((size_t)M * DM * 2);
constexpr size_t WS_END = WS_XC + al((size_t)M * CONVD * 2);
constexpr int CW_BAR = 4096;
constexpr int RING_BYTES = 131072, MISC_OFF = RING_BYTES + 320, LDS_BYTES = 147456;
}

#define GAS __attribute__((address_space(1)))
#define LAS __attribute__((address_space(3)))
typedef unsigned short bf16;
typedef unsigned v4u __attribute__((ext_vector_type(4)));
typedef unsigned v2u __attribute__((ext_vector_type(2)));
typedef float f32x4 __attribute__((ext_vector_type(4)));
#define LDS_WAIT() asm volatile("s_waitcnt lgkmcnt(0)" ::: "memory")
#define VM_WAIT() asm volatile("s_waitcnt vmcnt(0)" ::: "memory")
__device__ __forceinline__ unsigned f2bf(float f) { unsigned u = __builtin_bit_cast(unsigned, f); return (u + 0x7fffu + ((u >> 16) & 1u)) >> 16; }
__device__ __forceinline__ unsigned pk2(float lo, float hi) { return f2bf(lo) | (f2bf(hi) << 16); }
__device__ __forceinline__ float bf2f(unsigned short b) { return __builtin_bit_cast(float, ((unsigned)b) << 16); }
__device__ __forceinline__ float bflo(unsigned w) { return __builtin_bit_cast(float, w << 16); }
__device__ __forceinline__ float bfhi(unsigned w) { return __builtin_bit_cast(float, w & 0xffff0000u); }

namespace pg8 {
#define PG8_LAS __attribute__((address_space(3)))
typedef unsigned short bf16_t;
typedef short bf16x8 __attribute__((ext_vector_type(8)));
typedef float f32x4 __attribute__((ext_vector_type(4)));
typedef unsigned u32x4 __attribute__((ext_vector_type(4)));
constexpr int BM = 256, BK = 64, HALF = 128, HTB = HALF * BK * 2  , STAGE_BYTES = 8 * HTB, NXCD = 8, WGM = 8;

__host__ __device__ __forceinline__ int lds_byte(int r, int c) { const int st = (r >> 4) * 2 + (c >> 5), rr = r & 15, cc = c & 31, ob = rr * 64 + cc * 2; return st * 1024 + (ob ^ (((ob >> 9) & 1) << 5)); }
__host__ __device__ __forceinline__ void stage_rc(int b, int& R, int& C) { const int st = b / 1024, sb = b % 1024, swz = sb ^ (((sb >> 9) & 1) << 5); R = (st >> 1) * 16 + swz / 64; C = (st & 1) * 32 + (swz % 64) / 2; }
__host__ __device__ __forceinline__ int perm32(int rho) { const int n = rho >> 4, i = rho & 15; return 8 * (i >> 2) + 4 * n + (i & 3); }

struct Unit { int pm, pn; };
struct Gemm { const bf16_t* A; const bf16_t* Bt; int M, N, K; };

struct StaticOrder {
    int nM, nN, nwg, G, c;
    __host__ __device__ void init(int M, int N, int G_, int c_) { nM = M / BM; nN = N / BM; nwg = nM * nN; G = G_; c = c_; }
    __host__ __device__ bool next(int i, Unit& u) const {
        const long L = (long)i * G + c; if (L >= nwg) return false;
        int wgid = (int)L; { const int q = nwg / NXCD, r = nwg % NXCD, xcd = wgid % NXCD, off = wgid / NXCD; wgid = (xcd < r ? xcd * (q + 1) : r * (q + 1) + (xcd - r) * q) + off; }
        const int nig = WGM * nN, gid = wgid / nig, fm = gid * WGM, gsz = (nM - fm) < WGM ? (nM - fm) : WGM;
        u.pm = fm + ((wgid % nig) % gsz); u.pn = (wgid % nig) / gsz; return true;
    }
    __device__ __forceinline__ void a_ready(const Unit&) const {}
    __device__ __forceinline__ void done(const Unit&) const {}
};

__device__ __forceinline__ unsigned cvt_pk_bf16(float lo, float hi) { unsigned r; asm volatile("v_cvt_pk_bf16_f32 %0, %1, %2" : "=v"(r) : "v"(lo), "v"(hi)); return r; }
typedef unsigned u32x2 __attribute__((ext_vector_type(2)));

struct CmpOrder {
    int G, c;
    __device__ bool next(int i, Unit& u) const { const int L = i * G + c; if (L >= 544) return false; u.pm = L; u.pn = L >= 272 ? 1 : 0; return true; }
    __device__ __forceinline__ void a_ready(const Unit&) const {}
    __device__ __forceinline__ void done(const Unit&) const {}
};

struct EpiIn {
    static constexpr bool PERM = false, AFTER_DRAIN = false;
    bf16_t* ZX; float* DT; float* pconv; float* sconv;
    __device__ __forceinline__ void operator()(const f32x4 (&acc)[2][2][4][2], const Unit& u, int wr, int wc, int fr, int fq) const {
        const int colt = u.pn * BM + wc * 32 + 4 * fq;
#pragma unroll
        for (int ai = 0; ai < 2; ++ai)
#pragma unroll
            for (int m = 0; m < 4; ++m) {
                const int row = u.pm * BM + ai * HALF + wr * 64 + m * 16 + fr;
                float* cptr = nullptr;
                if (row < cfg::MP) { const int t = row & 2047; if (t >= 2045) cptr = pconv + (size_t)((row >> 11) * 3 + (t - 2045)) * cfg::CONVD; }
                else { const int sr = row - cfg::MP, t = sr & 7; if (t >= 5) cptr = sconv + (size_t)((sr >> 3) * 3 + (t - 5)) * cfg::CONVD; }
#pragma unroll
                for (int bj = 0; bj < 2; ++bj)
#pragma unroll
                    for (int n = 0; n < 2; ++n) {
                        const int col = colt + bj * HALF + n * 16; const f32x4 v = acc[ai][bj][m][n];
                        if (col < cfg::ZXW) {
                            u32x2 w; w.x = cvt_pk_bf16(v[0], v[1]); w.y = cvt_pk_bf16(v[2], v[3]);
                            *(u32x2*)(ZX + (size_t)row * cfg::ZXW + col) = w;
                            if (cptr && col >= cfg::DIN) *(f32x4*)(cptr + (col - cfg::DIN)) = v;
                        } else if (col < cfg::INDIM) *(f32x4*)(DT + (size_t)row * 32 + (col - cfg::ZXW)) = v;
                    }
            }
    }
};
struct EpiRes {
    static constexpr bool PERM = false, AFTER_DRAIN = false;
    float* out; const float* resA; const float* resB;
    __device__ __forceinline__ void operator()(const f32x4 (&acc)[2][2][4][2], const Unit& u, int wr, int wc, int fr, int fq) const {
        const int colt = u.pn * BM + wc * 32 + 4 * fq;
#pragma unroll
        for (int ai = 0; ai < 2; ++ai)
#pragma unroll
            for (int m = 0; m < 4; ++m) {
                const int row = u.pm * BM + ai * HALF + wr * 64 + m * 16 + fr;
                const float* rp = (row < cfg::MP ? resA : resB) + (size_t)row * cfg::DM + colt; float* op = out + (size_t)row * cfg::DM + colt;
#pragma unroll
                for (int bj = 0; bj < 2; ++bj)
#pragma unroll
                    for (int n = 0; n < 2; ++n) { const f32x4 r = *(const f32x4*)(rp + bj * HALF + n * 16); *(f32x4*)(op + bj * HALF + n * 16) = acc[ai][bj][m][n] + r * cfg::ALPHA; }
            }
    }
};
struct EpiRelu2 {
    static constexpr bool PERM = true, AFTER_DRAIN = false;
    bf16_t* O;
    __device__ __forceinline__ void operator()(const f32x4 (&acc)[2][2][4][2], const Unit& u, int wr, int wc, int fr, int fq) const {
        const int col0 = u.pn * BM + wc * 32 + 8 * fq;
#pragma unroll
        for (int ai = 0; ai < 2; ++ai)
#pragma unroll
            for (int m = 0; m < 4; ++m) { bf16_t* rowp = O + (size_t)(u.pm * BM + ai * HALF + wr * 64 + m * 16 + fr) * cfg::DFF + col0;
#pragma unroll
                for (int bj = 0; bj < 2; ++bj) { f32x4 v0 = acc[ai][bj][m][0], v1 = acc[ai][bj][m][1];
#pragma unroll
                    for (int j = 0; j < 4; ++j) { const float a = fmaxf(v0[j], 0.f), b = fmaxf(v1[j], 0.f); v0[j] = a * a; v1[j] = b * b; }
                    u32x4 w; w.x = cvt_pk_bf16(v0[0], v0[1]); w.y = cvt_pk_bf16(v0[2], v0[3]); w.z = cvt_pk_bf16(v1[0], v1[1]); w.w = cvt_pk_bf16(v1[2], v1[3]);
                    *(u32x4*)(rowp + bj * HALF) = w; } }
    }
};
struct EpiKvq {
    static constexpr bool PERM = false, AFTER_DRAIN = false;
    float* out; bf16_t* KVB; bf16_t* QB; float* GATES; bf16_t* ACMP;
    __device__ __forceinline__ void operator()(const f32x4 (&acc)[2][2][4][2], const Unit& u, int wr, int wc, int fr, int fq) const {
        const int colt = u.pn * BM + wc * 32 + 4 * fq;
#pragma unroll
        for (int ai = 0; ai < 2; ++ai)
#pragma unroll
            for (int m = 0; m < 4; ++m) {
                const int row = u.pm * BM + ai * HALF + wr * 64 + m * 16 + fr;
                const bool prompt = row < cfg::MP; const int sr = row - cfg::MP;
                const int b = prompt ? (row >> 11) : (sr >> 3), t = prompt ? (row & 2047) : (sr & 7);
#pragma unroll
                for (int bj = 0; bj < 2; ++bj)
#pragma unroll
                    for (int n = 0; n < 2; ++n) {
                        const int col = colt + bj * HALF + n * 16; const f32x4 v = acc[ai][bj][m][n];
                        if (col < cfg::KVW) {
                            const int br = col >> 9, cc = col & 511;
                            float* dst = nullptr;
                            if (prompt) { if (br == 0) dst = out + cfg::O_PCMP + (size_t)row * 512 + cc; else if (br == 1) dst = out + cfg::O_PSEL + (size_t)row * 512 + cc;
                                          else if (t >= 1536) dst = out + cfg::O_PWIN + (size_t)(b * 512 + t - 1536) * 512 + cc; }
                            else { if (br == 0) dst = out + cfg::O_SCMP + (size_t)sr * 512 + cc; else if (br == 1) dst = out + cfg::O_SSEL + (size_t)sr * 512 + cc;
                                   else dst = out + cfg::O_SWIN + (size_t)(b * 512 + 504 + t) * 512 + cc; }
                            if (dst) *(f32x4*)dst = v;
                            u32x2 w; w.x = cvt_pk_bf16(v[0], v[1]); w.y = cvt_pk_bf16(v[2], v[3]);
                            *(u32x2*)(KVB + (size_t)row * cfg::KVW + col) = w;
                            if (prompt && br == 0) { const int kv = cc >> 8, g = (cc >> 6) & 3, d = cc & 63;
                                *(u32x2*)(ACMP + ((size_t)kv * cfg::NCMPROWS + 65536 + (size_t)(b * 4 + g) * 128 + (t >> 4)) * 1024 + (t & 15) * 64 + d) = w; }
                        } else if (col < cfg::KVW + 1024) {
                            u32x2 w; w.x = cvt_pk_bf16(v[0] * cfg::QSCALE, v[1] * cfg::QSCALE); w.y = cvt_pk_bf16(v[2] * cfg::QSCALE, v[3] * cfg::QSCALE);
                            *(u32x2*)(QB + (size_t)row * cfg::DM + (col - cfg::KVW)) = w;
                        } else if (col < cfg::KVW + cfg::QGW) {
                            f32x4 s;
#pragma unroll
                            for (int j = 0; j < 4; ++j) s[j] = 1.f / (1.f + __expf(-v[j]));
                            *(f32x4*)(GATES + (size_t)row * 48 + (col - cfg::KVW - 1024)) = s;
                        }
                    }
            }
    }
};
struct EpiP {
    static constexpr bool PERM = false, AFTER_DRAIN = false;
    float* P;
    __device__ __forceinline__ void operator()(const f32x4 (&acc)[2][2][4][2], const Unit& u, int wr, int wc, int fr, int fq) const {
        const int colt = wc * 32 + 4 * fq;
#pragma unroll
        for (int ai = 0; ai < 2; ++ai)
#pragma unroll
            for (int m = 0; m < 4; ++m) { float* op = P + (size_t)(u.pm * BM + ai * HALF + wr * 64 + m * 16 + fr) * 256 + colt;
#pragma unroll
                for (int bj = 0; bj < 2; ++bj)
#pragma unroll
                    for (int n = 0; n < 2; ++n) *(f32x4*)(op + bj * HALF + n * 16) = acc[ai][bj][m][n]; }
    }
};

template <class Epi, class Sched, bool ALIGN_EPI = false, bool SP2 = false>
__device__ __forceinline__ void gemm_phase(PG8_LAS unsigned char* lds, const Gemm g, const Sched& S, const Epi& E) {
    const int tid = threadIdx.x, wid = __builtin_amdgcn_readfirstlane(tid >> 6), lane = tid & 63, wr = wid >> 2, wc = wid & 3, fr = lane & 15, fq = lane >> 4;
    const int K = g.K, nt = K / BK;
    unsigned voffA[2], voffB[2];
#pragma unroll
    for (int i = 0; i < 2; ++i) { int R, C; stage_rc(tid * 16 + i * 8192, R, C); const int Rb = Epi::PERM ? ((R & ~31) + perm32(R & 31)) : R;
        voffA[i] = (unsigned)(R * K + C) * 2u; voffB[i] = (unsigned)(Rb * K + C) * 2u; }
    const size_t kstep = (size_t)(BK * 2);
    const size_t hstep = (size_t)HALF * K * 2;
    const size_t tstep = 2 * hstep;
    const unsigned ldsw = (unsigned)wid * 1024u;
    const int aoff = lds_byte(wr * 64 + fr, fq * 8), boff = lds_byte(wc * 32 + fr, fq * 8);
#define PG8_SA(b, h) (((b) * 2 + (h)) * HTB)
#define PG8_SB(b, h) ((4 + (b) * 2 + (h)) * HTB)
#define PG8_STAGE(bufoff, gbase, voff) do { _Pragma("unroll") for (int _i = 0; _i < 2; ++_i) \
        __builtin_amdgcn_global_load_lds((const unsigned*)((const char*)(gbase) + (voff)[_i]), (PG8_LAS unsigned*)(lds + (bufoff) + ldsw + _i * 8192), 16, 0, 0); } while (0)
#define PG8_LDA(dst, b, h) do { _Pragma("unroll") for (int m = 0; m < 4; ++m) _Pragma("unroll") for (int k = 0; k < 2; ++k) dst[m][k] = *(const PG8_LAS bf16x8*)(lds + PG8_SA(b, h) + aoff + m * 2048 + k * 1024); } while (0)
#define PG8_LDB(dst, b, h) do { _Pragma("unroll") for (int n = 0; n < 2; ++n) _Pragma("unroll") for (int k = 0; k < 2; ++k) dst[n][k] = *(const PG8_LAS bf16x8*)(lds + PG8_SB(b, h) + boff + n * 2048 + k * 1024); } while (0)
#define PG8_MMA(ai, bj, At, Bt) do { __builtin_amdgcn_s_setprio(1); _Pragma("unroll") for (int m = 0; m < 4; ++m) _Pragma("unroll") for (int n = 0; n < 2; ++n) _Pragma("unroll") for (int k = 0; k < 2; ++k) \
        acc[ai][bj][m][n] = __builtin_amdgcn_mfma_f32_16x16x32_bf16(Bt[n][k], At[m][k], acc[ai][bj][m][n], 0, 0, 0); __builtin_amdgcn_s_setprio(0); } while (0)
#define PG8_WAIT_V(n) asm volatile("s_waitcnt vmcnt(" #n ")" ::: "memory")
#define PG8_WAIT_L(n) asm volatile("s_waitcnt lgkmcnt(" #n ")" ::: "memory")
#define PG8_BAR __builtin_amdgcn_s_barrier()
#define PG8_SCHED __builtin_amdgcn_sched_barrier(0)
    Unit cur, nxt; int ui = 0;
    if (!S.next(0, cur)) return;
    f32x4 acc[2][2][4][2];
#pragma unroll
    for (int a = 0; a < 2; ++a)
#pragma unroll
        for (int b = 0; b < 2; ++b)
#pragma unroll
            for (int m = 0; m < 4; ++m)
#pragma unroll
                for (int n = 0; n < 2; ++n) acc[a][b][m][n] = (f32x4){0.f, 0.f, 0.f, 0.f};
    bf16x8 At[4][2], B0[2][2], B1[2][2];
    const char* cA = (const char*)g.A + (size_t)cur.pm * tstep; const char* cB = (const char*)g.Bt + (size_t)cur.pn * tstep;
    S.a_ready(cur);
    if constexpr (SP2) {
        PG8_STAGE(PG8_SB(0, 0), cB, voffB); PG8_STAGE(PG8_SB(0, 1), cB + hstep, voffB); PG8_STAGE(PG8_SA(0, 0), cA, voffA); PG8_STAGE(PG8_SA(0, 1), cA + hstep, voffA);
        if (wr == 1) PG8_BAR;
        PG8_WAIT_V(2); PG8_BAR;
        PG8_STAGE(PG8_SB(1, 0), cB + kstep, voffB); PG8_STAGE(PG8_SA(1, 0), cA + kstep, voffA); PG8_STAGE(PG8_SB(1, 1), cB + hstep + kstep, voffB);
        PG8_WAIT_V(6); PG8_BAR;
    } else {
        PG8_STAGE(PG8_SB(0, 0), cB, voffB); PG8_STAGE(PG8_SA(0, 0), cA, voffA); PG8_STAGE(PG8_SB(0, 1), cB + hstep, voffB); PG8_STAGE(PG8_SA(0, 1), cA + hstep, voffA);
        if (wr == 1) PG8_BAR;
        PG8_WAIT_V(4); PG8_BAR;
        PG8_STAGE(PG8_SB(1, 0), cB + kstep, voffB); PG8_STAGE(PG8_SA(1, 0), cA + kstep, voffA); PG8_STAGE(PG8_SB(1, 1), cB + hstep + kstep, voffB);
        PG8_WAIT_V(6); PG8_BAR;
    }
    for (;;) {
        const bool has_next = S.next(ui + 1, nxt);
        const char* nA = has_next ? (const char*)g.A + (size_t)nxt.pm * tstep : cA; const char* nB = has_next ? (const char*)g.Bt + (size_t)nxt.pn * tstep : cB;
        for (int t = 0; t < nt; t += 2) {
            const bool last = (t == nt - 2);
            const char* a1 = cA + (size_t)(t + 1) * kstep;
            const char* a2 = last ? nA : cA + (size_t)(t + 2) * kstep; const char* b2 = last ? nB : cB + (size_t)(t + 2) * kstep;
            const char* a3 = a2 + kstep; const char* b3 = b2 + kstep;
            if (last && has_next) S.a_ready(nxt);
            if constexpr (SP2) {
            PG8_LDB(B0, 0, 0); PG8_LDB(B1, 0, 1); PG8_SCHED; PG8_LDA(At, 0, 0); PG8_STAGE(PG8_SA(1, 1), a1 + hstep, voffA);
            PG8_WAIT_V(8); PG8_WAIT_L(0); PG8_BAR; PG8_MMA(0, 0, At, B0); PG8_MMA(0, 1, At, B1); PG8_BAR; PG8_SCHED;
            PG8_LDA(At, 0, 1); PG8_STAGE(PG8_SB(0, 0), b2, voffB); PG8_STAGE(PG8_SB(0, 1), b2 + hstep, voffB); PG8_STAGE(PG8_SA(0, 0), a2, voffA);
            PG8_WAIT_V(8); PG8_WAIT_L(0); PG8_BAR; PG8_MMA(1, 0, At, B0); PG8_MMA(1, 1, At, B1); PG8_BAR; PG8_SCHED;
            PG8_LDB(B0, 1, 0); PG8_LDB(B1, 1, 1); PG8_SCHED; PG8_LDA(At, 1, 0); PG8_STAGE(PG8_SA(0, 1), a2 + hstep, voffA);
            PG8_WAIT_V(8); PG8_WAIT_L(0); PG8_BAR; PG8_MMA(0, 0, At, B0); PG8_MMA(0, 1, At, B1); PG8_BAR; PG8_SCHED;
            PG8_LDA(At, 1, 1); PG8_STAGE(PG8_SB(1, 0), b3, voffB); PG8_STAGE(PG8_SB(1, 1), b3 + hstep, voffB); PG8_STAGE(PG8_SA(1, 0), a3, voffA);
            PG8_WAIT_V(8); PG8_WAIT_L(0); PG8_BAR; PG8_MMA(1, 0, At, B0); PG8_MMA(1, 1, At, B1); PG8_BAR; PG8_SCHED;
            } else {
            PG8_LDB(B0, 0, 0); PG8_SCHED; PG8_LDA(At, 0, 0); PG8_STAGE(PG8_SA(1, 1), a1 + hstep, voffA);
            PG8_WAIT_L(8); PG8_BAR; PG8_WAIT_L(0); PG8_MMA(0, 0, At, B0); PG8_BAR; PG8_SCHED;
            PG8_LDB(B1, 0, 1); PG8_STAGE(PG8_SB(0, 0), b2, voffB);
            PG8_BAR; PG8_WAIT_L(0); PG8_MMA(0, 1, At, B1); PG8_BAR;
            PG8_LDA(At, 0, 1); PG8_STAGE(PG8_SA(0, 0), a2, voffA);
            PG8_BAR; PG8_WAIT_L(0); PG8_MMA(1, 0, At, B0); PG8_BAR; PG8_SCHED;
            PG8_STAGE(PG8_SB(0, 1), b2 + hstep, voffB);
            PG8_WAIT_V(6); PG8_BAR; PG8_MMA(1, 1, At, B1); PG8_BAR;
            PG8_LDB(B0, 1, 0); PG8_SCHED; PG8_LDA(At, 1, 0); PG8_STAGE(PG8_SA(0, 1), a2 + hstep, voffA);
            PG8_WAIT_L(8); PG8_BAR; PG8_WAIT_L(0); PG8_MMA(0, 0, At, B0); PG8_BAR; PG8_SCHED;
            PG8_LDB(B1, 1, 1); PG8_STAGE(PG8_SB(1, 0), b3, voffB);
            PG8_BAR; PG8_WAIT_L(0); PG8_MMA(0, 1, At, B1); PG8_BAR;
            PG8_LDA(At, 1, 1); PG8_STAGE(PG8_SA(1, 0), a3, voffA);
            PG8_BAR; PG8_WAIT_L(0); PG8_MMA(1, 0, At, B0); PG8_BAR; PG8_SCHED;
            PG8_STAGE(PG8_SB(1, 1), b3 + hstep, voffB);
            PG8_WAIT_V(6); PG8_BAR; PG8_MMA(1, 1, At, B1); PG8_BAR;
            }
        }
        if constexpr (ALIGN_EPI) { if (wr == 0) PG8_BAR; }
        if constexpr (!Epi::AFTER_DRAIN) { E(acc, cur, wr, wc, fr, fq); S.done(cur); }
        if (!has_next) break;
#pragma unroll
        for (int a = 0; a < 2; ++a)
#pragma unroll
            for (int b = 0; b < 2; ++b)
#pragma unroll
                for (int m = 0; m < 4; ++m)
#pragma unroll
                    for (int n = 0; n < 2; ++n) acc[a][b][m][n] = (f32x4){0.f, 0.f, 0.f, 0.f};
        cur = nxt; cA = nA; cB = nB; ++ui;
        if constexpr (ALIGN_EPI) { if (wr == 1) PG8_BAR; }
    }
    PG8_WAIT_V(0);
    if constexpr (!ALIGN_EPI) { if (wr == 0) PG8_BAR; }
    PG8_BAR;
    if constexpr (Epi::AFTER_DRAIN) { E.fused(acc, cur, wr, wc, fr, fq, lds, wid, lane); S.done(cur); }
#undef PG8_SA
#undef PG8_SB
#undef PG8_STAGE
#undef PG8_LDA
#undef PG8_LDB
#undef PG8_MMA
#undef PG8_WAIT_V
#undef PG8_WAIT_L
#undef PG8_BAR
#undef PG8_SCHED
}
}
#define XB_TMO      128
#define XB_XCNT(j)  (256  + 64 * (j))
#define XB_XSUB(j)  (1280 + 64 * (j))
#define XB_XGEN(j)  (2304 + 64 * (j))
#define XB_TOP      3328
#define XB_TOPGEN   3392
#define XCD_BAR_WORDS 3456
#define XB_SPIN_CAP (1u << 18)

__device__ __forceinline__ unsigned xb_ld(unsigned* p)              { return __hip_atomic_load(p, __ATOMIC_RELAXED, __HIP_MEMORY_SCOPE_AGENT); }
__device__ __forceinline__ unsigned xb_add(unsigned* p, unsigned v) { return __hip_atomic_fetch_add(p, v, __ATOMIC_RELAXED, __HIP_MEMORY_SCOPE_AGENT); }
__device__ __forceinline__ unsigned xb_xcc_id() { return (unsigned)__builtin_amdgcn_s_getreg((3 << 11) | 20) & 0xFu; }
#define XB_SPIN(cond, bar) do { unsigned _sp = 0; while (cond) { __builtin_amdgcn_s_sleep(1); \
    if ((++_sp & 255u) == 0u) { if (xb_ld(&(bar)[XB_TMO])) break; if (_sp > XB_SPIN_CAP) { atomicAdd(&(bar)[XB_TMO], 1u); break; } } } } while (0)

struct XcdBarrier {
    unsigned* bar; unsigned x;
    volatile LAS unsigned* st;
};

__device__ __forceinline__ XcdBarrier xcd_barrier_post(unsigned* bar, volatile LAS unsigned* st) {
    XcdBarrier b; b.bar = bar; b.x = xb_xcc_id(); b.st = st;
    if (threadIdx.x == 0) (void)xb_add(&bar[XB_XCNT(b.x)], 1u);
    return b;
}
__device__ __forceinline__ void xcd_barrier_complete(unsigned* bar, unsigned x, unsigned& nloc, unsigned& nx) {
    const unsigned G = gridDim.x * gridDim.y * gridDim.z;
    unsigned sum, cnt, mine, sp = 0u;
    for (;;) {
        sum = 0u; cnt = 0u; mine = 0u;
#pragma unroll
        for (unsigned j = 0; j < 16; ++j) { const unsigned c = xb_ld(&bar[XB_XCNT(j)]); sum += c; cnt += (c > 0u) ? 1u : 0u; mine = (j == x) ? c : mine; }
        if (sum == G) break;
        __builtin_amdgcn_s_sleep(1);
        if ((++sp & 255u) == 0u) { if (xb_ld(&bar[XB_TMO])) break; if (sp > XB_SPIN_CAP) { atomicAdd(&bar[XB_TMO], 1u); break; } }
    }
    nloc = mine > 0u ? mine : 1u; nx = cnt > 0u ? cnt : 1u;
}

__device__ __forceinline__ void xcd_barrier(const XcdBarrier& b) {
    asm volatile("s_waitcnt vmcnt(0)" ::: "memory");
    __syncthreads();
    if (threadIdx.x == 0) {
        unsigned* bar = b.bar;
        __builtin_amdgcn_s_waitcnt(0);
        unsigned nloc = b.st[0], nx = b.st[1];
        if (nloc == 0u) { xcd_barrier_complete(bar, b.x, nloc, nx); b.st[0] = nloc; b.st[1] = nx; }
        const unsigned old = xb_add(&bar[XB_XSUB(b.x)], 1u);
        const unsigned gen = old / nloc;
        if (old + 1u == (gen + 1u) * nloc) {
            __builtin_amdgcn_fence(__ATOMIC_RELEASE, "agent");
            asm volatile("s_waitcnt vmcnt(0)" ::: "memory");
            const unsigned og = xb_add(&bar[XB_TOP], 1u);
            const unsigned tg = og / nx;
            if (og + 1u == (tg + 1u) * nx) xb_add(&bar[XB_TOPGEN], 1u);
            else XB_SPIN(xb_ld(&bar[XB_TOPGEN]) == tg, bar);
            __builtin_amdgcn_fence(__ATOMIC_ACQUIRE, "agent");
            xb_add(&bar[XB_XGEN(b.x)], 1u);
            asm volatile("s_waitcnt vmcnt(0)" ::: "memory");
        } else {
            XB_SPIN(xb_ld(&bar[XB_XGEN(b.x)]) == gen, bar);
            __builtin_amdgcn_fence(__ATOMIC_ACQUIRE, "agent");
            asm volatile("s_waitcnt vmcnt(0)" ::: "memory");
        }
    }
    __syncthreads();
}

constexpr int NWAVES = 8, NTHR = 512;
#ifndef PROBE_REPS
#define PROBE_REPS {1,1,1,1,1,1,1,1,1,1,1,1,1,1,1,1,1,1,1,1,1,1,1}
#endif
constexpr int probe_reps_[23] = PROBE_REPS;
__device__ __forceinline__ constexpr int probe_rep(int k) { return probe_reps_[k]; }
__device__ __forceinline__ float wave_sum(float v) {
#pragma unroll
    for (int o = 1; o < 64; o <<= 1) v += __shfl_xor(v, o);
    return v;
}
__device__ __forceinline__ float silu_f(float v) { return v / (1.f + __expf(-v)); }

__device__ __forceinline__ void tr_item(const float* __restrict__ W, int N, bf16* WT, int ldk, int row_off, const float* __restrict__ kscale, LAS float* scr, int item, int lane) {
    const int nblk = (N + 31) >> 5, kb = item / nblk, nb = item - kb * nblk, k0 = 64 * kb, n0 = 32 * nb;
    const int nn = n0 + (lane & 31);
#pragma unroll 8
    for (int i = 0; i < 32; ++i) { const int kk = 2 * i + (lane >> 5); float v = (nn < N) ? W[(size_t)(k0 + kk) * N + nn] : 0.f; if (kscale) v *= kscale[k0 + kk]; scr[kk * 33 + (lane & 31)] = v; }
    LDS_WAIT();
    const int c = lane & 7;
#pragma unroll
    for (int j = 0; j < 4; ++j) { const int n = (lane >> 3) + 8 * j; const LAS float* s = scr + (8 * c) * 33 + n;
        v4u o; o.x = pk2(s[0 * 33], s[1 * 33]); o.y = pk2(s[2 * 33], s[3 * 33]); o.z = pk2(s[4 * 33], s[5 * 33]); o.w = pk2(s[6 * 33], s[7 * 33]);
        if (n0 + n < N) *(v4u*)(WT + (size_t)(row_off + n0 + n) * ldk + k0 + 8 * c) = o; }
    LDS_WAIT();
}

struct Args {
    const float* x_prompt; const float* x_sample; const float* state_ssm; const float* state_conv; const float* cache_cmp; const float* cache_sel; const float* cache_win; const int* page_table;
    const float* ln_g; const float* ln_b; const float* m_in_w; const float* m_conv_w; const float* m_conv_b; const float* m_dt_bias; const float* m_a_log; const float* m_d; const float* m_norm_w; const float* m_out_w;
    const float* kv_w; const float* cmp_w1; const float* cmp_pe; const float* cmp_w2; const float* q_w; const float* o_w; const float* rel_bias; const float* mlp_w1; const float* mlp_w2;
    float* out; unsigned char* ws; int ph_lo, ph_hi, li, pad;
};

__device__ __forceinline__ void p0_prologue(const Args& a, LAS unsigned char* lds, int G) {
    using namespace cfg;
    const int tid = threadIdx.x, lane = tid & 63, wave = tid >> 6;
    LAS float* scr = (LAS float*)(lds + wave * 16384);
    unsigned char* ws = a.ws;
    const int gw = blockIdx.x * NWAVES + wave, NGW = G * NWAVES;
    constexpr int I_IN = 16 * 161, I_OUT = 32 * 32, I_W1 = 16 * 128, I_W2 = 64 * 32, I_KV = 16 * 48, I_Q = 16 * 34, I_O = 16 * 32, I_C = 16 * 4;
    constexpr int NIT = I_IN + I_OUT + 2 * I_W1 + 2 * I_W2 + I_KV + I_Q + I_O + 4 * I_C;
    for (int it = gw; it < NIT; it += NGW) {
        int r = it;
        if (r < I_IN) { tr_item(a.m_in_w, INDIM, (bf16*)(ws + WS_WIN), DM, 0, nullptr, scr, r, lane); continue; } r -= I_IN;
        if (r < I_OUT) { tr_item(a.m_out_w, DM, (bf16*)(ws + WS_WOUT), DIN, 0, a.m_norm_w, scr, r, lane); continue; } r -= I_OUT;
        if (r < 2 * I_W1) { const int l = r / I_W1; tr_item(a.mlp_w1 + (size_t)l * DM * DFF, DFF, (bf16*)(ws + WS_W1) + (size_t)l * DFF * DM, DM, 0, nullptr, scr, r - l * I_W1, lane); continue; } r -= 2 * I_W1;
        if (r < 2 * I_W2) { const int l = r / I_W2; tr_item(a.mlp_w2 + (size_t)l * DM * DFF, DM, (bf16*)(ws + WS_W2) + (size_t)l * DFF * DM, DFF, 0, nullptr, scr, r - l * I_W2, lane); continue; } r -= 2 * I_W2;
        if (r < I_KV) { tr_item(a.kv_w, KVW, (bf16*)(ws + WS_WKVQ), DM, 0, nullptr, scr, r, lane); continue; } r -= I_KV;
        if (r < I_Q) { tr_item(a.q_w, QGW, (bf16*)(ws + WS_WKVQ), DM, KVW, nullptr, scr, r, lane); continue; } r -= I_Q;
        if (r < I_O) { tr_item(a.o_w, DM, (bf16*)(ws + WS_WO), DM, 0, nullptr, scr, r, lane); continue; } r -= I_O;
        { const int q = r / I_C; tr_item(a.cmp_w1 + (size_t)q * 1024 * 128, 128, (bf16*)(ws + WS_WC1), 1024, q * 128, nullptr, scr, r - q * I_C, lane); }
    }
    const size_t gt = (size_t)blockIdx.x * NTHR + tid, NT = (size_t)G * NTHR;
    { v4u z = {0u, 0u, 0u, 0u};
      v4u* p1 = (v4u*)((bf16*)(ws + WS_WIN) + (size_t)INDIM * DM); for (size_t i = gt; i < (size_t)(INPAD - INDIM) * DM / 8; i += NT) p1[i] = z;
      v4u* p2 = (v4u*)((bf16*)(ws + WS_WKVQ) + (size_t)(KVW + QGW) * DM); for (size_t i = gt; i < (size_t)(KVQN - KVW - QGW) * DM / 8; i += NT) p2[i] = z; }
    { v4u* xb = (v4u*)(ws + WS_XB);
      for (size_t i = gt; i < (size_t)M * DM / 8; i += NT) { const size_t e = i * 8; const float* src = e < (size_t)MP * DM ? a.x_prompt + e : a.x_sample + (e - (size_t)MP * DM);
          const f32x4 v0 = *(const f32x4*)src, v1 = *(const f32x4*)(src + 4); v4u o; o.x = pk2(v0[0], v0[1]); o.y = pk2(v0[2], v0[3]); o.z = pk2(v1[0], v1[1]); o.w = pk2(v1[2], v1[3]); xb[i] = o; } }
    { float* pec = (float*)(ws + WS_PEC);
      for (size_t i = gt; i < 32 * 256; i += NT) { const int sl = (int)(i >> 8), kve = (int)(i & 255), kv = kve >> 7, e = kve & 127; float s = 0.f;
          for (int k = 64 * sl; k < 64 * sl + 64; ++k) s += a.cmp_pe[(size_t)kv * 2048 + k] * a.cmp_w1[((size_t)kv * 2048 + k) * 128 + e];
          pec[i] = s; } }
}

__device__ __forceinline__ void fill_acmp(const Args& a, int vb, int NB, size_t i0, size_t i1) {
    using namespace cfg;
    bf16* ac = (bf16*)(a.ws + WS_ACMP);
    for (size_t i = i0 + (size_t)vb * NTHR + threadIdx.x; i < i1; i += (size_t)NB * NTHR) { const int ch = (int)(i & 63); const size_t tok = i >> 6; const int b = (int)(tok >> 11), t = (int)(tok & 2047);
        const int page = a.page_table[b * NPAGE + (t >> 7)]; const float* src = a.cache_cmp + ((size_t)page * PAGE + (t & 127)) * 512 + ch * 8;
        const f32x4 v0 = *(const f32x4*)src, v1 = *(const f32x4*)(src + 4); v4u o; o.x = pk2(v0[0], v0[1]); o.y = pk2(v0[2], v0[3]); o.z = pk2(v1[0], v1[1]); o.w = pk2(v1[2], v1[3]);
        const int kv = ch >> 5, g = (ch >> 3) & 3, d0 = (ch & 7) * 8;
        *(v4u*)(ac + ((size_t)kv * NCMPROWS + (size_t)(b * 4 + g) * 128 + (t >> 4)) * 1024 + (t & 15) * 64 + d0) = o; }
}
__device__ __forceinline__ void fill_swin(const Args& a, int vb, int NB) {
    using namespace cfg;
    f32x4* dst = (f32x4*)(a.out + O_SWIN); const f32x4* src = (const f32x4*)a.cache_win;
    for (size_t i = (size_t)vb * NTHR + threadIdx.x; i < (size_t)DB * 504 * 128; i += (size_t)NB * NTHR) { const size_t b = i / (504 * 128), r = i - b * (504 * 128); dst[b * 512 * 128 + r] = src[b * 512 * 128 + 8 * 128 + r]; }
}
constexpr size_t ACMP_ITEMS = (size_t)cfg::DB * cfg::PAST * 64, ACMP_SPLIT = ACMP_ITEMS / 3;

__device__ __forceinline__ void scan_phase(const Args& a, LAS unsigned char* lds, int G) {
    using namespace cfg;
    const int tid = threadIdx.x, lane = tid & 63, wave = tid >> 6, p = tid >> 3, nq = tid & 7;
    LAS float* cv = (LAS float*)lds;
    LAS float* dts = cv + 16 * 320;
    LAS float* dAs = dts + 16;
    LAS float* ygs = dAs + 16;
    const bf16* ZX = (const bf16*)(a.ws + WS_ZX); const float* DT = (const float*)(a.ws + WS_DT);
    bf16* YG = (bf16*)(a.ws + WS_YG); float* SSQ = (float*)(a.ws + WS_SSQ);
    for (int u = blockIdx.x; u < NPB * NH + DB * NH; u += G) {
        const bool prompt = u < NPB * NH; const int su = prompt ? u : u - NPB * NH; const int b = su >> 5, hd = su & 31, g = hd >> 3;
        const int L = prompt ? SEQ : DS; const int row0 = prompt ? b * SEQ : MP + b * DS;
        float h[16];
        float* sdst = a.out + (prompt ? O_PSSM : O_SSSM) + ((size_t)(b * NH + hd) * HD + p) * DST + nq * 16;
        if (prompt) {
#pragma unroll
            for (int i = 0; i < 16; ++i) h[i] = 0.f;
        } else { const float* s0 = a.state_ssm + ((size_t)(b * NH + hd) * HD + p) * DST + nq * 16;
#pragma unroll
            for (int i4 = 0; i4 < 4; ++i4) { const f32x4 v = *(const f32x4*)(s0 + 4 * i4); h[4 * i4] = v[0]; h[4 * i4 + 1] = v[1]; h[4 * i4 + 2] = v[2]; h[4 * i4 + 3] = v[3]; } }
        const float dtb = a.m_dt_bias[hd], Aneg = -__expf(a.m_a_log[hd]), Dh = a.m_d[hd];
        for (int t0 = 0; t0 < L; t0 += 16) {
            const int nt = (L - t0) < 16 ? (L - t0) : 16;
            __syncthreads();
            for (int idx = tid; idx < nt * 320; idx += NTHR) { const int tt = idx / 320, cl = idx - tt * 320;
                const int cx = cl < 64 ? hd * 64 + cl : (cl < 192 ? 2048 + g * 128 + (cl - 64) : 2560 + g * 128 + (cl - 192));
                float acc = a.m_conv_b[cx];
#pragma unroll
                for (int k = 0; k < 4; ++k) { const int t = t0 + tt - 3 + k;
                    const float xv = t >= 0 ? bf2f(ZX[(size_t)(row0 + t) * ZXW + DIN + cx]) : (prompt ? 0.f : a.state_conv[(size_t)(b * 3 + t + 3) * CONVD + cx]);
                    acc += a.m_conv_w[k * CONVD + cx] * xv; }
                cv[tt * 320 + cl] = silu_f(acc); }
            if (tid < nt) { const float dtr = DT[(size_t)(row0 + t0 + tid) * 32 + hd] + dtb; const float dtv = dtr > 20.f ? dtr : log1pf(__expf(dtr)); dts[tid] = dtv; dAs[tid] = __expf(dtv * Aneg); }
            __syncthreads();
            for (int tt = 0; tt < nt; ++tt) {
                const float x = cv[tt * 320 + p], dtv = dts[tt], dA = dAs[tt], xdt = x * dtv;
                const LAS f32x4* Bp = (const LAS f32x4*)(cv + tt * 320 + 64 + nq * 16); const LAS f32x4* Cp = (const LAS f32x4*)(cv + tt * 320 + 192 + nq * 16);
                float acc = 0.f;
#pragma unroll
                for (int i4 = 0; i4 < 4; ++i4) { const f32x4 Bv = Bp[i4], Cv = Cp[i4];
#pragma unroll
                    for (int j = 0; j < 4; ++j) { h[4 * i4 + j] = dA * h[4 * i4 + j] + xdt * Bv[j]; acc += h[4 * i4 + j] * Cv[j]; } }
                acc += __shfl_xor(acc, 1); acc += __shfl_xor(acc, 2); acc += __shfl_xor(acc, 4);
                if (nq == 0) { const float y = acc + Dh * x; const float z = bf2f(ZX[(size_t)(row0 + t0 + tt) * ZXW + hd * 64 + p]); ygs[tt * 64 + p] = y * silu_f(z); }
            }
            __syncthreads();
            for (int idx = tid; idx < nt * 32; idx += NTHR) { const int tt = idx >> 5, pp = (idx & 31) * 2;
                *(unsigned*)(YG + (size_t)(row0 + t0 + tt) * DIN + hd * 64 + pp) = pk2(ygs[tt * 64 + pp], ygs[tt * 64 + pp + 1]); }
            for (int tt = wave; tt < nt; tt += NWAVES) { const float v = ygs[tt * 64 + lane]; const float s = wave_sum(v * v); if (lane == 0) SSQ[(size_t)(row0 + t0 + tt) * 32 + hd] = s; }
        }
#pragma unroll
        for (int i4 = 0; i4 < 4; ++i4) { f32x4 v = {h[4 * i4], h[4 * i4 + 1], h[4 * i4 + 2], h[4 * i4 + 3]}; *(f32x4*)(sdst + 4 * i4) = v; }
    }
}

__device__ __forceinline__ void norm_phase(const Args& a, int G) {
    using namespace cfg;
    const bf16* YG = (const bf16*)(a.ws + WS_YG); const float* SSQ = (const float*)(a.ws + WS_SSQ); bf16* YN = (bf16*)(a.ws + WS_YN);
    const size_t gt = (size_t)blockIdx.x * NTHR + threadIdx.x, NT = (size_t)G * NTHR;
    for (size_t i = gt; i < (size_t)M * DIN / 8; i += NT) { const size_t row = i >> 8; const int c8 = (int)(i & 255), g = c8 >> 6;
        const f32x4 s0 = *(const f32x4*)(SSQ + row * 32 + g * 8), s1 = *(const f32x4*)(SSQ + row * 32 + g * 8 + 4);
        const float ms = ((s0[0] + s0[1]) + (s0[2] + s0[3]) + (s1[0] + s1[1]) + (s1[2] + s1[3])) * (1.f / 512.f);
        const float r = 1.f / sqrtf(ms + RMS_EPS);
        const v4u v = *(const v4u*)(YG + i * 8); v4u o;
        o.x = pk2(bflo(v.x) * r, bfhi(v.x) * r); o.y = pk2(bflo(v.y) * r, bfhi(v.y) * r); o.z = pk2(bflo(v.z) * r, bfhi(v.z) * r); o.w = pk2(bflo(v.w) * r, bfhi(v.w) * r);
        *(v4u*)(YN + i * 8) = o; }
}

__device__ __forceinline__ void ln_phase(const float* PRE, const float* gam, const float* bet, float* outF, bf16* outB, int G) {
    using namespace cfg;
    const int lane = threadIdx.x & 63, wave = threadIdx.x >> 6;
    f32x4 gv[4], bv[4];
#pragma unroll
    for (int j = 0; j < 4; ++j) { gv[j] = *(const f32x4*)(gam + 4 * lane + 256 * j); bv[j] = *(const f32x4*)(bet + 4 * lane + 256 * j); }
    for (int row = blockIdx.x * NWAVES + wave; row < M; row += G * NWAVES) {
        const float* xr = PRE + (size_t)row * DM + 4 * lane; f32x4 v[4]; float s = 0.f;
#pragma unroll
        for (int j = 0; j < 4; ++j) { v[j] = *(const f32x4*)(xr + 256 * j); s += (v[j][0] + v[j][1]) + (v[j][2] + v[j][3]); }
        const float mean = wave_sum(s) * (1.f / DM); float s2 = 0.f;
#pragma unroll
        for (int j = 0; j < 4; ++j) { v[j] = v[j] - mean; s2 += (v[j][0] * v[j][0] + v[j][1] * v[j][1]) + (v[j][2] * v[j][2] + v[j][3] * v[j][3]); }
        const float rstd = 1.f / sqrtf(wave_sum(s2) * (1.f / DM) + LN_EPS);
#pragma unroll
        for (int j = 0; j < 4; ++j) { const f32x4 o = v[j] * rstd * gv[j] + bv[j]; *(f32x4*)(outF + (size_t)row * DM + 4 * lane + 256 * j) = o;
            if (outB) { v2u w; w.x = pk2(o[0], o[1]); w.y = pk2(o[2], o[3]); *(v2u*)(outB + (size_t)row * DM + 4 * lane + 256 * j) = w; } }
    }
}

__device__ __forceinline__ void cmp2_phase(const Args& a, LAS unsigned char* lds, int G) {
    using namespace cfg;
    const int tid = threadIdx.x;
    LAS float* w2s = (LAS float*)lds;
    LAS float* pcs = w2s + 2 * 128 * 64;
    LAS float* hs = pcs + 256;
    const float* P = (const float*)(a.ws + WS_PCMP); const float* pec = (const float*)(a.ws + WS_PEC);
    for (int i = tid; i < 2 * 128 * 64; i += NTHR) w2s[i] = a.cmp_w2[i];
    if (tid < 256) { float s = 0.f; for (int sl = 0; sl < 32; ++sl) s += pec[sl * 256 + tid]; pcs[tid] = s; }
    __syncthreads();
    for (int u = blockIdx.x; u < 2 * NCMPROWS / 64; u += G) {
        const size_t r0 = (size_t)u * 64; const int kv = r0 >= (size_t)NCMPROWS ? 1 : 0;
        __syncthreads();
        for (int i = tid; i < 64 * 128; i += NTHR) { const int rl = i >> 7, e = i & 127; const size_t r = r0 + rl; const int c = (int)(r & 127);
            float hv = 0.f; if (c < 127) hv = silu_f(P[r * 256 + e] + P[(r + 1) * 256 + 128 + e] + pcs[kv * 128 + e]);
            hs[rl * 129 + e] = hv; }
        __syncthreads();
        const int rl = tid >> 3, dq = tid & 7; float o[8];
#pragma unroll
        for (int j = 0; j < 8; ++j) o[j] = 0.f;
        for (int e = 0; e < 128; ++e) { const float s = hs[rl * 129 + e]; const LAS f32x4* wp = (const LAS f32x4*)(w2s + (kv * 128 + e) * 64 + dq * 8); const f32x4 w0 = wp[0], w1 = wp[1];
            o[0] += s * w0[0]; o[1] += s * w0[1]; o[2] += s * w0[2]; o[3] += s * w0[3]; o[4] += s * w1[0]; o[5] += s * w1[1]; o[6] += s * w1[2]; o[7] += s * w1[3]; }
        bf16* dst = (bf16*)(a.ws + (kv ? WS_VC : WS_KC)) + ((r0 - (size_t)kv * NCMPROWS) + rl) * 64 + dq * 8;
        v4u w; w.x = pk2(o[0], o[1]); w.y = pk2(o[2], o[3]); w.z = pk2(o[4], o[5]); w.w = pk2(o[6], o[7]); *(v4u*)dst = w;
    }
}

__device__ __forceinline__ void ld16(const void* p, bool isf32, float (&o)[16]) {
    if (isf32) { const f32x4* q = (const f32x4*)p;
#pragma unroll
        for (int i = 0; i < 4; ++i) { const f32x4 v = q[i]; o[4 * i] = v[0]; o[4 * i + 1] = v[1]; o[4 * i + 2] = v[2]; o[4 * i + 3] = v[3]; } }
    else { const v4u* q = (const v4u*)p;
#pragma unroll
        for (int i = 0; i < 2; ++i) { const v4u v = q[i]; o[8 * i] = bflo(v.x); o[8 * i + 1] = bfhi(v.x); o[8 * i + 2] = bflo(v.y); o[8 * i + 3] = bfhi(v.y); o[8 * i + 4] = bflo(v.z); o[8 * i + 5] = bfhi(v.z); o[8 * i + 6] = bflo(v.w); o[8 * i + 7] = bfhi(v.w); } }
}
#define WSYNC() asm volatile("s_waitcnt lgkmcnt(0)" ::: "memory")

template <bool PROMPT>
__device__ __forceinline__ void attn_item(const Args& a, int b, int g, int tg, int lane, const LAS float* bt, LAS float* sc, LAS float* scoreL, LAS int* flagL) {
    using namespace cfg;
    const int tl = lane >> 4, hh = (lane >> 2) & 3, dq = lane & 3, rowl = lane >> 2;
    const int t = tg * 4 + tl, pos = PROMPT ? t : PAST + t, row = PROMPT ? b * SEQ + t : MP + b * DS + t, head = g * 4 + hh;
    const int posmax = (PROMPT ? 0 : PAST) + tg * 4 + 3, posmin = posmax - 3;
    const bf16* KVB = (const bf16*)(a.ws + WS_KVB);
    float q[16]; ld16((const bf16*)(a.ws + WS_QB) + (size_t)row * DM + head * 64 + dq * 16, false, q);
    const float* gp = (const float*)(a.ws + WS_GATES) + (size_t)row * 48 + head * 3; const float g0 = gp[0], g1 = gp[1], g2 = gp[2];
    const LAS float* btr = bt + head * 128;
    float out[16];
    {
        const size_t cb = ((size_t)((PROMPT ? DB + b : b) * 4 + g) * 128) * 64;
        const bf16* KCb = (const bf16*)(a.ws + WS_KC) + cb; const bf16* VCb = (const bf16*)(a.ws + WS_VC) + cb;
        int ncw = posmax >= 31 ? ((posmax - 31) >> 4) + 1 : 0; if (ncw > 127) ncw = 127;
        float m = -1e30f;
        for (int c = 0; c < ncw; ++c) { float k[16]; ld16(KCb + c * 64 + dq * 16, false, k); float s = 0.f;
#pragma unroll
            for (int i = 0; i < 16; ++i) s += q[i] * k[i];
            s += __shfl_xor(s, 1); s += __shfl_xor(s, 2);
            const int dist = pos - (16 * c + 31); s = dist >= 0 ? s + btr[dist < 127 ? dist : 127] : -1e30f;
            if (dq == 0) sc[rowl * 128 + c] = s; m = fmaxf(m, s); }
        WSYNC();
        float l = 0.f;
        for (int c = dq; c < ncw; c += 4) { const float s = sc[rowl * 128 + c]; const float e = s > -1e29f ? exp2f(s - m) : 0.f; sc[rowl * 128 + c] = e; l += e; }
        l += __shfl_xor(l, 1); l += __shfl_xor(l, 2);
        const float inv = l > 0.f ? 1.f / l : 0.f;
        WSYNC();
        float oc[16];
#pragma unroll
        for (int i = 0; i < 16; ++i) oc[i] = 0.f;
        for (int c = 0; c < ncw; ++c) { const float pv = sc[rowl * 128 + c] * inv; float v[16]; ld16(VCb + c * 64 + dq * 16, false, v);
#pragma unroll
            for (int i = 0; i < 16; ++i) oc[i] += pv * v[i]; }
        WSYNC();
        if (dq == 0) scoreL[144 + rowl] = inv;
        WSYNC();
        const int nsel = PROMPT ? 32 : 33, j = lane & 15, blk = pos >> 6;
        for (int s = j; s < nsel; s += 16) { float imp = 0.f;
#pragma unroll
            for (int h2 = 0; h2 < 4; ++h2) { const float iv = scoreL[144 + tl * 4 + h2]; float sm = 0.f;
#pragma unroll
                for (int c = 4 * s - 1; c <= 4 * s + 3; ++c) if (c >= 0 && c < ncw) sm += sc[(tl * 4 + h2) * 128 + c];
                imp += sm * iv; }
            const bool valid = s * 64 <= pos, forced = (s == 0) || (s == blk) || (s == blk - 1);
            scoreL[tl * 36 + s] = valid ? imp + (forced ? 1000.f : 0.f) : -1.f; }
        WSYNC();
        for (int s = j; s < nsel; s += 16) { const float my = scoreL[tl * 36 + s]; int rank = 0;
            for (int s2 = 0; s2 < nsel; ++s2) { const float o = scoreL[tl * 36 + s2]; rank += ((o > my) || (o == my && s2 < s)) ? 1 : 0; }
            flagL[tl * 36 + s] = rank < 16 ? 1 : 0; }
        WSYNC();
#pragma unroll
        for (int i = 0; i < 16; ++i) out[i] = g0 * oc[i];
    }
    {
        float ms = -1e30f, ls = 0.f, os[16];
#pragma unroll
        for (int i = 0; i < 16; ++i) os[i] = 0.f;
        const int nblk = (posmax >> 6) + 1;
        for (int s = 0; s < nblk; ++s) {
            const int fl = flagL[tl * 36 + s];
            if (!__any(fl)) continue;
            int kend = posmax - s * 64 + 1; if (kend > 64) kend = 64;
            for (int kk = 0; kk < kend; ++kk) { const int kpos = s * 64 + kk;
                const void* kp; const void* vp; bool f32src = false;
                if (PROMPT) { const bf16* r = KVB + (size_t)(b * SEQ + kpos) * KVW + 512 + g * 64 + dq * 16; kp = r; vp = r + 256; }
                else if (kpos < PAST) { const int page = a.page_table[b * NPAGE + (kpos >> 7)]; const float* r = a.cache_sel + ((size_t)page * PAGE + (kpos & 127)) * 512 + g * 64 + dq * 16; kp = r; vp = r + 256; f32src = true; }
                else { const bf16* r = KVB + (size_t)(MP + b * DS + kpos - PAST) * KVW + 512 + g * 64 + dq * 16; kp = r; vp = r + 256; }
                float k[16]; ld16(kp, f32src, k); float sd = 0.f;
#pragma unroll
                for (int i = 0; i < 16; ++i) sd += q[i] * k[i];
                sd += __shfl_xor(sd, 1); sd += __shfl_xor(sd, 2);
                float v[16]; ld16(vp, f32src, v);
                if (fl && kpos <= pos) { const int dist = pos - kpos; const float sv = sd + btr[dist < 127 ? dist : 127];
                    if (sv > ms) { const float corr = exp2f(ms - sv); ls *= corr;
#pragma unroll
                        for (int i = 0; i < 16; ++i) os[i] *= corr;
                        ms = sv; }
                    const float pv = exp2f(sv - ms); ls += pv;
#pragma unroll
                    for (int i = 0; i < 16; ++i) os[i] += pv * v[i]; }
            }
        }
        const float sc1 = g1 / ls;
#pragma unroll
        for (int i = 0; i < 16; ++i) out[i] += sc1 * os[i];
    }
    {
        float ms = -1e30f, ls = 0.f, os[16];
#pragma unroll
        for (int i = 0; i < 16; ++i) os[i] = 0.f;
        int kstart = posmin - 511; if (kstart < 0) kstart = 0;
        for (int kpos = kstart; kpos <= posmax; ++kpos) {
            const void* kp; const void* vp; bool f32src = false;
            if (PROMPT) { const bf16* r = KVB + (size_t)(b * SEQ + kpos) * KVW + 1024 + g * 64 + dq * 16; kp = r; vp = r + 256; }
            else if (kpos < PAST) { const float* r = a.cache_win + ((size_t)b * 512 + (kpos - (PAST - 512))) * 512 + g * 64 + dq * 16; kp = r; vp = r + 256; f32src = true; }
            else { const bf16* r = KVB + (size_t)(MP + b * DS + kpos - PAST) * KVW + 1024 + g * 64 + dq * 16; kp = r; vp = r + 256; }
            float k[16]; ld16(kp, f32src, k); float sd = 0.f;
#pragma unroll
            for (int i = 0; i < 16; ++i) sd += q[i] * k[i];
            sd += __shfl_xor(sd, 1); sd += __shfl_xor(sd, 2);
            float v[16]; ld16(vp, f32src, v);
            const int dist = pos - kpos;
            if (dist >= 0 && dist < 512) { const float sv = sd + btr[dist < 127 ? dist : 127];
                if (sv > ms) { const float corr = exp2f(ms - sv); ls *= corr;
#pragma unroll
                    for (int i = 0; i < 16; ++i) os[i] *= corr;
                    ms = sv; }
                const float pv = exp2f(sv - ms); ls += pv;
#pragma unroll
                for (int i = 0; i < 16; ++i) os[i] += pv * v[i]; }
        }
        const float sc2 = g2 / ls;
#pragma unroll
        for (int i = 0; i < 16; ++i) out[i] += sc2 * os[i];
    }
    bf16* op = (bf16*)(a.ws + WS_OB) + (size_t)row * DM + head * 64 + dq * 16;
    v4u w0, w1; w0.x = pk2(out[0], out[1]); w0.y = pk2(out[2], out[3]); w0.z = pk2(out[4], out[5]); w0.w = pk2(out[6], out[7]);
    w1.x = pk2(out[8], out[9]); w1.y = pk2(out[10], out[11]); w1.z = pk2(out[12], out[13]); w1.w = pk2(out[14], out[15]);
    *(v4u*)op = w0; *(v4u*)(op + 8) = w1;
}

__device__ __forceinline__ void attn_phase(const Args& a, LAS unsigned char* lds, int G) {
    using namespace cfg;
    const int tid = threadIdx.x, lane = tid & 63, wave = tid >> 6;
    LAS float* bt = (LAS float*)lds;
    LAS float* sc = (LAS float*)(lds + 8192 + wave * 9728);
    LAS float* scoreL = sc + 16 * 128;
    LAS int* flagL = (LAS int*)(scoreL + 160);
    for (int i = tid; i < 16 * 128; i += NTHR) { const int h = i >> 7, d = i & 127;
        int bucket = d; if (d >= 16) { bucket = 16 + (int)(__logf((float)d / 16.f) / 2.0794415416798357f * 16.f); if (bucket > 31) bucket = 31; }
        bt[i] = a.rel_bias[bucket * 16 + h] * LOG2E; }
    __syncthreads();
    for (int v = blockIdx.x; v < 2048 + 128; v += G) {
        if (v < 2048) { const int j = v >> 8, k = v & 255, bg = k >> 3, r = k & 7;
            const int uidx = (j >> 1) * 16 + ((j & 1) ? 15 - r : r);
            attn_item<true>(a, bg >> 2, bg & 3, uidx * 8 + wave, lane, bt, sc, scoreL, flagL); }
        else { const int bs = v - 2048; attn_item<false>(a, bs, wave >> 1, wave & 1, lane, bt, sc, scoreL, flagL); }
    }
}

typedef short bf16x8 __attribute__((ext_vector_type(8)));
typedef short s16x4 __attribute__((ext_vector_type(4)));
typedef short v4i16_t __attribute__((ext_vector_type(4)));
typedef float f32x16 __attribute__((ext_vector_type(16)));
#define NEG_INF (-__builtin_inff())
__device__ __forceinline__ s16x4 vtr(const LAS unsigned char* p) { return __builtin_bit_cast(s16x4, __builtin_amdgcn_ds_read_tr16_b64_v4i16((LAS v4i16_t*)p)); }
__device__ __forceinline__ unsigned cvtpk(float lo, float hi) { unsigned r; asm volatile("v_cvt_pk_bf16_f32 %0, %1, %2" : "=v"(r) : "v"(lo), "v"(hi)); return r; }
constexpr int AT_BT = 0, AT_KS = 8192, AT_VS = 40960, AT_SC = 73728, AT_END = 81920;

__device__ __forceinline__ void tile_ld(const bf16* Kg, const bf16* Vg, int pitch, int wid, int lane, v4u& kr, v4u& vr) {
    kr = *(const v4u*)(Kg + (size_t)lane * pitch + wid * 8);
    vr = *(const v4u*)(Vg + (size_t)(16 * (wid & 3) + (lane >> 2)) * pitch + (wid >> 2) * 32 + (lane & 3) * 8);
}
__device__ __forceinline__ void tile_st(LAS unsigned char* lds, int slot, int wid, int lane, const v4u& kr, const v4u& vr) {
    *(LAS v4u*)(lds + AT_KS + slot * 8192 + wid * 1024 + lane * 16) = kr;
    *(LAS v4u*)(lds + AT_VS + slot * 8192 + wid * 1024 + lane * 16) = vr;
}
__device__ __forceinline__ void qk_tile(const LAS unsigned char* lds, int slot, const bf16x8 (&qf)[4], int r32, int hi, f32x16& p0, f32x16& p1) {
    const LAS unsigned char* kp = lds + AT_KS + slot * 8192 + hi * 1024 + r32 * 16;
    p0 = f32x16{}; p1 = f32x16{};
#pragma unroll
    for (int j = 0; j < 4; ++j) { const bf16x8 k0 = *(const LAS bf16x8*)(kp + j * 2048), k1 = *(const LAS bf16x8*)(kp + j * 2048 + 512);
        p0 = __builtin_amdgcn_mfma_f32_32x32x16_bf16(k0, qf[j], p0, 0, 0, 0); p1 = __builtin_amdgcn_mfma_f32_32x32x16_bf16(k1, qf[j], p1, 0, 0, 0); }
}
__device__ __forceinline__ void pv_img(const LAS unsigned char* vimg, int lane, int hi, const f32x16& p0, const f32x16& p1, f32x16 (&o)[2]) {
    const LAS unsigned char* vp = vimg + ((lane >> 4) & 1) * 32 + (lane & 3) * 8 + (4 * hi + ((lane & 15) >> 2)) * 64;
    bf16x8 pf[4];
#pragma unroll
    for (int k = 0; k < 4; ++k) { const f32x16& p = (k < 2) ? p0 : p1; const int b0 = (k & 1) * 8; v4u w;
        w.x = cvtpk(p[b0], p[b0 + 1]); w.y = cvtpk(p[b0 + 2], p[b0 + 3]); w.z = cvtpk(p[b0 + 4], p[b0 + 5]); w.w = cvtpk(p[b0 + 6], p[b0 + 7]); pf[k] = __builtin_bit_cast(bf16x8, w); }
#pragma unroll
    for (int db = 0; db < 2; ++db)
#pragma unroll
        for (int ks = 0; ks < 4; ++ks) { const s16x4 lo = vtr(vp + db * 4096 + ks * 1024), hv = vtr(vp + db * 4096 + ks * 1024 + 512);
            const bf16x8 vf = {lo[0], lo[1], lo[2], lo[3], hv[0], hv[1], hv[2], hv[3]};
            o[db] = __builtin_amdgcn_mfma_f32_32x32x16_bf16(vf, pf[ks], o[db], 0, 0, 0); }
}

__device__ __forceinline__ void pv_tile(const LAS unsigned char* lds, int slot, int lane, int hi, const f32x16& p0, const f32x16& p1, f32x16 (&o)[2]) { pv_img(lds + AT_VS + slot * 8192, lane, hi, p0, p1, o); }
template <int MODE>
__device__ __forceinline__ void bias_mask(f32x16& p0, f32x16& p1, int dbase, bool near, bool flag, const LAS float* btr, float b31) {
    if (near) {
#pragma unroll
        for (int r = 0; r < 16; ++r) { const int d0 = dbase - ((r & 3) + 8 * (r >> 2)), d1 = d0 - 32;
            const bool ok0 = flag && d0 >= 0 && (MODE == 1 || d0 < 512), ok1 = flag && d1 >= 0 && (MODE == 1 || d1 < 512);
            const float b0 = btr[d0 < 0 ? 0 : (d0 > 127 ? 127 : d0)], b1 = btr[d1 < 0 ? 0 : (d1 > 127 ? 127 : d1)];
            p0[r] = ok0 ? p0[r] + b0 : NEG_INF; p1[r] = ok1 ? p1[r] + b1 : NEG_INF; }
    } else {
#pragma unroll
        for (int r = 0; r < 16; ++r) { const int d0 = dbase - ((r & 3) + 8 * (r >> 2)), d1 = d0 - 32;
            const bool ok0 = flag && (MODE == 1 || d0 < 512), ok1 = flag && (MODE == 1 || d1 < 512);
            p0[r] = ok0 ? p0[r] + b31 : NEG_INF; p1[r] = ok1 ? p1[r] + b31 : NEG_INF; }
    }
}
__device__ __forceinline__ void online_update(f32x16& p0, f32x16& p1, float& m, float& l, f32x16 (&o)[2]) {
    float tmax = NEG_INF;
#pragma unroll
    for (int r = 0; r < 16; ++r) tmax = fmaxf(tmax, fmaxf(p0[r], p1[r]));
    tmax = fmaxf(tmax, __shfl_xor(tmax, 32));
    const float mn = fmaxf(m, tmax), ms = (mn == NEG_INF) ? 0.f : mn;
    const float corr = __builtin_amdgcn_exp2f(m - ms);
    float sum = 0.f;
#pragma unroll
    for (int r = 0; r < 16; ++r) { p0[r] = __builtin_amdgcn_exp2f(p0[r] - ms); p1[r] = __builtin_amdgcn_exp2f(p1[r] - ms); sum += p0[r] + p1[r]; }
    l = l * corr + sum; m = mn;
#pragma unroll
    for (int r = 0; r < 16; ++r) { o[0][r] *= corr; o[1][r] *= corr; }
}
template <int MODE>
__device__ __forceinline__ void flash_branch(LAS unsigned char* lds, const bf16* Kg, const bf16* Vg, int kt0, int kt1, const bf16x8 (&qf)[4], int pos, int posmin, int posmax,
                                             const LAS float* btr, float b31, unsigned selmask, float gate, f32x16 (&o)[2], int wid, int lane) {
    const int r32 = lane & 31, hi = lane >> 5;
    float m = NEG_INF, l = 0.f; o[0] = f32x16{}; o[1] = f32x16{};
    v4u kr, vr;
    __syncthreads();
    tile_ld(Kg + (size_t)kt0 * 64 * cfg::KVW, Vg + (size_t)kt0 * 64 * cfg::KVW, cfg::KVW, wid, lane, kr, vr);
    tile_st(lds, 0, wid, lane, kr, vr);
    __syncthreads();
    for (int kt = kt0; kt <= kt1; ++kt) {
        const int slot = (kt - kt0) & 1;
        if (kt < kt1) tile_ld(Kg + (size_t)(kt + 1) * 64 * cfg::KVW, Vg + (size_t)(kt + 1) * 64 * cfg::KVW, cfg::KVW, wid, lane, kr, vr);
        const bool flag = (MODE == 1) ? ((selmask >> kt) & 1u) != 0u : true;
        const bool wave_on = (MODE == 1) ? (__any(flag) != 0) : (posmin - (kt * 64 + 63) < 512);
        if (wave_on) {
            f32x16 p0, p1; qk_tile(lds, slot, qf, r32, hi, p0, p1);
            const bool near = (posmin - (kt * 64 + 63)) < 113;
            bias_mask<MODE>(p0, p1, pos - kt * 64 - 4 * hi, near, flag, btr, b31);
            online_update(p0, p1, m, l, o);
            pv_tile(lds, slot, lane, hi, p0, p1, o);
        }
        if (kt < kt1) tile_st(lds, slot ^ 1, wid, lane, kr, vr);
        __syncthreads();
    }
    l += __shfl_xor(l, 32);
    const float sc = l > 0.f ? gate / l : 0.f;
#pragma unroll
    for (int r = 0; r < 16; ++r) { o[0][r] *= sc; o[1][r] *= sc; }
}

__device__ __forceinline__ void cmp_softmax_scores(f32x16 (&p)[4], int pos, int tokl, int hh, int hi, const LAS float* btr, LAS float* scoreL) {
        float mx = NEG_INF;
#pragma unroll
        for (int u = 0; u < 4; ++u)
#pragma unroll
            for (int r = 0; r < 16; ++r) { const int c = 32 * u + (r & 3) + 8 * (r >> 2) + 4 * hi; const int d = pos - 31 - 16 * c;
                const float bv = btr[d < 0 ? 0 : (d > 127 ? 127 : d)];
                p[u][r] = d >= 0 ? p[u][r] + bv : NEG_INF; mx = fmaxf(mx, p[u][r]); }
        mx = fmaxf(mx, __shfl_xor(mx, 32));
        const float ms = (mx == NEG_INF) ? 0.f : mx;
        float l = 0.f;
#pragma unroll
        for (int u = 0; u < 4; ++u)
#pragma unroll
            for (int r = 0; r < 16; ++r) { p[u][r] = __builtin_amdgcn_exp2f(p[u][r] - ms); l += p[u][r]; }
        l += __shfl_xor(l, 32);
        const float inv = l > 0.f ? 1.f / l : 0.f;
#pragma unroll
        for (int u = 0; u < 4; ++u)
#pragma unroll
            for (int r = 0; r < 16; ++r) p[u][r] *= inv;
        {
            float X[4][4];
#pragma unroll
            for (int u = 0; u < 4; ++u)
#pragma unroll
                for (int jq = 0; jq < 4; ++jq) X[u][jq] = __shfl_xor(p[u][4 * jq + 3], 32);
            const int blk = pos >> 6;
#pragma unroll
            for (int u = 0; u < 4; ++u)
#pragma unroll
                for (int jq = 0; jq < 4; ++jq) {
                    const float Gq = (p[u][4 * jq] + p[u][4 * jq + 1]) + (p[u][4 * jq + 2] + p[u][4 * jq + 3]);
                    const float xprev = (jq > 0) ? X[u][jq - 1] : (u > 0 ? X[u - 1][3] : 0.f);
                    float imp = Gq + (hi ? X[u][jq] : xprev);
                    imp += __shfl_xor(imp, 1); imp += __shfl_xor(imp, 2);
                    const int s = 8 * u + 2 * jq + hi;
                    const bool valid = s * 64 <= pos, forced = (s == 0) || (s == blk) || (s == blk - 1);
                    const float score = valid ? imp + (forced ? 1000.f : 0.f) : -1.f;
                    if (hh == 0) scoreL[tokl * 32 + s] = score;
                }
            WSYNC();
        }
}
template <bool SAMPLE>
__device__ __forceinline__ void cmp_ranks(int tokl, int lane, const LAS float* scoreL, unsigned& selmask) {
    const int tk = lane >> 3, i8 = lane & 7;
    float my[4]; int rank[4];
#pragma unroll
    for (int j = 0; j < 4; ++j) { my[j] = scoreL[tk * 32 + 8 * j + i8]; rank[j] = 0; }
#pragma unroll
    for (int q4 = 0; q4 < 8; ++q4) { const f32x4 v = *(const LAS f32x4*)(scoreL + tk * 32 + 4 * q4);
#pragma unroll
        for (int e = 0; e < 4; ++e) { const int s2 = 4 * q4 + e;
#pragma unroll
            for (int j = 0; j < 4; ++j) rank[j] += ((v[e] > my[j]) || (v[e] == my[j] && s2 < 8 * j + i8)) ? 1 : 0; } }
#pragma unroll
    for (int j = 0; j < 4; ++j) { const unsigned long long bal = __ballot(rank[j] < (SAMPLE ? 15 : 16)); selmask |= ((unsigned)(bal >> (8 * tokl)) & 0xffu) << (8 * j); }
    WSYNC();
}

__device__ __forceinline__ void attn_mfma_unit(const Args& a, int b, int g, int qt, LAS unsigned char* lds) {
    using namespace cfg;
    const int tid = threadIdx.x, lane = tid & 63, r32 = lane & 31, hi = lane >> 5;
    const int wid = __builtin_amdgcn_readfirstlane(tid >> 6);
    LAS float* scoreL = (LAS float*)(lds + AT_SC + wid * 1024);
    const int tokl = r32 >> 2, hh = r32 & 3, head = g * 4 + hh;
    const int posmin = qt * 64 + wid * 8, posmax = posmin + 7, pos = posmin + tokl, row = b * SEQ + pos;
    const LAS float* btr = (const LAS float*)(lds + AT_BT) + head * 128;
    const float b31 = btr[127];
    bf16x8 qf[4];
    { const bf16* qp = (const bf16*)(a.ws + WS_QB) + (size_t)row * DM + head * 64 + hi * 8;
#pragma unroll
      for (int s = 0; s < 4; ++s) qf[s] = *(const bf16x8*)(qp + 16 * s); }
    const float* gp = (const float*)(a.ws + WS_GATES) + (size_t)row * 48 + head * 3; const float g0 = gp[0], g1 = gp[1], g2 = gp[2];
    LAS float* oL = (LAS float*)(lds + (wid < 2 ? 24576 + wid * 8192 : (wid < 4 ? 57344 + (wid - 2) * 8192 : 81920 + (wid - 4) * 8192)));
    unsigned selmask = 0u;
    {
        const size_t cb = ((size_t)((DB + b) * 4 + g) * 128) * 64;
        const bf16* KCb = (const bf16*)(a.ws + WS_KC) + cb; const bf16* VCb = (const bf16*)(a.ws + WS_VC) + cb;
        const int posmaxu = qt * 64 + 63; int ncu = ((posmaxu - 31) >> 4) + 1; if (ncu > 127) ncu = 127;
        const int ntile = (ncu + 63) >> 6;
        v4u kr, vr;
        __syncthreads();
        for (int tl = 0; tl < ntile; ++tl) { tile_ld(KCb + tl * 64 * 64, VCb + tl * 64 * 64, 64, wid, lane, kr, vr); tile_st(lds, tl, wid, lane, kr, vr); }
        __syncthreads();
        f32x16 p[4]; p[2] = f32x16{}; p[3] = f32x16{};
        qk_tile(lds, 0, qf, r32, hi, p[0], p[1]);
        if (ntile > 1) qk_tile(lds, 1, qf, r32, hi, p[2], p[3]);
        cmp_softmax_scores(p, pos, tokl, hh, hi, btr, scoreL);
        f32x16 o[2]; o[0] = f32x16{}; o[1] = f32x16{};
        pv_tile(lds, 0, lane, hi, p[0], p[1], o);
        if (ntile > 1) pv_tile(lds, 1, lane, hi, p[2], p[3], o);
        cmp_ranks<false>(tokl, lane, scoreL, selmask);
#pragma unroll
        for (int db = 0; db < 2; ++db)
#pragma unroll
            for (int r = 0; r < 16; ++r) oL[(db * 16 + r) * 64 + lane] = g0 * o[db][r];
    }
    const bf16* KVB = (const bf16*)(a.ws + WS_KVB) + (size_t)b * SEQ * KVW + g * 64;
    f32x16 oacc[2];
    flash_branch<1>(lds, KVB + 512, KVB + 768, 0, qt, qf, pos, posmin, posmax, btr, b31, selmask, g1, oacc, wid, lane);
#pragma unroll
    for (int db = 0; db < 2; ++db)
#pragma unroll
        for (int r = 0; r < 16; ++r) oL[(db * 16 + r) * 64 + lane] += oacc[db][r];
    flash_branch<2>(lds, KVB + 1024, KVB + 1280, qt >= 8 ? qt - 8 : 0, qt, qf, pos, posmin, posmax, btr, b31, 0u, g2, oacc, wid, lane);
#pragma unroll
    for (int db = 0; db < 2; ++db)
#pragma unroll
        for (int r = 0; r < 16; ++r) oacc[db][r] += oL[(db * 16 + r) * 64 + lane];
    bf16* op = (bf16*)(a.ws + WS_OB) + (size_t)row * DM + head * 64 + 4 * hi;
#pragma unroll
    for (int db = 0; db < 2; ++db)
#pragma unroll
        for (int jq = 0; jq < 4; ++jq) { v2u w; w.x = cvtpk(oacc[db][4 * jq], oacc[db][4 * jq + 1]); w.y = cvtpk(oacc[db][4 * jq + 2], oacc[db][4 * jq + 3]);
            *(v2u*)(op + 32 * db + 8 * jq) = w; }
}


template <bool F32> __device__ __forceinline__ bf16x8 ld8(const void* p) {
    if (F32) { const f32x4 a = *(const f32x4*)p, b = *((const f32x4*)p + 1); v4u w; w.x = cvtpk(a[0], a[1]); w.y = cvtpk(a[2], a[3]); w.z = cvtpk(b[0], b[1]); w.w = cvtpk(b[2], b[3]); return __builtin_bit_cast(bf16x8, w); }
    else return *(const bf16x8*)p;
}
template <bool F32, class RowFn> __device__ __forceinline__ void kfrag_load(const RowFn& rowp, int lane, bf16x8 (&kf)[8]) {
    typedef typename std::conditional<F32, float, bf16>::type T;
    const int r32 = lane & 31, hi = lane >> 5;
#pragma unroll
    for (int half = 0; half < 2; ++half) { const T* kp = (const T*)rowp(r32 + 32 * half) + 8 * hi;
#pragma unroll
        for (int j = 0; j < 4; ++j) kf[2 * j + half] = ld8<F32>(kp + 16 * j); }
}
template <bool F32, class RowFn> __device__ __forceinline__ void vimg_load(const RowFn& rowp, long voff, int lane, LAS unsigned char* vimg) {
    typedef typename std::conditional<F32, float, bf16>::type T;
    bf16x8 v[8];
#pragma unroll
    for (int i = 0; i < 8; ++i) { const T* vp = (const T*)rowp(16 * (i & 3) + (lane >> 2)) + voff + (i >> 2) * 32 + (lane & 3) * 8; v[i] = ld8<F32>(vp); }
    WSYNC();
#pragma unroll
    for (int i = 0; i < 8; ++i) *(LAS bf16x8*)(vimg + i * 1024 + lane * 16) = v[i];
    WSYNC();
}
__device__ __forceinline__ void qk_frags(const bf16x8 (&kf)[8], const bf16x8 (&qf)[4], f32x16& p0, f32x16& p1) {
    p0 = f32x16{}; p1 = f32x16{};
#pragma unroll
    for (int j = 0; j < 4; ++j) { p0 = __builtin_amdgcn_mfma_f32_32x32x16_bf16(kf[2 * j], qf[j], p0, 0, 0, 0); p1 = __builtin_amdgcn_mfma_f32_32x32x16_bf16(kf[2 * j + 1], qf[j], p1, 0, 0, 0); }
}

__device__ __forceinline__ void attn_sample_unit(const Args& a, int b, int gp, LAS unsigned char* lds) {
    using namespace cfg;
    const int tid = threadIdx.x, lane = tid & 63, r32 = lane & 31, hi = lane >> 5;
    const int wid = __builtin_amdgcn_readfirstlane(tid >> 6);
    const int g = 2 * gp + (wid >> 2), part = wid & 3;
    LAS unsigned char* vimg = lds + AT_KS + wid * 8192;
    LAS float* scoreL = (LAS float*)(lds + AT_SC + wid * 1024);
    const int tokl = r32 >> 2, hh = r32 & 3, head = g * 4 + hh;
    const int posmin = PAST, pos = PAST + tokl, row = MP + b * DS + tokl;
    const LAS float* btr = (const LAS float*)(lds + AT_BT) + head * 128;
    const float b31 = btr[127];
    bf16x8 qf[4];
    { const bf16* qp = (const bf16*)(a.ws + WS_QB) + (size_t)row * DM + head * 64 + hi * 8;
#pragma unroll
      for (int s = 0; s < 4; ++s) qf[s] = *(const bf16x8*)(qp + 16 * s); }
    const float* gpt = (const float*)(a.ws + WS_GATES) + (size_t)row * 48 + head * 3; const float g0 = gpt[0], g1 = gpt[1], g2 = gpt[2];
    LAS float* ocL = (LAS float*)(lds + AT_END + (wid >> 2) * 8192);
    unsigned selmask = 0u;
    __syncthreads();
    {
        const bf16* KCb = (const bf16*)(a.ws + WS_KC) + ((size_t)(b * 4 + g) * 128) * 64; const long voffc = (long)((WS_VC - WS_KC) / 2);
        f32x16 p[4]; bf16x8 kf[8];
        auto r0 = [&](int key) { return (const void*)(KCb + (size_t)key * 64); };
        auto r1 = [&](int key) { return (const void*)(KCb + (size_t)(64 + key) * 64); };
        kfrag_load<false>(r0, lane, kf); qk_frags(kf, qf, p[0], p[1]);
        kfrag_load<false>(r1, lane, kf); qk_frags(kf, qf, p[2], p[3]);
        cmp_softmax_scores(p, pos, tokl, hh, hi, btr, scoreL);
        if (part == 0) {
            f32x16 oc[2]; oc[0] = f32x16{}; oc[1] = f32x16{};
            vimg_load<false>(r0, voffc, lane, vimg); pv_img(vimg, lane, hi, p[0], p[1], oc);
            vimg_load<false>(r1, voffc, lane, vimg); pv_img(vimg, lane, hi, p[2], p[3], oc);
#pragma unroll
            for (int db = 0; db < 2; ++db)
#pragma unroll
                for (int r = 0; r < 16; ++r) ocL[(db * 16 + r) * 64 + lane] = g0 * oc[db][r];
        }
        cmp_ranks<true>(tokl, lane, scoreL, selmask);
    }
    const bf16* KVBn = (const bf16*)(a.ws + WS_KVB) + (size_t)(MP + b * DS) * KVW + g * 64;
    float ms_ = NEG_INF, ls_ = 0.f; f32x16 os_[2]; os_[0] = f32x16{}; os_[1] = f32x16{};
    for (int kt = part; kt <= 32; kt += 4) {
        const bool flag = kt == 32 ? true : ((selmask >> kt) & 1u) != 0u;
        if (!__any(flag)) continue;
        f32x16 p0, p1; bf16x8 kf[8];
        const bool near = (posmin - (kt * 64 + 63)) < 113;
        if (kt < 32) {
            const int page = a.page_table[b * NPAGE + (kt >> 1)];
            const float* base = a.cache_sel + ((size_t)page * PAGE + (kt & 1) * 64) * 512 + g * 64;
            auto rf = [&](int key) { return (const void*)(base + (size_t)key * 512); };
            kfrag_load<true>(rf, lane, kf); vimg_load<true>(rf, 256, lane, vimg);
        } else {
            auto rf = [&](int key) { return (const void*)(KVBn + (size_t)(key < DS ? key : DS - 1) * KVW + 512); };
            kfrag_load<false>(rf, lane, kf); vimg_load<false>(rf, 256, lane, vimg);
        }
        qk_frags(kf, qf, p0, p1);
        bias_mask<1>(p0, p1, pos - kt * 64 - 4 * hi, near, flag, btr, b31);
        online_update(p0, p1, ms_, ls_, os_);
        pv_img(vimg, lane, hi, p0, p1, os_);
    }
    float mw_ = NEG_INF, lw_ = 0.f; f32x16 ow_[2]; ow_[0] = f32x16{}; ow_[1] = f32x16{};
    for (int i = part; i <= 8; i += 4) {
        f32x16 p0, p1; bf16x8 kf[8];
        const int key0 = (PAST - 512) + 64 * i;
        const bool near = (posmin - (key0 + 63)) < 113;
        if (i < 8) {
            const float* base = a.cache_win + ((size_t)b * 512 + 64 * i) * 512 + g * 64;
            auto rf = [&](int key) { return (const void*)(base + (size_t)key * 512); };
            kfrag_load<true>(rf, lane, kf); vimg_load<true>(rf, 256, lane, vimg);
        } else {
            auto rf = [&](int key) { return (const void*)(KVBn + (size_t)(key < DS ? key : DS - 1) * KVW + 1024); };
            kfrag_load<false>(rf, lane, kf); vimg_load<false>(rf, 256, lane, vimg);
        }
        qk_frags(kf, qf, p0, p1);
        bias_mask<2>(p0, p1, pos - key0 - 4 * hi, near, true, btr, b31);
        online_update(p0, p1, mw_, lw_, ow_);
        pv_img(vimg, lane, hi, p0, p1, ow_);
    }
    ls_ += __shfl_xor(ls_, 32); lw_ += __shfl_xor(lw_, 32);
    scoreL[lane] = ms_; scoreL[64 + lane] = ls_; scoreL[128 + lane] = mw_; scoreL[192 + lane] = lw_;
    __syncthreads();
    {
        const LAS float* st = (const LAS float*)(lds + AT_SC + (wid & 4) * 1024);
        float Ms = NEG_INF, Mw = NEG_INF;
#pragma unroll
        for (int w = 0; w < 4; ++w) { Ms = fmaxf(Ms, st[w * 256 + lane]); Mw = fmaxf(Mw, st[w * 256 + 128 + lane]); }
        float Ls = 0.f, Lw = 0.f;
#pragma unroll
        for (int w = 0; w < 4; ++w) { Ls += st[w * 256 + 64 + lane] * __builtin_amdgcn_exp2f(st[w * 256 + lane] - Ms); Lw += st[w * 256 + 192 + lane] * __builtin_amdgcn_exp2f(st[w * 256 + 128 + lane] - Mw); }
        const float fs = g1 * __builtin_amdgcn_exp2f(ms_ - Ms) / Ls, fw = g2 * __builtin_amdgcn_exp2f(mw_ - Mw) / Lw;
        LAS float* slab = (LAS float*)vimg;
#pragma unroll
        for (int db = 0; db < 2; ++db)
#pragma unroll
            for (int r = 0; r < 16; ++r) slab[(db * 16 + r) * 64 + lane] = fs * os_[db][r] + fw * ow_[db][r] + (part == 0 ? ocL[(db * 16 + r) * 64 + lane] : 0.f);
    }
    __syncthreads();
    if (part == 0) {
        const LAS float* sl = (const LAS float*)(lds + AT_KS + wid * 8192);
        bf16* op = (bf16*)(a.ws + WS_OB) + (size_t)row * DM + head * 64 + 4 * hi;
#pragma unroll
        for (int db = 0; db < 2; ++db)
#pragma unroll
            for (int jq = 0; jq < 4; ++jq) { float v[4];
#pragma unroll
                for (int e = 0; e < 4; ++e) { const int idx = (db * 16 + 4 * jq + e) * 64 + lane; v[e] = (sl[idx] + sl[2048 + idx]) + (sl[4096 + idx] + sl[6144 + idx]); }
                v2u w; w.x = cvtpk(v[0], v[1]); w.y = cvtpk(v[2], v[3]); *(v2u*)(op + 32 * db + 8 * jq) = w; }
    }
}

__device__ __forceinline__ void attn_phase2(const Args& a, LAS unsigned char* lds, int G) {
    using namespace cfg;
    const int tid = threadIdx.x, lane = tid & 63, wave = tid >> 6;
    LAS float* bt = (LAS float*)(lds + AT_BT);
    for (int i = tid; i < 16 * 128; i += NTHR) { const int h = i >> 7, d = i & 127;
        int bucket = d; if (d >= 16) { bucket = 16 + (int)(__logf((float)d / 16.f) / 2.0794415416798357f * 16.f); if (bucket > 31) bucket = 31; }
        bt[i] = a.rel_bias[bucket * 16 + h] * LOG2E; }
    __syncthreads();
    for (int rep_ = 0; rep_ < probe_rep(21); ++rep_) for (int v = blockIdx.x; v < 1024; v += G) { const int j = v >> 8, k = v & 255, bg = k >> 3, r = k & 7;
        const int qt = (j == 0) ? 31 - r : (j == 1) ? 16 + r : (j == 2) ? 15 - r : r;
        attn_mfma_unit(a, bg >> 2, bg & 3, qt, lds); }
    __syncthreads();
    for (int rep_ = 0; rep_ < probe_rep(22); ++rep_) for (int v = blockIdx.x; v < 2 * DB; v += G) attn_sample_unit(a, v >> 1, v & 1, lds);
}

__device__ __forceinline__ void conv_phase(const Args& a, int G) {
    using namespace cfg;
    const bf16* ZX = (const bf16*)(a.ws + WS_ZX); bf16* XC = (bf16*)(a.ws + WS_XC);
    const size_t gt = (size_t)blockIdx.x * NTHR + threadIdx.x, NT = (size_t)G * NTHR;
    for (size_t it = gt; it < (size_t)(M / 4) * 384; it += NT) {
        const int oct = (int)(it % 384), r4 = (int)(it / 384), row = r4 * 4, cx = oct * 8;
        const bool prompt = row < MP; const int t = prompt ? (row & 2047) : ((row - MP) & 7), bsm = (row - MP) >> 3;
        float x[7][8];
#pragma unroll
        for (int j = 0; j < 7; ++j) { const int tt = t - 3 + j;
            if (tt >= 0) { const v4u r = *(const v4u*)(ZX + (size_t)(row - 3 + j) * ZXW + DIN + cx);
                x[j][0] = bflo(r.x); x[j][1] = bfhi(r.x); x[j][2] = bflo(r.y); x[j][3] = bfhi(r.y); x[j][4] = bflo(r.z); x[j][5] = bfhi(r.z); x[j][6] = bflo(r.w); x[j][7] = bfhi(r.w); }
            else if (!prompt) { const float* sp = a.state_conv + (size_t)(bsm * 3 + 3 + tt) * CONVD + cx; const f32x4 s0 = *(const f32x4*)sp, s1 = *(const f32x4*)(sp + 4);
                x[j][0] = s0[0]; x[j][1] = s0[1]; x[j][2] = s0[2]; x[j][3] = s0[3]; x[j][4] = s1[0]; x[j][5] = s1[1]; x[j][6] = s1[2]; x[j][7] = s1[3]; }
            else {
#pragma unroll
                for (int c = 0; c < 8; ++c) x[j][c] = 0.f; } }
        float w[5][8];
#pragma unroll
        for (int k = 0; k < 5; ++k) { const float* wp = (k < 4 ? a.m_conv_w + (size_t)k * CONVD : a.m_conv_b) + cx; const f32x4 w0 = *(const f32x4*)wp, w1 = *(const f32x4*)(wp + 4);
            w[k][0] = w0[0]; w[k][1] = w0[1]; w[k][2] = w0[2]; w[k][3] = w0[3]; w[k][4] = w1[0]; w[k][5] = w1[1]; w[k][6] = w1[2]; w[k][7] = w1[3]; }
#pragma unroll
        for (int rr = 0; rr < 4; ++rr) { float v[8];
#pragma unroll
            for (int c = 0; c < 8; ++c) v[c] = silu_f(w[4][c] + w[0][c] * x[rr][c] + w[1][c] * x[rr + 1][c] + w[2][c] * x[rr + 2][c] + w[3][c] * x[rr + 3][c]);
            v4u o; o.x = pk2(v[0], v[1]); o.y = pk2(v[2], v[3]); o.z = pk2(v[4], v[5]); o.w = pk2(v[6], v[7]);
            *(v4u*)(XC + (size_t)(row + rr) * CONVD + cx) = o; }
    }
}

constexpr int SC_CS = 2112;
constexpr int SC_BROW = 0, SC_CIMG = 16 * SC_CS, SC_XIMG = SC_CIMG + 32768, SC_XWIMG = SC_XIMG + 16384, SC_HIMG = SC_XWIMG + 16384, SC_CW = SC_HIMG + 16384, SC_UP = 132096;
static_assert(SC_CW + 5 * 320 * 4 <= 131072, "scan LDS map");
__device__ __forceinline__ float softplus_f(float x) { return x > 20.f ? x : log1pf(__expf(x)); }

__device__ __forceinline__ void ssd_dt_load(const Args& a, int row_first, int hd, int tid, float& d0, float& d1) {
    if (tid < 128) { const float* DT = (const float*)(a.ws + cfg::WS_DT); d0 = DT[(size_t)(row_first + tid) * 32 + hd]; d1 = DT[(size_t)(row_first + (tid ^ 64)) * 32 + hd]; }
}
__device__ __forceinline__ void ssd_dt_stage(float d0, float d1, float dtb, float Aneg, LAS float* up  , int tid) {
    if (tid < 128) {
        const int l = tid;
        const float dtv = softplus_f(d0 + dtb), dto = softplus_f(d1 + dtb);
        const float av = dtv * Aneg, ao = dto * Aneg;
        float sc = av; const int lane = tid & 63;
#pragma unroll
        for (int o = 1; o < 64; o <<= 1) { const float t = __shfl_up(sc, o); if (lane >= o) sc += t; }
        const float mytot = __shfl(sc, 63), othtot = wave_sum(ao);
        const float acum = sc + (tid >= 64 ? othtot : 0.f), total = mytot + othtot;
        up[l] = acum; up[128 + l] = dtv; up[256 + l] = __expf(total - acum);
    }
}

__device__ __forceinline__ void ssd_prompt_unit(const Args& a, int b, int hd, LAS unsigned char* lds) {
    using namespace cfg;
    const int tid = threadIdx.x, lane = tid & 63, r32 = lane & 31, hi = lane >> 5;
    const int wid = __builtin_amdgcn_readfirstlane(tid >> 6);
    const int pb = wid >> 2, lb = wid & 3, g = hd >> 3, row0 = b * SEQ;
    const bf16* ZX = (const bf16*)(a.ws + WS_ZX); bf16* YG = (bf16*)(a.ws + WS_YG); float* SSQ = (float*)(a.ws + WS_SSQ);
    LAS float* upb = (LAS float*)(lds + SC_UP); LAS float* ssqx = upb + 768;
    const bf16* XC = (const bf16*)(a.ws + WS_XC);
    const float dtb = a.m_dt_bias[hd], Aneg = -__expf(a.m_a_log[hd]), Dh = a.m_d[hd];
    const int ss = 64 * (wid & 1) + lane, oct0 = wid >> 1;
    int pcol[10];
#pragma unroll
    for (int i = 0; i < 10; ++i) { const int oct = oct0 + 4 * i; pcol[i] = oct < 8 ? hd * 64 + 8 * oct : (oct < 24 ? 2048 + g * 128 + 8 * (oct - 8) : 2560 + g * 128 + 8 * (oct - 24)); }
    v4u pre[10];
#pragma unroll
    for (int i = 0; i < 10; ++i) pre[i] = *(const v4u*)(XC + (size_t)(row0 + ss) * CONVD + pcol[i]);
    f32x16 hT = f32x16{};
    __syncthreads();
    { float d0 = 0.f, d1 = 0.f; ssd_dt_load(a, row0, hd, tid, d0, d1); ssd_dt_stage(d0, d1, dtb, Aneg, upb, tid); }
    __syncthreads();
    for (int ci = 0; ci < SEQ / 128; ++ci) {
        const int t0 = ci * 128; LAS float* up = upb + (ci & 1) * 384;
        float dn0 = 0.f, dn1 = 0.f;
        if (ci + 1 < SEQ / 128) ssd_dt_load(a, row0 + t0 + 128, hd, tid, dn0, dn1);
        { const float dw = up[128 + ss] * up[256 + ss];
#pragma unroll
          for (int i = 0; i < 10; ++i) { const int oct = oct0 + 4 * i; const v4u r = pre[i];
              if (oct < 8) { v4u ww; ww.x = pk2(bflo(r.x) * dw, bfhi(r.x) * dw); ww.y = pk2(bflo(r.y) * dw, bfhi(r.y) * dw); ww.z = pk2(bflo(r.z) * dw, bfhi(r.z) * dw); ww.w = pk2(bflo(r.w) * dw, bfhi(r.w) * dw);
                  const int off = (oct >> 2) * 8192 + ss * 64 + (oct & 3) * 16;
                  *(LAS v4u*)(lds + SC_XIMG + off) = r; *(LAS v4u*)(lds + SC_XWIMG + off) = ww; }
              else if (oct < 24) *(LAS v4u*)(lds + SC_BROW + (oct - 8) * SC_CS + ss * 16) = r;
              else *(LAS v4u*)(lds + SC_CIMG + (oct - 24) * 2048 + ss * 16) = r; } }
#pragma unroll
        for (int jq = 0; jq < 4; ++jq) { v2u w; w.x = pk2(hT[4 * jq], hT[4 * jq + 1]); w.y = pk2(hT[4 * jq + 2], hT[4 * jq + 3]);
            *(LAS v2u*)(lds + SC_HIMG + (4 * lb + jq) * 1024 + (32 * pb + r32) * 16 + hi * 8) = w; }
        if (ci > 0 && tid < 128) SSQ[(size_t)(row0 + t0 - 128 + tid) * 32 + hd] = ssqx[tid] + ssqx[128 + tid];
        if (ci + 1 < SEQ / 128) ssd_dt_stage(dn0, dn1, dtb, Aneg, upb + ((ci + 1) & 1) * 384, tid);
        __syncthreads();
        {
            const int lm = 32 * lb + r32;
            const float acl = up[lm], el = __expf(acl);
            if (ci + 1 < SEQ / 128) {
#pragma unroll
                for (int i = 0; i < 10; ++i) pre[i] = *(const v4u*)(XC + (size_t)(row0 + t0 + 128 + ss) * CONVD + pcol[i]);
            }
            v2u zw[4];
#pragma unroll
            for (int jq = 0; jq < 4; ++jq) zw[jq] = *(const v2u*)(ZX + (size_t)(row0 + t0 + lm) * ZXW + hd * 64 + 32 * pb + 8 * jq + 4 * hi);
            bf16x8 cf[8];
#pragma unroll
            for (int k = 0; k < 8; ++k) cf[k] = *(const LAS bf16x8*)(lds + SC_CIMG + (2 * k + hi) * 2048 + lm * 16);
            f32x16 acc = f32x16{};
#pragma unroll
            for (int k = 0; k < 8; ++k) { const bf16x8 hf = *(const LAS bf16x8*)(lds + SC_HIMG + (2 * k + hi) * 1024 + (32 * pb + r32) * 16);
                acc = __builtin_amdgcn_mfma_f32_32x32x16_bf16(hf, cf[k], acc, 0, 0, 0); }
#pragma unroll
            for (int r = 0; r < 16; ++r) acc[r] *= el;
            const LAS unsigned char* xtr = lds + SC_XIMG + pb * 8192 + ((lane >> 4) & 1) * 32 + (lane & 3) * 8 + (4 * hi + ((lane & 15) >> 2)) * 64;
            for (int sb = 0; sb <= lb; ++sb) {
                f32x16 gt = f32x16{};
#pragma unroll
                for (int k = 0; k < 8; ++k) { const bf16x8 bfr = *(const LAS bf16x8*)(lds + SC_BROW + (2 * k + hi) * SC_CS + (32 * sb + r32) * 16);
                    gt = __builtin_amdgcn_mfma_f32_32x32x16_bf16(bfr, cf[k], gt, 0, 0, 0); }
#pragma unroll
                for (int jq = 0; jq < 4; ++jq) { const f32x4 as4 = *(const LAS f32x4*)(up + 32 * sb + 8 * jq + 4 * hi), ds4 = *(const LAS f32x4*)(up + 128 + 32 * sb + 8 * jq + 4 * hi);
#pragma unroll
                    for (int e = 0; e < 4; ++e) { const int s = 32 * sb + 8 * jq + 4 * hi + e; const float d = acl - as4[e];
                        gt[4 * jq + e] = (s <= lm) ? gt[4 * jq + e] * (__expf(d < 0.f ? d : 0.f) * ds4[e]) : 0.f; } }
                bf16x8 pf[2];
#pragma unroll
                for (int ks = 0; ks < 2; ++ks) { v4u w; w.x = cvtpk(gt[8 * ks], gt[8 * ks + 1]); w.y = cvtpk(gt[8 * ks + 2], gt[8 * ks + 3]); w.z = cvtpk(gt[8 * ks + 4], gt[8 * ks + 5]); w.w = cvtpk(gt[8 * ks + 6], gt[8 * ks + 7]); pf[ks] = __builtin_bit_cast(bf16x8, w); }
#pragma unroll
                for (int ks = 0; ks < 2; ++ks) { const s16x4 lo = vtr(xtr + (32 * sb + 16 * ks) * 64), hv = vtr(xtr + (32 * sb + 16 * ks) * 64 + 512);
                    const bf16x8 xf = {lo[0], lo[1], lo[2], lo[3], hv[0], hv[1], hv[2], hv[3]};
                    acc = __builtin_amdgcn_mfma_f32_32x32x16_bf16(xf, pf[ks], acc, 0, 0, 0); }
            }
            { const float dod = Dh; float ssq = 0.f; const size_t grow = (size_t)(row0 + t0 + lm);
#pragma unroll
              for (int jq = 0; jq < 4; ++jq) { const int p4 = 32 * pb + 8 * jq + 4 * hi;
                  const v2u xw = *(const LAS v2u*)(lds + SC_XIMG + pb * 8192 + lm * 64 + (8 * jq + 4 * hi) * 2);
                  const float y0 = (acc[4 * jq] + dod * bflo(xw.x)) * silu_f(bflo(zw[jq].x)), y1 = (acc[4 * jq + 1] + dod * bfhi(xw.x)) * silu_f(bfhi(zw[jq].x));
                  const float y2 = (acc[4 * jq + 2] + dod * bflo(xw.y)) * silu_f(bflo(zw[jq].y)), y3 = (acc[4 * jq + 3] + dod * bfhi(xw.y)) * silu_f(bfhi(zw[jq].y));
                  ssq += (y0 * y0 + y1 * y1) + (y2 * y2 + y3 * y3);
                  v2u w; w.x = pk2(y0, y1); w.y = pk2(y2, y3); *(v2u*)(YG + grow * DIN + hd * 64 + p4) = w; }
              ssq += __shfl_xor(ssq, 32);
              if (hi == 0) ssqx[pb * 128 + lm] = ssq; }
            { const float etot = __expf(up[127]);
#pragma unroll
              for (int r = 0; r < 16; ++r) hT[r] *= etot;
              const LAS unsigned char* bn = lds + SC_BROW + (4 * lb + 2 * ((lane >> 4) & 1) + ((lane & 3) >> 1)) * SC_CS + (8 * hi + ((lane & 15) >> 2)) * 16 + (lane & 1) * 8;
              const LAS unsigned char* xn = lds + SC_XWIMG + pb * 8192 + ((lane >> 4) & 1) * 32 + (lane & 3) * 8 + (8 * hi + ((lane & 15) >> 2)) * 64;
#pragma unroll
              for (int k = 0; k < 8; ++k) {
                  const s16x4 blo = vtr(bn + (16 * k) * 16), bhv = vtr(bn + (16 * k) * 16 + 64);
                  const bf16x8 bt = {blo[0], blo[1], blo[2], blo[3], bhv[0], bhv[1], bhv[2], bhv[3]};
                  const s16x4 lo = vtr(xn + (16 * k) * 64), hv = vtr(xn + (16 * k) * 64 + 256);
                  const bf16x8 xf = {lo[0], lo[1], lo[2], lo[3], hv[0], hv[1], hv[2], hv[3]};
                  hT = __builtin_amdgcn_mfma_f32_32x32x16_bf16(bt, xf, hT, 0, 0, 0); } }
        }
        __syncthreads();
    }
    if (tid < 128) SSQ[(size_t)(row0 + SEQ - 128 + tid) * 32 + hd] = ssqx[tid] + ssqx[128 + tid];
    { float* sd = a.out + O_PSSM + ((size_t)(b * NH + hd) * HD + 32 * pb + r32) * DST + 32 * lb + 4 * hi;
#pragma unroll
      for (int jq = 0; jq < 4; ++jq) { const f32x4 v = {hT[4 * jq], hT[4 * jq + 1], hT[4 * jq + 2], hT[4 * jq + 3]}; *(f32x4*)(sd + 8 * jq) = v; } }
    __syncthreads();
}

__device__ __forceinline__ void ssd_sample_wave(const Args& a, int b, int hd, int lane, LAS float* bc  ) {
    using namespace cfg;
    const int g = hd >> 3, row0 = MP + b * DS;
    const bf16* ZX = (const bf16*)(a.ws + WS_ZX); const float* DT = (const float*)(a.ws + WS_DT);
    bf16* YG = (bf16*)(a.ws + WS_YG); float* SSQ = (float*)(a.ws + WS_SSQ);
    const float dtb = a.m_dt_bias[hd], Aneg = -__expf(a.m_a_log[hd]), Dh = a.m_d[hd];
    LAS float* xsl = bc + 2048;
    { const bf16* XC = (const bf16*)(a.ws + WS_XC);
#pragma unroll
      for (int t = 0; t < 8; ++t) { const bf16* xr = XC + (size_t)(row0 + t) * CONVD;
          xsl[t * 64 + lane] = bf2f(xr[hd * 64 + lane]);
          bc[t * 256 + lane] = bf2f(xr[2048 + g * 128 + lane]); bc[t * 256 + 64 + lane] = bf2f(xr[2048 + g * 128 + 64 + lane]);
          bc[t * 256 + 128 + lane] = bf2f(xr[2560 + g * 128 + lane]); bc[t * 256 + 192 + lane] = bf2f(xr[2560 + g * 128 + 64 + lane]); } }
    WSYNC();
    float h[128];
    { const float* s0 = a.state_ssm + ((size_t)(b * NH + hd) * HD + lane) * DST;
#pragma unroll
      for (int i = 0; i < 32; ++i) { const f32x4 v = *(const f32x4*)(s0 + 4 * i); h[4 * i] = v[0]; h[4 * i + 1] = v[1]; h[4 * i + 2] = v[2]; h[4 * i + 3] = v[3]; } }
#pragma unroll 1
    for (int t = 0; t < 8; ++t) {
        const float xst = xsl[t * 64 + lane];
        const float dtv = softplus_f(DT[(size_t)(row0 + t) * 32 + hd] + dtb), dA = __expf(dtv * Aneg), xdt = xst * dtv;
        float y = 0.f;
#pragma unroll
        for (int i = 0; i < 32; ++i) { const f32x4 Bv = *(const LAS f32x4*)(bc + t * 256 + 4 * i), Cv = *(const LAS f32x4*)(bc + t * 256 + 128 + 4 * i);
#pragma unroll
            for (int e = 0; e < 4; ++e) { h[4 * i + e] = dA * h[4 * i + e] + xdt * Bv[e]; y += h[4 * i + e] * Cv[e]; } }
        const float z = bf2f(ZX[(size_t)(row0 + t) * ZXW + hd * 64 + lane]);
        const float yg = (y + Dh * xst) * silu_f(z);
        YG[(size_t)(row0 + t) * DIN + hd * 64 + lane] = (bf16)f2bf(yg);
        const float ss = wave_sum(yg * yg); if (lane == 0) SSQ[(size_t)(row0 + t) * 32 + hd] = ss;
    }
    { float* sd = a.out + O_SSSM + ((size_t)(b * NH + hd) * HD + lane) * DST;
#pragma unroll
      for (int i = 0; i < 32; ++i) { const f32x4 v = {h[4 * i], h[4 * i + 1], h[4 * i + 2], h[4 * i + 3]}; *(f32x4*)(sd + 4 * i) = v; } }
    WSYNC();
}

__device__ __forceinline__ void scan_phase2(const Args& a, LAS unsigned char* lds, int G) {
    using namespace cfg;
    for (int rep_ = 0; rep_ < probe_rep(19); ++rep_) for (int u = blockIdx.x; u < NPB * NH; u += G) ssd_prompt_unit(a, u >> 5, u & 31, lds);
    __syncthreads();
    const int lane = threadIdx.x & 63, wave = threadIdx.x >> 6;
    LAS float* bc = (LAS float*)(lds + wave * 10240);
    for (int rep_ = 0; rep_ < probe_rep(20); ++rep_) for (int u = blockIdx.x * NWAVES + wave; u < DB * NH; u += G * NWAVES) ssd_sample_wave(a, u >> 5, u & 31, lane, bc);
}

constexpr int N_PHASES = 19;

__global__ void __launch_bounds__(NTHR, 2) yoco_fwd(Args args) {
    using namespace cfg;
    extern __shared__ __attribute__((aligned(16))) unsigned char lds_raw[];
    LAS unsigned char* lds = (LAS unsigned char*)lds_raw;
    const int tid = threadIdx.x, G = gridDim.x;
    unsigned char* ws = args.ws;
    for (int u = tid; u < (LDS_BYTES - RING_BYTES) / 4; u += NTHR) ((LAS unsigned*)(lds + RING_BYTES))[u] = 0u;
    __syncthreads();
    const bool one_launch = (args.ph_hi - args.ph_lo) > 1;
    XcdBarrier bar; bar.bar = (unsigned*)(ws + WS_CTL) + CW_BAR; bar.x = 0; bar.st = nullptr;
    if (one_launch) bar = xcd_barrier_post((unsigned*)(ws + WS_CTL) + CW_BAR, (volatile LAS unsigned*)(lds + MISC_OFF) + 8);
    const int lo = args.ph_lo, hi = args.ph_hi;
#define IN(k) (lo <= (k) && (k) < hi)
#define SEAM(k) do { if (IN(k) && IN((k) + 1)) xcd_barrier(bar); } while (0)
    bf16* const XB = (bf16*)(ws + WS_XB); bf16* const HAB = (bf16*)(ws + WS_HAB); bf16* const HBB = (bf16*)(ws + WS_HBB); bf16* const HFF = (bf16*)(ws + WS_HFF);
    float* const PRE = (float*)(ws + WS_PRE); float* const HA = (float*)(ws + WS_HA); float* const HB = (float*)(ws + WS_HB);

    if (IN(0)) { for (int rep_ = 0; rep_ < probe_rep(0); ++rep_) { if (rep_) __syncthreads();  p0_prologue(args, lds, G);  } SEAM(0); }
    if (IN(1)) { for (int rep_ = 0; rep_ < probe_rep(1); ++rep_) { if (rep_) __syncthreads();  pg8::Gemm g{XB, (const bf16*)(ws + WS_WIN), M, INPAD, DM}; pg8::StaticOrder S; S.init(M, INPAD, G, (int)blockIdx.x);
        pg8::EpiIn E{(bf16*)(ws + WS_ZX), (float*)(ws + WS_DT), args.out + O_PCONV, args.out + O_SCONV};
        pg8::gemm_phase<pg8::EpiIn, pg8::StaticOrder, true, true>(lds, g, S, E);  } SEAM(1); }
    if (IN(2)) { for (int rep_ = 0; rep_ < probe_rep(2); ++rep_) { if (rep_) __syncthreads(); conv_phase(args, G); } SEAM(2); }
    if (IN(3)) { for (int rep_ = 0; rep_ < probe_rep(3); ++rep_) { if (rep_) __syncthreads();  scan_phase2(args, lds, G);  } SEAM(3); }
    if (IN(4)) { for (int rep_ = 0; rep_ < probe_rep(4); ++rep_) { if (rep_) __syncthreads();  norm_phase(args, G);  } SEAM(4); }
    if (IN(5)) { for (int rep_ = 0; rep_ < probe_rep(5); ++rep_) { if (rep_) __syncthreads();  pg8::Gemm g{(const bf16*)(ws + WS_YN), (const bf16*)(ws + WS_WOUT), M, DM, DIN}; pg8::StaticOrder S; S.init(M, DM, G, (int)blockIdx.x);
        pg8::EpiRes E{PRE, args.x_prompt, args.x_sample - (size_t)MP * DM};
        pg8::gemm_phase<pg8::EpiRes, pg8::StaticOrder, true, true>(lds, g, S, E); if ((int)blockIdx.x >= 16 && G > 16) fill_acmp(args, (int)blockIdx.x - 16, G - 16, 0, ACMP_SPLIT);  } SEAM(5); }
    if (IN(6)) { for (int rep_ = 0; rep_ < probe_rep(6); ++rep_) { if (rep_) __syncthreads();  ln_phase(PRE, args.ln_g + 0 * DM, args.ln_b + 0 * DM, HA, HAB, G);  } SEAM(6); }
    if (IN(7)) { for (int rep_ = 0; rep_ < probe_rep(7); ++rep_) { if (rep_) __syncthreads();  pg8::Gemm g{HAB, (const bf16*)(ws + WS_W1), M, DFF, DM}; pg8::StaticOrder S; S.init(M, DFF, G, (int)blockIdx.x);
        pg8::EpiRelu2 E{HFF}; pg8::gemm_phase<pg8::EpiRelu2, pg8::StaticOrder, true, true>(lds, g, S, E);  } SEAM(7); }
    if (IN(8)) { for (int rep_ = 0; rep_ < probe_rep(8); ++rep_) { if (rep_) __syncthreads();  pg8::Gemm g{HFF, (const bf16*)(ws + WS_W2), M, DM, DFF}; pg8::StaticOrder S; S.init(M, DM, G, (int)blockIdx.x);
        pg8::EpiRes E{PRE, HA, HA}; pg8::gemm_phase<pg8::EpiRes, pg8::StaticOrder, true, true>(lds, g, S, E); if ((int)blockIdx.x >= 16 && G > 16) fill_acmp(args, (int)blockIdx.x - 16, G - 16, ACMP_SPLIT, ACMP_ITEMS);  } SEAM(8); }
    if (IN(9)) { for (int rep_ = 0; rep_ < probe_rep(9); ++rep_) { if (rep_) __syncthreads();  ln_phase(PRE, args.ln_g + 1 * DM, args.ln_b + 1 * DM, HB, HBB, G);  } SEAM(9); }
    if (IN(10)) { for (int rep_ = 0; rep_ < probe_rep(10); ++rep_) { if (rep_) __syncthreads();  pg8::Gemm g{HBB, (const bf16*)(ws + WS_WKVQ), M, KVQN, DM}; pg8::StaticOrder S; S.init(M, KVQN, G, (int)blockIdx.x);
        pg8::EpiKvq E{args.out, (bf16*)(ws + WS_KVB), (bf16*)(ws + WS_QB), (float*)(ws + WS_GATES), (bf16*)(ws + WS_ACMP)};
        pg8::gemm_phase<pg8::EpiKvq, pg8::StaticOrder, true, true>(lds, g, S, E);  } SEAM(10); }
    if (IN(11)) { for (int rep_ = 0; rep_ < probe_rep(11); ++rep_) { if (rep_) __syncthreads();  pg8::Gemm g{(const bf16*)(ws + WS_ACMP), (const bf16*)(ws + WS_WC1), 2 * NCMPROWS, 512, 1024}; pg8::CmpOrder S{G, (int)blockIdx.x};
        pg8::EpiP E{(float*)(ws + WS_PCMP)}; pg8::gemm_phase<pg8::EpiP, pg8::CmpOrder, true, true>(lds, g, S, E);  } SEAM(11); }
    if (IN(12)) { for (int rep_ = 0; rep_ < probe_rep(12); ++rep_) { if (rep_) __syncthreads();  cmp2_phase(args, lds, G);  } SEAM(12); }
    if (IN(13)) { for (int rep_ = 0; rep_ < probe_rep(13); ++rep_) { if (rep_) __syncthreads();  attn_phase2(args, lds, G);  } SEAM(13); }
    if (IN(14)) { for (int rep_ = 0; rep_ < probe_rep(14); ++rep_) { if (rep_) __syncthreads();  pg8::Gemm g{(const bf16*)(ws + WS_OB), (const bf16*)(ws + WS_WO), M, DM, DM}; pg8::StaticOrder S; S.init(M, DM, G, (int)blockIdx.x);
        pg8::EpiRes E{PRE, HB, HB}; pg8::gemm_phase<pg8::EpiRes, pg8::StaticOrder, true, true>(lds, g, S, E);  } SEAM(14); }
    if (IN(15)) { for (int rep_ = 0; rep_ < probe_rep(15); ++rep_) { if (rep_) __syncthreads();  ln_phase(PRE, args.ln_g + 2 * DM, args.ln_b + 2 * DM, HA, HAB, G);  } SEAM(15); }
    if (IN(16)) { for (int rep_ = 0; rep_ < probe_rep(16); ++rep_) { if (rep_) __syncthreads();  pg8::Gemm g{HAB, (const bf16*)(ws + WS_W1) + (size_t)DFF * DM, M, DFF, DM}; pg8::StaticOrder S; S.init(M, DFF, G, (int)blockIdx.x);
        pg8::EpiRelu2 E{HFF}; pg8::gemm_phase<pg8::EpiRelu2, pg8::StaticOrder, true, true>(lds, g, S, E);  } SEAM(16); }
    if (IN(17)) { for (int rep_ = 0; rep_ < probe_rep(17); ++rep_) { if (rep_) __syncthreads();  pg8::Gemm g{HFF, (const bf16*)(ws + WS_W2) + (size_t)DFF * DM, M, DM, DFF}; pg8::StaticOrder S; S.init(M, DM, G, (int)blockIdx.x);
        pg8::EpiRes E{PRE, HA, HA}; pg8::gemm_phase<pg8::EpiRes, pg8::StaticOrder, true, true>(lds, g, S, E); if ((int)blockIdx.x >= 16 && G > 16) fill_swin(args, (int)blockIdx.x - 16, G - 16);  } SEAM(17); }
    if (IN(18)) { for (int rep_ = 0; rep_ < probe_rep(18); ++rep_) { if (rep_) __syncthreads(); ln_phase(PRE, args.ln_g + 3 * DM, args.ln_b + 3 * DM, args.out + O_YP, nullptr, G); } }
#undef IN
#undef SEAM
}

extern "C" void kernel_launch(void* const* d_in, const int* in_sizes, int n_in, void* d_out, int out_size, void* d_ws, size_t ws_size, hipStream_t stream) {
    using namespace cfg;
    static int grid = 0;
    if (grid == 0) {
        if (n_in != 27 || (size_t)out_size != O_END || ws_size < WS_END) { fprintf(stderr, "kernel_launch: unexpected shapes (n_in %d, out %d, ws %zu, need %zu); nothing launched\n", n_in, out_size, ws_size, (size_t)WS_END); grid = -1; return; }
        int dev = 0, cus = 0, per_cu = 0;
        if (hipGetDevice(&dev) != hipSuccess || hipDeviceGetAttribute(&cus, hipDeviceAttributeMultiprocessorCount, dev) != hipSuccess) { grid = -1; return; }
        if (hipFuncSetAttribute((const void*)yoco_fwd, hipFuncAttributeMaxDynamicSharedMemorySize, LDS_BYTES) != hipSuccess) { fprintf(stderr, "kernel_launch: hipFuncSetAttribute failed\n"); grid = -1; return; }
        if (hipOccupancyMaxActiveBlocksPerMultiprocessor(&per_cu, (const void*)yoco_fwd, NTHR, LDS_BYTES) != hipSuccess || per_cu < 1) { fprintf(stderr, "kernel_launch: occupancy query says %d blocks per CU\n", per_cu); }
        (void)hipGetLastError();
        grid = cus;
    }
    if (grid < 0) return;
    if (hipMemsetAsync((char*)d_ws + WS_CTL, 0, CTL_ZERO_BYTES, stream) != hipSuccess) { fprintf(stderr, "kernel_launch: memset failed\n"); return; }
    Args a{};
    const float* const* fin = (const float* const*)d_in;
    a.x_prompt = fin[0]; a.x_sample = fin[1]; a.state_ssm = fin[2]; a.state_conv = fin[3]; a.cache_cmp = fin[4]; a.cache_sel = fin[5]; a.cache_win = fin[6]; a.page_table = (const int*)d_in[7];
    a.ln_g = fin[8]; a.ln_b = fin[9]; a.m_in_w = fin[10]; a.m_conv_w = fin[11]; a.m_conv_b = fin[12]; a.m_dt_bias = fin[13]; a.m_a_log = fin[14]; a.m_d = fin[15]; a.m_norm_w = fin[16]; a.m_out_w = fin[17];
    a.kv_w = fin[18]; a.cmp_w1 = fin[19]; a.cmp_pe = fin[20]; a.cmp_w2 = fin[21]; a.q_w = fin[22]; a.o_w = fin[23]; a.rel_bias = fin[24]; a.mlp_w1 = fin[25]; a.mlp_w2 = fin[26];
    a.out = (float*)d_out; a.ws = (unsigned char*)d_ws; a.pad = 0;
    constexpr int NL = (MK_N_LAUNCHES == 1) ? 1 : N_PHASES;
    for (int li = 0; li < NL; ++li) {
        a.ph_lo = (NL == 1) ? 0 : li; a.ph_hi = (NL == 1) ? N_PHASES : li + 1; a.li = li;
        hipLaunchKernelGGL(yoco_fwd, dim3(grid), dim3(NTHR), LDS_BYTES, stream, a);
        const hipError_t le = hipPeekAtLastError();
        if (le != hipSuccess) { fprintf(stderr, "kernel_launch: launch %d failed: %s\n", li, hipGetErrorName(le)); break; }
    }
}
```
